# Optimizing an MI355X kernel written in HIP

```python
import jax
import jax.numpy as jnp
from jax import lax
import numpy as np

D_MODEL = 1024
BATCH = 16
SEQ = 4096
DEPTH = 4

PLE_DIM = 256
D_FF = 2816
EPS = 1e-6
ROPE_THETA = 500000.0
ROPE_FRACTION = 4
NEG_BIG = -1e30

A_HEAD_DIM = 64
A_HEADS_PER_GROUP = 4
A_GROUPS = ((128, 1), (512, 4), (2048, 16))
A_HEADS = A_HEADS_PER_GROUP * len(A_GROUPS)
A_WIDTH = A_HEADS * A_HEAD_DIM
A_OUT = A_HEADS_PER_GROUP * A_HEAD_DIM

B_HEADS = 8
B_DK = 128
B_DV = 96
B_QK_WIDTH = B_HEADS * B_DK
B_WIDTH = B_HEADS * B_DV
B_CHUNK = 32

C_HEADS = 6
C_NOPE = 128
C_ROPE = 64
C_V = 128
C_Q_RANK = 384
C_KV_RANK = 256
C_ROPE_THETA = 10000.0
C_WIDTH = C_HEADS * C_V
C_QBLOCK = 128

N_BRANCHES = 3
IN_SIZES = (A_WIDTH, A_WIDTH, A_WIDTH, B_QK_WIDTH, B_QK_WIDTH, B_WIDTH, B_WIDTH, C_Q_RANK, C_KV_RANK, C_ROPE, N_BRANCHES * D_MODEL)
IN_WIDTH = sum(IN_SIZES)

kernel_name = 'hybrid_gated_parallel_mixer_trunk'

F32 = jnp.float32


def rmsnorm(x, g):
    xf = x.astype(F32)
    y = xf * lax.rsqrt(jnp.mean(xf * xf, axis=-1, keepdims=True) + EPS)
    return (y * g.astype(F32)).astype(x.dtype)


def swiglu(x, w_up, w_down):
    g, u = jnp.split(x @ w_up, 2, axis=-1)
    return (jax.nn.silu(g) * u) @ w_down


def rope_table(seq, dim, theta):
    inv_freq = 1.0 / (theta ** (jnp.arange(0, dim, 2, dtype=F32) / dim))
    ang = jnp.arange(seq, dtype=F32)[:, None] * inv_freq[None, :]
    return jnp.cos(ang), jnp.sin(ang)


def apply_rope(t, cos, sin):
    t1, t2 = jnp.split(t.astype(F32), 2, axis=-1)
    c = cos[None, :, None, :]
    s = sin[None, :, None, :]
    return jnp.concatenate([t1 * c - t2 * s, t2 * c + t1 * s], axis=-1).astype(t.dtype)


def partial_rope(t, cos, sin):
    rot = 2 * cos.shape[-1]
    return jnp.concatenate([apply_rope(t[..., :rot], cos, sin), t[..., rot:]], axis=-1)


def dilated_group(q, k, v, window, dil, scale):
    Bn, Sn, H, hd = q.shape
    span = window // dil
    n = Sn // dil
    nb = -(-n // span)
    pad = nb * span - n

    def to_blocks(t):
        t = t.reshape(Bn, n, dil, H, hd).transpose(0, 2, 1, 3, 4)
        t = jnp.pad(t, ((0, 0), (0, 0), (0, pad), (0, 0), (0, 0)))
        return t.reshape(Bn, dil, nb, span, H, hd)

    def with_prev(t):
        prev = jnp.pad(t, ((0, 0), (0, 0), (1, 0), (0, 0), (0, 0), (0, 0)))[:, :, :-1]
        return jnp.concatenate([prev, t], axis=3)

    qb = to_blocks(q)
    kw = with_prev(to_blocks(k))
    vw = with_prev(to_blocks(v))
    s = jnp.einsum('brnqhd,brnkhd->brnhqk', qb, kw).astype(F32) * scale
    qi = jnp.arange(span)[:, None]
    kj = jnp.arange(2 * span)[None, :]
    dist = qi + span - kj
    key_sub = (jnp.arange(nb) * span)[:, None, None] + kj[None] - span
    mask = (dist >= 0)[None] & (dist <= span)[None] & (key_sub >= 0)
    mask = mask[None, None, :, None]
    s = jnp.where(mask, s, NEG_BIG)
    m = jnp.max(s, axis=-1, keepdims=True)
    e = jnp.where(mask, jnp.exp(s - m), 0.0)
    den = jnp.sum(e, axis=-1, keepdims=True)
    o = jnp.einsum('brnhqk,brnkhd->brnqhd', (e / den).astype(v.dtype), vw)
    lse = (m + jnp.log(den))[..., 0]
    o = o.reshape(Bn, dil, nb * span, H, hd)[:, :, :n].transpose(0, 2, 1, 3, 4).reshape(Bn, Sn, H, hd)
    lse = lse.transpose(0, 1, 2, 4, 3).reshape(Bn, dil, nb * span, H)[:, :, :n]
    lse = lse.transpose(0, 2, 1, 3).reshape(Bn, Sn, H)
    return o, lse


def dilated_window_attention(q, k, v):
    scale = A_HEAD_DIM ** -0.5
    outs, lses = [], []
    for g, (window, dil) in enumerate(A_GROUPS):
        hs = slice(g * A_HEADS_PER_GROUP, (g + 1) * A_HEADS_PER_GROUP)
        o, lse = dilated_group(q[:, :, hs], k[:, :, hs], v[:, :, hs], window, dil, scale)
        outs.append(o)
        lses.append(lse)
    w = jax.nn.softmax(jnp.stack(lses, axis=0), axis=0)
    o = jnp.einsum('gbsh,gbshd->bshd', w, jnp.stack(outs, axis=0).astype(F32))
    return o.astype(q.dtype)


def hgrn2_chunkwise(q, log_f, k, v):
    Bn, Sn, H, dk = q.shape
    L = B_CHUNK
    N = Sn // L

    def chunk(t):
        return t.reshape(Bn, N, L, H, t.shape[-1]).transpose(1, 0, 3, 2, 4)

    q, log_f, k, v = chunk(q), chunk(log_f), chunk(k), chunk(v)
    cum = jnp.cumsum(log_f, axis=3)
    ref = cum[:, :, :, L // 2 - 1:L // 2]
    a = jnp.einsum('nbhld,nbhmd->nbhlm', q * jnp.exp(cum - ref), k * jnp.exp(ref - cum))
    causal = jnp.tril(jnp.ones((L, L), dtype=bool))
    o_intra = jnp.einsum('nbhlm,nbhmv->nbhlv', jnp.where(causal, a, 0.0), v)
    total = cum[:, :, :, -1]
    q_inter = q * jnp.exp(cum)
    k_end = k * jnp.exp(total[:, :, :, None] - cum)

    def step(state, xs):
        qi, ke, vc, tot = xs
        o = jnp.einsum('bhld,bhdv->bhlv', qi, state)
        state = state * jnp.exp(tot)[..., None] + jnp.einsum('bhld,bhlv->bhdv', ke, vc)
        return state, o

    s0 = jnp.zeros((Bn, H, dk, v.shape[-1]), F32)
    _, o_inter = lax.scan(step, s0, (q_inter, k_end, v, total))
    o = o_intra + o_inter
    return o.transpose(1, 0, 3, 2, 4).reshape(Bn, Sn, H, v.shape[-1])


def causal_block_attention(q, k, v, scale):
    Bn, Sn, H, dq = q.shape
    dv = v.shape[-1]
    nq = Sn // C_QBLOCK
    qb = q.reshape(Bn, nq, C_QBLOCK, H, dq).transpose(1, 0, 2, 3, 4)
    kpos = jnp.arange(Sn)

    def one(args):
        qi, start = args
        s = jnp.einsum('bqhd,bkhd->bhqk', qi, k).astype(F32) * scale
        qpos = start + jnp.arange(C_QBLOCK)
        s = jnp.where(qpos[:, None] >= kpos[None, :], s, NEG_BIG)
        p = jax.nn.softmax(s, axis=-1)
        return jnp.einsum('bhqk,bkhd->bqhd', p.astype(v.dtype), v)

    o = lax.map(one, (qb, jnp.arange(nq) * C_QBLOCK))
    return o.transpose(1, 0, 2, 3, 4).reshape(Bn, Sn, H, dv)


def token_mixers(h, w_in, lb, b_gnorm, c_q_norm, w_c_qb, c_kv_norm, w_c_kvb,
                 w_branch_a, w_branch_b, w_branch_c, w_out, rope_a, rope_c):
    Bn, Sn, _ = h.shape
    dt = h.dtype
    offsets = np.cumsum(IN_SIZES)[:-1].tolist()
    (a_q, a_k, a_v, b_q, b_f, b_i, b_g, c_q, c_kv, c_kr, gate_logits) = jnp.split(h @ w_in, offsets, axis=-1)

    def heads(t, n_heads):
        return t.reshape(Bn, Sn, n_heads, -1)

    cos_a, sin_a = rope_a
    qa = partial_rope(heads(a_q, A_HEADS), cos_a, sin_a)
    ka = partial_rope(heads(a_k, A_HEADS), cos_a, sin_a)
    ya = dilated_window_attention(qa, ka, heads(a_v, A_HEADS)).reshape(Bn, Sn, A_OUT) @ w_branch_a

    z = heads(b_f, B_HEADS).astype(F32)
    lbh = lb.astype(F32).reshape(B_HEADS, B_DK)
    log_f = jnp.log(lbh + (1.0 - lbh) * jax.nn.sigmoid(z))
    k_in = (1.0 - lbh) * jax.nn.sigmoid(-z)
    yb = hgrn2_chunkwise(heads(b_q, B_HEADS).astype(F32), log_f, k_in, heads(b_i, B_HEADS).astype(F32))
    yb = rmsnorm(yb, b_gnorm) * jax.nn.silu(heads(b_g, B_HEADS).astype(F32))
    yb = yb.reshape(Bn, Sn, B_WIDTH).astype(dt) @ w_branch_b

    cos_c, sin_c = rope_c
    qc = (rmsnorm(c_q, c_q_norm) @ w_c_qb).reshape(Bn, Sn, C_HEADS, C_NOPE + C_ROPE)
    q_pe = apply_rope(qc[..., C_NOPE:], cos_c, sin_c)
    qc = jnp.concatenate([qc[..., :C_NOPE], q_pe], axis=-1)
    kvc = (rmsnorm(c_kv, c_kv_norm) @ w_c_kvb).reshape(Bn, Sn, C_HEADS, C_NOPE + C_V)
    k_pe = apply_rope(c_kr.reshape(Bn, Sn, 1, C_ROPE), cos_c, sin_c)
    kc = jnp.concatenate([kvc[..., :C_NOPE], jnp.broadcast_to(k_pe, (Bn, Sn, C_HEADS, C_ROPE))], axis=-1)
    yc = causal_block_attention(qc, kc, kvc[..., C_NOPE:], (C_NOPE + C_ROPE) ** -0.5)
    yc = yc.reshape(Bn, Sn, C_WIDTH) @ w_branch_c

    gates = jax.nn.sigmoid(gate_logits.astype(F32)).reshape(Bn, Sn, N_BRANCHES, D_MODEL).astype(dt)
    merged = gates[:, :, 0] * ya + gates[:, :, 1] * yb + gates[:, :, 2] * yc
    return merged @ w_out


def setup_inputs(seed: int = 0) -> dict:
    key = jax.random.key(seed)
    ks = jax.random.split(key, 32)
    L = DEPTH
    D = D_MODEL

    def w(k, shape, fan_in):
        return jax.random.normal(k, shape, F32) * fan_in ** -0.5

    def gain(k, shape):
        return 1.0 + 0.05 * jax.random.normal(k, shape, F32)

    return {
        'x': jax.random.normal(ks[0], (BATCH, SEQ, D), F32),
        'p': jax.random.normal(ks[1], (DEPTH, BATCH, SEQ, PLE_DIM), F32),
        'norm_ffn1': gain(ks[2], (L, D)),
        'w_ffn1_up': w(ks[3], (L, D, 2 * D_FF), D),
        'w_ffn1_down': w(ks[4], (L, D_FF, D), D_FF),
        'norm_mix': gain(ks[5], (L, D)),
        'w_in': w(ks[6], (L, D, IN_WIDTH), D),
        'b_lb_logits': 0.1 * jax.random.normal(ks[7], (L, B_QK_WIDTH), F32),
        'b_gnorm': gain(ks[8], (L, B_DV)),
        'c_q_norm': gain(ks[9], (L, C_Q_RANK)),
        'w_c_qb': w(ks[10], (L, C_Q_RANK, C_HEADS * (C_NOPE + C_ROPE)), C_Q_RANK),
        'c_kv_norm': gain(ks[11], (L, C_KV_RANK)),
        'w_c_kvb': w(ks[12], (L, C_KV_RANK, C_HEADS * (C_NOPE + C_V)), C_KV_RANK),
        'w_branch_a': w(ks[13], (L, A_OUT, D), A_OUT),
        'w_branch_b': w(ks[14], (L, B_WIDTH, D), B_WIDTH),
        'w_branch_c': w(ks[15], (L, C_WIDTH, D), C_WIDTH),
        'w_out': w(ks[16], (L, D, D), D),
        'norm_ffn2': gain(ks[17], (L, D)),
        'w_ffn2_up': w(ks[18], (L, D, 2 * D_FF), D),
        'w_ffn2_down': w(ks[19], (L, D_FF, D), D_FF),
        'norm_ple': gain(ks[20], (L, D)),
        'w_ple_gate': w(ks[21], (L, D, D), D),
        'w_ple_proj': w(ks[22], (L, PLE_DIM, D), PLE_DIM),
        'norm_final': gain(ks[23], (D,)),
    }


def reference(x, p, norm_ffn1, w_ffn1_up, w_ffn1_down, norm_mix, w_in, b_lb_logits, b_gnorm,
              c_q_norm, w_c_qb, c_kv_norm, w_c_kvb, w_branch_a, w_branch_b, w_branch_c, w_out,
              norm_ffn2, w_ffn2_up, w_ffn2_down, norm_ple, w_ple_gate, w_ple_proj, norm_final):
    Sn = x.shape[1]
    rope_a = rope_table(Sn, A_HEAD_DIM // ROPE_FRACTION, ROPE_THETA)
    rope_c = rope_table(Sn, C_ROPE, C_ROPE_THETA)
    lb_p = jax.nn.softmax(b_lb_logits.astype(F32), axis=0)
    lower_bounds = jnp.cumsum(lb_p, axis=0) - lb_p[0:1]
    for i in range(DEPTH):
        x = x + 0.5 * swiglu(rmsnorm(x, norm_ffn1[i]), w_ffn1_up[i], w_ffn1_down[i])
        h = rmsnorm(x, norm_mix[i])
        x = x + token_mixers(h, w_in[i], lower_bounds[i], b_gnorm[i], c_q_norm[i], w_c_qb[i],
                             c_kv_norm[i], w_c_kvb[i], w_branch_a[i], w_branch_b[i], w_branch_c[i],
                             w_out[i], rope_a, rope_c)
        x = x + 0.5 * swiglu(rmsnorm(x, norm_ffn2[i]), w_ffn2_up[i], w_ffn2_down[i])
        gate = jax.nn.sigmoid((rmsnorm(x, norm_ple[i]) @ w_ple_gate[i]).astype(F32)).astype(x.dtype)
        x = x + gate * (p[i] @ w_ple_proj[i])
    return rmsnorm(x, norm_final)
```

```cpp
#include <hip/hip_runtime.h>
#include <cstdio>
#include <cstdint>

#ifndef MK_DUP
#define MK_DUP 0u
#endif
#define MK_NAIVE_A 0
#define MK_NAIVE_C 0
#define MK_NAIVE_B 0
#ifndef PH_MASK
#define PH_MASK 0xFFFFFFFFu
#endif
#ifndef MK_N_LAUNCHES
#define MK_N_LAUNCHES 1
#endif

namespace pg8 {
#define PG8_LAS __attribute__((address_space(3)))
typedef unsigned short bf16_t;
typedef short bf16x8 __attribute__((ext_vector_type(8)));
typedef float f32x4 __attribute__((ext_vector_type(4)));
typedef unsigned u32x4 __attribute__((ext_vector_type(4)));
typedef unsigned u32x2 __attribute__((ext_vector_type(2)));
constexpr int BM = 256, BK = 64, HALF = 128, HTB = HALF * BK * 2  , STAGE_BYTES = 8 * HTB, NXCD = 8, WGM = 8;

__host__ __device__ __forceinline__ int lds_byte(int r, int c) { const int st = (r >> 4) * 2 + (c >> 5), rr = r & 15, cc = c & 31, ob = rr * 64 + cc * 2; return st * 1024 + (ob ^ (((ob >> 9) & 1) << 5)); }
__host__ __device__ __forceinline__ void stage_rc(int b, int& R, int& C) { const int st = b / 1024, sb = b % 1024, swz = sb ^ (((sb >> 9) & 1) << 5); R = (st >> 1) * 16 + swz / 64; C = (st & 1) * 32 + (swz % 64) / 2; }
__host__ __device__ __forceinline__ int perm32(int rho) { const int n = rho >> 4, i = rho & 15; return 8 * (i >> 2) + 4 * n + (i & 3); }

struct Unit { int pm, pn; };
struct Gemm { const bf16_t* A; const bf16_t* Bt; int M, N, K, lda; };

struct StaticOrder {
    int nM, nN, nwg, G, c;
    __host__ __device__ void init(int M, int N, int G_, int c_) { nM = M / BM; nN = N / BM; nwg = nM * nN; G = G_; c = c_; }
    __host__ __device__ bool next(int i, Unit& u) const {
        const long L = (long)i * G + c; if (L >= nwg) return false;
        int wgid = (int)L; { const int q = nwg / NXCD, r = nwg % NXCD, xcd = wgid % NXCD, off = wgid / NXCD; wgid = (xcd < r ? xcd * (q + 1) : r * (q + 1) + (xcd - r) * q) + off; }
        const int nig = WGM * nN, gid = wgid / nig, fm = gid * WGM, gsz = (nM - fm) < WGM ? (nM - fm) : WGM;
        u.pm = fm + ((wgid % nig) % gsz); u.pn = (wgid % nig) / gsz; return true;
    }
    __device__ __forceinline__ void a_ready(const Unit&) const {}
    __device__ __forceinline__ void done(const Unit&) const {}
};

typedef float f32x2_t __attribute__((ext_vector_type(2))); typedef __bf16 bf16x2_t __attribute__((ext_vector_type(2)));
__device__ __forceinline__ unsigned cvt_pk_bf16(float lo, float hi) { f32x2_t v = {lo, hi}; bf16x2_t b = __builtin_convertvector(v, bf16x2_t); return __builtin_bit_cast(unsigned, b); }
typedef _Float16 f16x2_t __attribute__((ext_vector_type(2))); typedef _Float16 f16x8_t __attribute__((ext_vector_type(8)));
__device__ __forceinline__ unsigned cvt_pk_f16(float lo, float hi) { f32x2_t v = {lo, hi}; f16x2_t h = __builtin_convertvector(v, f16x2_t); return __builtin_bit_cast(unsigned, h); }
__device__ __forceinline__ float f16lo(unsigned u) { return (float)__builtin_bit_cast(f16x2_t, u)[0]; }
__device__ __forceinline__ float f16hi(unsigned u) { return (float)__builtin_bit_cast(f16x2_t, u)[1]; }

template <class Epi, class Sched, bool ALIGN_EPI = true, bool F16 = false>
__device__ __forceinline__ void gemm_phase(PG8_LAS unsigned char* lds, const Gemm g, const Sched& S, const Epi& E, int tid_in) {
    int tid_ = tid_in; asm volatile("" : "+v"(tid_));
    const int tid = tid_, wid = __builtin_amdgcn_readfirstlane(tid >> 6), lane = tid & 63, wr = wid >> 2, wc = wid & 3, fr = lane & 15, fq = lane >> 4;
    const int K = g.K, nt = K / BK, lda = g.lda;
    unsigned voffA[2], voffB[2];
#pragma unroll
    for (int i = 0; i < 2; ++i) { int R, C; stage_rc(tid * 16 + i * 8192, R, C); const int Rb = Epi::PERM ? ((Epi::ADJ ? 2 : 1) * (R & ~31) + perm32(R & 31)) : R;
        voffA[i] = (unsigned)(R * lda + C) * 2u; voffB[i] = (unsigned)(Rb * K + C) * 2u; }
    const size_t kstep = (size_t)(BK * 2);
    const size_t hstepA = (size_t)HALF * lda * 2, hstepB = (size_t)(Epi::ADJ ? 32 : HALF) * K * 2;
    const size_t tstepA = 2 * hstepA, tstepB = (size_t)2 * HALF * K * 2;
    const unsigned ldsw = (unsigned)wid * 1024u;
    const int aoff = lds_byte(wr * 64 + fr, fq * 8), boff = lds_byte(wc * 32 + fr, fq * 8);
#define PG8_SA(b, h) (((b) * 2 + (h)) * HTB)
#define PG8_SB(b, h) ((4 + (b) * 2 + (h)) * HTB)
#define PG8_STAGE(bufoff, gbase, voff) do { _Pragma("unroll") for (int _i = 0; _i < 2; ++_i) \
        __builtin_amdgcn_global_load_lds((const unsigned*)((const char*)(gbase) + (voff)[_i]), (PG8_LAS unsigned*)(lds + (bufoff) + ldsw + _i * 8192), 16, 0, 0); } while (0)
#define PG8_LDA(dst, b, h) do { _Pragma("unroll") for (int m = 0; m < 4; ++m) _Pragma("unroll") for (int k = 0; k < 2; ++k) dst[m][k] = *(const PG8_LAS bf16x8*)(lds + PG8_SA(b, h) + aoff + m * 2048 + k * 1024); } while (0)
#define PG8_LDB(dst, b, h) do { _Pragma("unroll") for (int n = 0; n < 2; ++n) _Pragma("unroll") for (int k = 0; k < 2; ++k) dst[n][k] = *(const PG8_LAS bf16x8*)(lds + PG8_SB(b, h) + boff + n * 2048 + k * 1024); } while (0)
#define PG8_MMA(ai, bj, At, Bt) do { __builtin_amdgcn_s_setprio(1); _Pragma("unroll") for (int m = 0; m < 4; ++m) _Pragma("unroll") for (int n = 0; n < 2; ++n) _Pragma("unroll") for (int k = 0; k < 2; ++k) \
        { if constexpr (F16) acc[ai][bj][m][n] = __builtin_amdgcn_mfma_f32_16x16x32_f16(__builtin_bit_cast(f16x8_t, Bt[n][k]), __builtin_bit_cast(f16x8_t, At[m][k]), acc[ai][bj][m][n], 0, 0, 0); \
          else acc[ai][bj][m][n] = __builtin_amdgcn_mfma_f32_16x16x32_bf16(Bt[n][k], At[m][k], acc[ai][bj][m][n], 0, 0, 0); } __builtin_amdgcn_s_setprio(0); } while (0)
#define PG8_WAIT_V(n) asm volatile("s_waitcnt vmcnt(" #n ")" ::: "memory")
#define PG8_WAIT_L(n) asm volatile("s_waitcnt lgkmcnt(" #n ")" ::: "memory")
#define PG8_BAR __builtin_amdgcn_s_barrier()
#define PG8_SCHED __builtin_amdgcn_sched_barrier(0)
    Unit cur, nxt; int ui = 0;
    if (!S.next(0, cur)) return;
    f32x4 acc[2][2][4][2];
#pragma unroll
    for (int a = 0; a < 2; ++a)
#pragma unroll
        for (int b = 0; b < 2; ++b)
#pragma unroll
            for (int m = 0; m < 4; ++m)
#pragma unroll
                for (int n = 0; n < 2; ++n) acc[a][b][m][n] = (f32x4){0.f, 0.f, 0.f, 0.f};
    bf16x8 At[4][2], B0[2][2], B1[2][2];
    const char* cA = (const char*)g.A + (size_t)cur.pm * tstepA; const char* cB = (const char*)g.Bt + (size_t)cur.pn * tstepB;
    S.a_ready(cur);
    PG8_STAGE(PG8_SB(0, 0), cB, voffB); PG8_STAGE(PG8_SB(0, 1), cB + hstepB, voffB); PG8_STAGE(PG8_SA(0, 0), cA, voffA); PG8_STAGE(PG8_SA(0, 1), cA + hstepA, voffA);
    if (wr == 1) PG8_BAR;
    PG8_WAIT_V(2); PG8_BAR;
    PG8_STAGE(PG8_SB(1, 0), cB + kstep, voffB); PG8_STAGE(PG8_SA(1, 0), cA + kstep, voffA); PG8_STAGE(PG8_SB(1, 1), cB + hstepB + kstep, voffB);
    PG8_WAIT_V(6); PG8_BAR;
    for (;;) {
        const bool has_next = S.next(ui + 1, nxt);
        const char* nA = has_next ? (const char*)g.A + (size_t)nxt.pm * tstepA : cA; const char* nB = has_next ? (const char*)g.Bt + (size_t)nxt.pn * tstepB : cB;
#pragma unroll 1
        for (int t = 0; t < nt; t += 2) {
            const bool last = (t == nt - 2);
            const char* a1 = cA + (size_t)(t + 1) * kstep;
            const char* a2 = last ? nA : cA + (size_t)(t + 2) * kstep; const char* b2 = last ? nB : cB + (size_t)(t + 2) * kstep;
            const char* a3 = a2 + kstep; const char* b3 = b2 + kstep;
            if (last && has_next) S.a_ready(nxt);
            PG8_LDB(B0, 0, 0); PG8_LDB(B1, 0, 1); PG8_SCHED; PG8_LDA(At, 0, 0); PG8_STAGE(PG8_SA(1, 1), a1 + hstepA, voffA);
            PG8_WAIT_V(8); PG8_WAIT_L(0); PG8_BAR; PG8_MMA(0, 0, At, B0); PG8_MMA(0, 1, At, B1); PG8_BAR; PG8_SCHED;
            PG8_LDA(At, 0, 1); PG8_STAGE(PG8_SB(0, 0), b2, voffB); PG8_STAGE(PG8_SB(0, 1), b2 + hstepB, voffB); PG8_STAGE(PG8_SA(0, 0), a2, voffA);
            PG8_WAIT_V(8); PG8_WAIT_L(0); PG8_BAR; PG8_MMA(1, 0, At, B0); PG8_MMA(1, 1, At, B1); PG8_BAR; PG8_SCHED;
            PG8_LDB(B0, 1, 0); PG8_LDB(B1, 1, 1); PG8_SCHED; PG8_LDA(At, 1, 0); PG8_STAGE(PG8_SA(0, 1), a2 + hstepA, voffA);
            PG8_WAIT_V(8); PG8_WAIT_L(0); PG8_BAR; PG8_MMA(0, 0, At, B0); PG8_MMA(0, 1, At, B1); PG8_BAR; PG8_SCHED;
            PG8_LDA(At, 1, 1); PG8_STAGE(PG8_SB(1, 0), b3, voffB); PG8_STAGE(PG8_SB(1, 1), b3 + hstepB, voffB); PG8_STAGE(PG8_SA(1, 0), a3, voffA);
            PG8_WAIT_V(8); PG8_WAIT_L(0); PG8_BAR; PG8_MMA(1, 0, At, B0); PG8_MMA(1, 1, At, B1); PG8_BAR; PG8_SCHED;
        }
        if constexpr (ALIGN_EPI) { if (wr == 0) PG8_BAR; }
        E(acc, cur, wr, wc, fr, fq);
        if (!has_next) break;
#pragma unroll
        for (int a = 0; a < 2; ++a)
#pragma unroll
            for (int b = 0; b < 2; ++b)
#pragma unroll
                for (int m = 0; m < 4; ++m)
#pragma unroll
                    for (int n = 0; n < 2; ++n) acc[a][b][m][n] = (f32x4){0.f, 0.f, 0.f, 0.f};
        cur = nxt; cA = nA; cB = nB; ++ui;
        if constexpr (ALIGN_EPI) { if (wr == 1) PG8_BAR; }
    }
    PG8_WAIT_V(0);
    if constexpr (!ALIGN_EPI) { if (wr == 0) PG8_BAR; }
    PG8_BAR;
#undef PG8_SA
#undef PG8_SB
#undef PG8_STAGE
#undef PG8_LDA
#undef PG8_LDB
#undef PG8_MMA
#undef PG8_WAIT_V
#undef PG8_WAIT_L
#undef PG8_BAR
#undef PG8_SCHED
}
struct Gemm3 { const bf16_t* A0; const bf16_t* A1; const bf16_t* A2; const bf16_t* B0; const bf16_t* B1; const bf16_t* B2; int K0, K1, K2; };
template <class Epi, class Sched>
__device__ __forceinline__ void gemm_phase_ms(PG8_LAS unsigned char* lds, const Gemm3 g, const Sched& S, const Epi& E, int tid_in) {
    constexpr bool ALIGN_EPI = true, F16 = false;
    int tid_ = tid_in; asm volatile("" : "+v"(tid_));
    const int tid = tid_, wid = __builtin_amdgcn_readfirstlane(tid >> 6), lane = tid & 63, wr = wid >> 2, wc = wid & 3, fr = lane & 15, fq = lane >> 4;
#define PG8_VOFF(vA_, vB_, K_) do { int R_, C_; stage_rc(tid * 16, R_, C_); const int Rb_ = Epi::PERM ? ((R_ & ~31) + perm32(R_ & 31)) : R_; vA_ = (unsigned)(R_ * (K_) + C_) * 2u; vB_ = (unsigned)(Rb_ * (K_) + C_) * 2u; } while (0)
#define PG8_SEGK(sg) ((sg) == 0 ? g.K0 : (sg) == 1 ? g.K1 : g.K2)
#define PG8_SEGA(sg) ((const char*)((sg) == 0 ? g.A0 : (sg) == 1 ? g.A1 : g.A2))
#define PG8_SEGB(sg) ((const char*)((sg) == 0 ? g.B0 : (sg) == 1 ? g.B1 : g.B2))
    const size_t kstep = (size_t)(BK * 2);
    const unsigned ldsw = (unsigned)wid * 1024u;
    const int aoff = lds_byte(wr * 64 + fr, fq * 8), boff = lds_byte(wc * 32 + fr, fq * 8);
#define PG8_SA(b, h) (((b) * 2 + (h)) * HTB)
#define PG8_SB(b, h) ((4 + (b) * 2 + (h)) * HTB)
#define PG8_STAGE(bufoff, gbase, voff, s64) do { __builtin_amdgcn_global_load_lds((const unsigned*)((const char*)(gbase) + (voff)), (PG8_LAS unsigned*)(lds + (bufoff) + ldsw), 16, 0, 0); \
        __builtin_amdgcn_global_load_lds((const unsigned*)((const char*)(gbase) + (s64) + (voff)), (PG8_LAS unsigned*)(lds + (bufoff) + ldsw + 8192), 16, 0, 0); } while (0)
#define PG8_LDA(dst, b, h) do { _Pragma("unroll") for (int m = 0; m < 4; ++m) _Pragma("unroll") for (int k = 0; k < 2; ++k) dst[m][k] = *(const PG8_LAS bf16x8*)(lds + PG8_SA(b, h) + aoff + m * 2048 + k * 1024); } while (0)
#define PG8_LDB(dst, b, h) do { _Pragma("unroll") for (int n = 0; n < 2; ++n) _Pragma("unroll") for (int k = 0; k < 2; ++k) dst[n][k] = *(const PG8_LAS bf16x8*)(lds + PG8_SB(b, h) + boff + n * 2048 + k * 1024); } while (0)
#define PG8_MMA(ai, bj, At, Bt) do { __builtin_amdgcn_s_setprio(1); _Pragma("unroll") for (int m = 0; m < 4; ++m) _Pragma("unroll") for (int n = 0; n < 2; ++n) _Pragma("unroll") for (int k = 0; k < 2; ++k) \
        { if constexpr (F16) acc[ai][bj][m][n] = __builtin_amdgcn_mfma_f32_16x16x32_f16(__builtin_bit_cast(f16x8_t, Bt[n][k]), __builtin_bit_cast(f16x8_t, At[m][k]), acc[ai][bj][m][n], 0, 0, 0); \
          else acc[ai][bj][m][n] = __builtin_amdgcn_mfma_f32_16x16x32_bf16(Bt[n][k], At[m][k], acc[ai][bj][m][n], 0, 0, 0); } __builtin_amdgcn_s_setprio(0); } while (0)
#define PG8_WAIT_V(n) asm volatile("s_waitcnt vmcnt(" #n ")" ::: "memory")
#define PG8_WAIT_L(n) asm volatile("s_waitcnt lgkmcnt(" #n ")" ::: "memory")
#define PG8_BAR __builtin_amdgcn_s_barrier()
#define PG8_SCHED __builtin_amdgcn_sched_barrier(0)
    Unit cur, nxt; int ui = 0, seg = 0;
    if (!S.next(0, cur)) return;
    f32x4 acc[2][2][4][2];
#pragma unroll
    for (int a = 0; a < 2; ++a)
#pragma unroll
        for (int b = 0; b < 2; ++b)
#pragma unroll
            for (int m = 0; m < 4; ++m)
#pragma unroll
                for (int n = 0; n < 2; ++n) acc[a][b][m][n] = (f32x4){0.f, 0.f, 0.f, 0.f};
    bf16x8 At[4][2], B0[2][2], B1[2][2];
    int Kc = PG8_SEGK(0); int nt = Kc / BK; size_t hstep = (size_t)HALF * Kc * 2;
    unsigned voffA, voffB; PG8_VOFF(voffA, voffB, Kc);
    const char* cA = PG8_SEGA(0) + (size_t)cur.pm * 2 * hstep; const char* cB = PG8_SEGB(0) + (size_t)cur.pn * 2 * hstep;
    S.a_ready(cur);
    PG8_STAGE(PG8_SB(0, 0), cB, voffB, (hstep >> 1)); PG8_STAGE(PG8_SB(0, 1), cB + hstep, voffB, (hstep >> 1)); PG8_STAGE(PG8_SA(0, 0), cA, voffA, (hstep >> 1)); PG8_STAGE(PG8_SA(0, 1), cA + hstep, voffA, (hstep >> 1));
    if (wr == 1) PG8_BAR;
    PG8_WAIT_V(2); PG8_BAR;
    PG8_STAGE(PG8_SB(1, 0), cB + kstep, voffB, (hstep >> 1)); PG8_STAGE(PG8_SA(1, 0), cA + kstep, voffA, (hstep >> 1)); PG8_STAGE(PG8_SB(1, 1), cB + hstep + kstep, voffB, (hstep >> 1));
    PG8_WAIT_V(6); PG8_BAR;
    for (;;) {
        const int nseg = (seg == 2) ? 0 : seg + 1; nxt = cur;
        const bool has_next = (seg < 2) ? true : S.next(ui + 1, nxt);
        const int Kn = has_next ? PG8_SEGK(nseg) : Kc; const size_t hstepN = (size_t)HALF * Kn * 2;
        unsigned voffAn, voffBn; PG8_VOFF(voffAn, voffBn, Kn);
        const char* nA = has_next ? PG8_SEGA(nseg) + (size_t)nxt.pm * 2 * hstepN : cA; const char* nB = has_next ? PG8_SEGB(nseg) + (size_t)nxt.pn * 2 * hstepN : cB;
#pragma unroll 1
        for (int t = 0; t < nt; t += 2) {
            const bool last = (t == nt - 2);
            const char* a1 = cA + (size_t)(t + 1) * kstep;
            const char* a2 = last ? nA : cA + (size_t)(t + 2) * kstep; const char* b2 = last ? nB : cB + (size_t)(t + 2) * kstep;
            const char* a3 = a2 + kstep; const char* b3 = b2 + kstep;
            const size_t hs2 = last ? hstepN : hstep;
            const unsigned vA2 = last ? voffAn : voffA, vB2 = last ? voffBn : voffB; const size_t q2 = hs2 >> 1;
            PG8_LDB(B0, 0, 0); PG8_LDB(B1, 0, 1); PG8_SCHED; PG8_LDA(At, 0, 0); PG8_STAGE(PG8_SA(1, 1), a1 + hstep, voffA, (hstep >> 1));
            PG8_WAIT_V(8); PG8_WAIT_L(0); PG8_BAR; PG8_MMA(0, 0, At, B0); PG8_MMA(0, 1, At, B1); PG8_BAR; PG8_SCHED;
            PG8_LDA(At, 0, 1); PG8_STAGE(PG8_SB(0, 0), b2, vB2, q2); PG8_STAGE(PG8_SB(0, 1), b2 + hs2, vB2, q2); PG8_STAGE(PG8_SA(0, 0), a2, vA2, q2);
            PG8_WAIT_V(8); PG8_WAIT_L(0); PG8_BAR; PG8_MMA(1, 0, At, B0); PG8_MMA(1, 1, At, B1); PG8_BAR; PG8_SCHED;
            PG8_LDB(B0, 1, 0); PG8_LDB(B1, 1, 1); PG8_SCHED; PG8_LDA(At, 1, 0); PG8_STAGE(PG8_SA(0, 1), a2 + hs2, vA2, q2);
            PG8_WAIT_V(8); PG8_WAIT_L(0); PG8_BAR; PG8_MMA(0, 0, At, B0); PG8_MMA(0, 1, At, B1); PG8_BAR; PG8_SCHED;
            PG8_LDA(At, 1, 1); PG8_STAGE(PG8_SB(1, 0), b3, vB2, q2); PG8_STAGE(PG8_SB(1, 1), b3 + hs2, vB2, q2); PG8_STAGE(PG8_SA(1, 0), a3, vA2, q2);
            PG8_WAIT_V(8); PG8_WAIT_L(0); PG8_BAR; PG8_MMA(1, 0, At, B0); PG8_MMA(1, 1, At, B1); PG8_BAR; PG8_SCHED;
        }
        if constexpr (ALIGN_EPI) { if (wr == 0) PG8_BAR; }
        E(acc, cur, seg, wr, wc, fr, fq);
        if (!has_next) break;
        if (seg == 2) {
#pragma unroll
        for (int a = 0; a < 2; ++a)
#pragma unroll
            for (int b = 0; b < 2; ++b)
#pragma unroll
                for (int m = 0; m < 4; ++m)
#pragma unroll
                    for (int n = 0; n < 2; ++n) acc[a][b][m][n] = (f32x4){0.f, 0.f, 0.f, 0.f};
        ++ui; }
        cur = nxt; cA = nA; cB = nB; seg = nseg; Kc = Kn; nt = Kc / BK; hstep = hstepN;
        voffA = voffAn; voffB = voffBn;
        if constexpr (ALIGN_EPI) { if (wr == 1) PG8_BAR; }
    }
    PG8_WAIT_V(0);
    if constexpr (!ALIGN_EPI) { if (wr == 0) PG8_BAR; }
    PG8_BAR;
#undef PG8_VOFF
#undef PG8_SEGK
#undef PG8_SEGA
#undef PG8_SEGB
#undef PG8_SA
#undef PG8_SB
#undef PG8_STAGE
#undef PG8_LDA
#undef PG8_LDB
#undef PG8_MMA
#undef PG8_WAIT_V
#undef PG8_WAIT_L
#undef PG8_BAR
#undef PG8_SCHED
}
}

typedef unsigned short bf16;
typedef float f32x4 __attribute__((ext_vector_type(4)));
typedef float f32x2 __attribute__((ext_vector_type(2)));
typedef unsigned u32x4 __attribute__((ext_vector_type(4)));
typedef unsigned u32x2 __attribute__((ext_vector_type(2)));
#define GAS __attribute__((address_space(1)))
#define LAS __attribute__((address_space(3)))

constexpr int BATCH = 16, SEQ = 4096, DM = 1024, MTOK = BATCH * SEQ, DEPTH = 4, DFF = 2816, PLE = 256, INW = 9664;
constexpr int O_CQ = 5888, O_CKV = 6272, O_CKR = 6528, O_G = 6592, O_B = 2304;
constexpr int N_IN1 = 3072, N_INB = 3584, N_ING = 3072, N_QB = 1280;
constexpr int P_QKVA = 2304, P_CLR = 768, CLR_KV = 384, CLR_KR = 640, P_QC = 1152, P_KVC = 1536, P_BIN = 3584, P_GS = 3072;
constexpr float EPS = 1e-6f, LOG2E = 1.4426950408889634f;
constexpr float QSCALE_A = 0.125f * LOG2E;
constexpr float QSCALE_C = 0.07216878364870322f * LOG2E;

constexpr size_t MiB = 1u << 20;
constexpr size_t WS_CTL = 0, CTL_ZERO_BYTES = 1 * MiB;
constexpr size_t WS_ROPEA = 1 * MiB, WS_ROPEC = 1 * MiB + 256 * 1024, WS_LB = 2 * MiB + 512 * 1024;
constexpr size_t WS_W = 4 * MiB;
constexpr size_t W_1U = 0, W_1D = 11 * MiB, W_IN1 = W_1D + 5632 * 1024, W_INB = 23 * MiB, W_ING = 30 * MiB, W_QB = 36 * MiB, W_KVB = 37 * MiB, W_A = 38 * MiB,
                 W_B = W_A + 512 * 1024, W_C = 40 * MiB, W_O = W_C + 1536 * 1024, W_2U = W_O + 2 * MiB, W_2D = W_2U + 11 * MiB, W_PG = 60 * MiB, W_PP = 62 * MiB;
static_assert(W_1U + (size_t)5632 * 1024 * 2 <= W_1D && W_1D + (size_t)1024 * 2816 * 2 <= W_IN1 && W_IN1 + (size_t)N_IN1 * 1024 * 2 <= W_INB && W_INB + (size_t)N_INB * 1024 * 2 <= W_ING &&
              W_ING + (size_t)N_ING * 1024 * 2 <= W_QB && W_QB + (size_t)N_QB * 384 * 2 <= W_KVB && W_KVB + (size_t)1536 * 256 * 2 <= W_A && W_A + 1024 * 256 * 2 <= W_B &&
              W_B + 1024 * 768 * 2 <= W_C && W_C + 1024 * 768 * 2 <= W_O && W_O + 1024 * 1024 * 2 <= W_2U && W_2U + (size_t)5632 * 1024 * 2 <= W_2D && W_2D + (size_t)1024 * 2816 * 2 <= W_PG &&
              W_PG + 1024 * 1024 * 2 <= W_PP && W_PP + 1024 * 256 * 2 <= 64 * MiB, "weight map");
constexpr size_t WS_XBE = 68 * MiB, WS_XBO = 196 * MiB, WS_XN = WS_XBE, WS_MG = 708 * MiB;
constexpr size_t WS_H = 324 * MiB, WS_QKVA = 196 * MiB, WS_CLR = 484 * MiB, WS_AOG = 612 * MiB, WS_LSE = 708 * MiB, WS_QC = 196 * MiB, WS_CO = 340 * MiB, WS_KVC = 744 * MiB,
                 WS_AOUT = 936 * MiB, WS_BIN = 484 * MiB, WS_BO = 196 * MiB, WS_GS = 484 * MiB, WS_PB = 936 * MiB, WS_PP = 708 * MiB, WS_SH = 292 * MiB, WS_SS0 = 968 * MiB, WS_SS1 = 972 * MiB, WS_END = 976 * MiB;
constexpr int CW_BAR = 4096;

constexpr int RING_BYTES = 131072, PHASE_LDS = 155648, LDSCTL_OFF = PHASE_LDS, MISC_OFF = LDSCTL_OFF + 320, LDS_BYTES = 163840;

#define RLX_AGENT __ATOMIC_RELAXED, __HIP_MEMORY_SCOPE_AGENT
#define LDS_WAIT() asm volatile("s_waitcnt lgkmcnt(0)" ::: "memory")
#define VM_WAIT() asm volatile("s_waitcnt vmcnt(0)" ::: "memory")
__device__ __forceinline__ unsigned f2bf(float f) { unsigned u = __builtin_bit_cast(unsigned, f); return (u + 0x7fffu + ((u >> 16) & 1u)) >> 16; }
__device__ __forceinline__ unsigned pk2(float lo, float hi) { return f2bf(lo) | (f2bf(hi) << 16); }
__device__ __forceinline__ float bflo(unsigned w) { return __builtin_bit_cast(float, w << 16); }
__device__ __forceinline__ float bfhi(unsigned w) { return __builtin_bit_cast(float, w & 0xffff0000u); }
__device__ __forceinline__ float bf2f(bf16 b) { return __builtin_bit_cast(float, (unsigned)b << 16); }
__device__ __forceinline__ float sigmoidf_(float x) { return __builtin_amdgcn_rcpf(1.f + __builtin_amdgcn_exp2f(-x * LOG2E)); }
__device__ __forceinline__ float wave_sum(float v) {
#pragma unroll
    for (int o = 1; o < 64; o <<= 1) v += __shfl_xor(v, o);
    return v;
}
__device__ __forceinline__ float wave_max(float v) {
#pragma unroll
    for (int o = 1; o < 64; o <<= 1) v = fmaxf(v, __shfl_xor(v, o));
    return v;
}

#define XB_TMO      128
#define XB_XCNT(j)  (256  + 64 * (j))
#define XB_XSUB(j)  (1280 + 64 * (j))
#define XB_XGEN(j)  (2304 + 64 * (j))
#define XB_TOP      3328
#define XB_TOPGEN   3392
#define XCD_BAR_WORDS 3456
#define XB_SPIN_CAP (1u << 25)
__device__ __forceinline__ unsigned xb_ld(unsigned* p)              { return __hip_atomic_load(p, __ATOMIC_RELAXED, __HIP_MEMORY_SCOPE_AGENT); }
__device__ __forceinline__ unsigned xb_add(unsigned* p, unsigned v) { return __hip_atomic_fetch_add(p, v, __ATOMIC_RELAXED, __HIP_MEMORY_SCOPE_AGENT); }
__device__ __forceinline__ unsigned xb_xcc_id() { return (unsigned)__builtin_amdgcn_s_getreg((3 << 11) | 20) & 0xFu; }
#define XB_SPIN(cond, bar) do { unsigned _sp = 0; while (cond) { __builtin_amdgcn_s_sleep(1); \
    if ((++_sp & 255u) == 0u) { if (xb_ld(&(bar)[XB_TMO])) break; if (_sp > XB_SPIN_CAP) { atomicAdd(&(bar)[XB_TMO], 1u); break; } } } } while (0)
struct XcdBarrier { unsigned* bar; unsigned x; volatile LAS unsigned* st; };
__device__ __forceinline__ XcdBarrier xcd_barrier_post(unsigned* bar, volatile LAS unsigned* st) {
    XcdBarrier b; b.bar = bar; b.x = xb_xcc_id(); b.st = st;
    if (threadIdx.x == 0) (void)xb_add(&bar[XB_XCNT(b.x)], 1u);
    return b;
}
__device__ __forceinline__ void xcd_barrier_complete(unsigned* bar, unsigned x, unsigned& nloc, unsigned& nx) {
    const unsigned G = gridDim.x * gridDim.y * gridDim.z;
    unsigned sum, cnt, mine, sp = 0u;
    for (;;) {
        sum = 0u; cnt = 0u; mine = 0u;
#pragma unroll
        for (unsigned j = 0; j < 16; ++j) { const unsigned c = xb_ld(&bar[XB_XCNT(j)]); sum += c; cnt += (c > 0u) ? 1u : 0u; mine = (j == x) ? c : mine; }
        if (sum == G) break;
        __builtin_amdgcn_s_sleep(1);
        if ((++sp & 255u) == 0u) { if (xb_ld(&bar[XB_TMO])) break; if (sp > XB_SPIN_CAP) { atomicAdd(&bar[XB_TMO], 1u); break; } }
    }
    nloc = mine > 0u ? mine : 1u; nx = cnt > 0u ? cnt : 1u;
}
__device__ __forceinline__ void xcd_barrier(const XcdBarrier& b, const bool leader) {
    asm volatile("s_waitcnt vmcnt(0)" ::: "memory");
    __syncthreads();
    if (leader) {
        unsigned* bar = b.bar;
        __builtin_amdgcn_s_waitcnt(0);
        unsigned nloc = b.st[0], nx = b.st[1];
        if (nloc == 0u) { xcd_barrier_complete(bar, b.x, nloc, nx); b.st[0] = nloc; b.st[1] = nx; }
        const unsigned old = xb_add(&bar[XB_XSUB(b.x)], 1u);
        const unsigned gen = old / nloc;
        if (old + 1u == (gen + 1u) * nloc) {
            __builtin_amdgcn_fence(__ATOMIC_RELEASE, "agent");
            asm volatile("s_waitcnt vmcnt(0)" ::: "memory");
            const unsigned og = xb_add(&bar[XB_TOP], 1u);
            const unsigned tg = og / nx;
            if (og + 1u == (tg + 1u) * nx) xb_add(&bar[XB_TOPGEN], 1u);
            else XB_SPIN(xb_ld(&bar[XB_TOPGEN]) == tg, bar);
            __builtin_amdgcn_fence(__ATOMIC_ACQUIRE, "agent");
            xb_add(&bar[XB_XGEN(b.x)], 1u);
            asm volatile("s_waitcnt vmcnt(0)" ::: "memory");
        } else {
            XB_SPIN(xb_ld(&bar[XB_XGEN(b.x)]) == gen, bar);
            __builtin_amdgcn_fence(__ATOMIC_ACQUIRE, "agent");
            asm volatile("s_waitcnt vmcnt(0)" ::: "memory");
        }
    }
    __syncthreads();
}

using pg8::Unit;
constexpr int RS_OFF = RING_BYTES, RS_SLOTS = 6;
struct RsTab { const LAS float* tab; int g0; };
__device__ __forceinline__ float rs_get(const RsTab& T, int row) { return T.tab[(((row >> 11) - T.g0) << 8) + (row & 255)]; }
__device__ __forceinline__ float row_rstd(const float* SS, int row) {
    const f32x4* p = (const f32x4*)(SS + (size_t)row * 16); const f32x4 a = p[0], b = p[1], c = p[2], d = p[3];
    const float s = (((a[0] + a[1]) + (a[2] + a[3])) + ((b[0] + b[1]) + (b[2] + b[3]))) + (((c[0] + c[1]) + (c[2] + c[3])) + ((d[0] + d[1]) + (d[2] + d[3])));
    return 1.f / sqrtf(s * (1.f / DM) + EPS);
}
struct EpiSwiglu {
    static constexpr bool PERM = true; static constexpr bool ADJ = false;
    bf16* H; RsTab SS;
    __device__ __forceinline__ void operator()(const f32x4 (&acc)[2][2][4][2], const Unit& u, int wr, int wc, int fr, int fq) const {
        const int row0 = u.pm * 256 + wr * 64 + fr, col0 = u.pn * 128 + wc * 32 + 8 * fq;
#pragma unroll
        for (int ai = 0; ai < 2; ++ai)
#pragma unroll
            for (int m = 0; m < 4; ++m) { const int row = row0 + ai * 128 + m * 16; const float rs = rs_get(SS, row);
                float h[8];
#pragma unroll
                for (int n = 0; n < 2; ++n)
#pragma unroll
                    for (int j = 0; j < 4; ++j) { const float g = acc[ai][0][m][n][j] * rs, uu = acc[ai][1][m][n][j] * rs; h[4 * n + j] = g * sigmoidf_(g) * uu; }
                u32x4 w; w.x = pg8::cvt_pk_bf16(h[0], h[1]); w.y = pg8::cvt_pk_bf16(h[2], h[3]); w.z = pg8::cvt_pk_bf16(h[4], h[5]); w.w = pg8::cvt_pk_bf16(h[6], h[7]);
                *(u32x4*)(H + (size_t)row * DFF + col0) = w; }
    }
};
struct EpiResid {
    static constexpr bool PERM = true; static constexpr bool ADJ = false;
    static constexpr int LA = 4;
    const bf16* XI; bf16* XO; float scale; float* SSo;
    __device__ __forceinline__ void operator()(const f32x4 (&acc)[2][2][4][2], const Unit& u, int wr, int wc, int fr, int fq) const {
        const unsigned row0 = u.pm * 256 + wr * 64 + fr, col0 = u.pn * 256 + wc * 32 + 8 * fq;
        float sc = scale; asm volatile("" : "+v"(sc));
        u32x4 xi[8][2];
#pragma unroll
        for (int it = 0; it < 8 + LA; ++it) {
            if (it < 8) { const unsigned off = (row0 + (it >> 2) * 128 + (it & 3) * 16) * (unsigned)DM + col0;
#pragma unroll
                for (int bj = 0; bj < 2; ++bj) xi[it][bj] = *(const u32x4*)(XI + off + bj * 128); }
            if (it >= LA) { const int r = it - LA; const unsigned row = row0 + (r >> 2) * 128 + (r & 3) * 16; float ssq = 0.f;
#pragma unroll
                for (int bj = 0; bj < 2; ++bj) { const unsigned off = row * (unsigned)DM + col0 + bj * 128; const u32x4 w = xi[r][bj]; const f32x4 a0 = acc[r >> 2][bj][r & 3][0], a1 = acc[r >> 2][bj][r & 3][1];
                    f32x4 x0, x1;
                    x0[0] = pg8::f16lo(w.x) + a0[0] * sc; x0[1] = pg8::f16hi(w.x) + a0[1] * sc; x0[2] = pg8::f16lo(w.y) + a0[2] * sc; x0[3] = pg8::f16hi(w.y) + a0[3] * sc;
                    x1[0] = pg8::f16lo(w.z) + a1[0] * sc; x1[1] = pg8::f16hi(w.z) + a1[1] * sc; x1[2] = pg8::f16lo(w.w) + a1[2] * sc; x1[3] = pg8::f16hi(w.w) + a1[3] * sc;
                    ssq += ((x0[0] * x0[0] + x0[1] * x0[1]) + (x0[2] * x0[2] + x0[3] * x0[3])) + ((x1[0] * x1[0] + x1[1] * x1[1]) + (x1[2] * x1[2] + x1[3] * x1[3]));
                    u32x4 o; o.x = pg8::cvt_pk_f16(x0[0], x0[1]); o.y = pg8::cvt_pk_f16(x0[2], x0[3]); o.z = pg8::cvt_pk_f16(x1[0], x1[1]); o.w = pg8::cvt_pk_f16(x1[2], x1[3]);
                    *(u32x4*)(XO + off) = o; }
                ssq += __shfl_xor(ssq, 16); ssq += __shfl_xor(ssq, 32);
                if (fq == 0) SSo[row * 16u + u.pn * 4 + wc] = ssq; }
        }
    }
};
template <int ACT, bool NORM> struct EpiBf16 {
    static constexpr bool PERM = true; static constexpr bool ADJ = true;
    bf16* O; int ldc; RsTab SS;
    __device__ __forceinline__ void operator()(const f32x4 (&acc)[2][2][4][2], const Unit& u, int wr, int wc, int fr, int fq) const {
        const int rbase = u.pm * 256 + wr * 64, colb = u.pn * 256 + wc * 64 + 8 * fq; const bool lo = fr < 8;
#pragma unroll
        for (int ai = 0; ai < 2; ++ai)
#pragma unroll
            for (int m = 0; m < 4; ++m) { const int rg = rbase + ai * 128 + m * 16; float rs = 1.f; if (NORM) rs = rs_get(SS, rg + fr);
                u32x4 w[2];
#pragma unroll
                for (int bj = 0; bj < 2; ++bj) { f32x4 v0 = acc[ai][bj][m][0], v1 = acc[ai][bj][m][1];
                    if (NORM) { v0 = v0 * rs; v1 = v1 * rs; }
                    if (ACT == 1) {
#pragma unroll
                        for (int j = 0; j < 4; ++j) { v0[j] = sigmoidf_(v0[j]); v1[j] = sigmoidf_(v1[j]); } }
                    w[bj].x = pg8::cvt_pk_bf16(v0[0], v0[1]); w[bj].y = pg8::cvt_pk_bf16(v0[2], v0[3]); w[bj].z = pg8::cvt_pk_bf16(v1[0], v1[1]); w[bj].w = pg8::cvt_pk_bf16(v1[2], v1[3]); }
                u32x4 give = lo ? w[1] : w[0], got;
                got.x = (unsigned)__shfl_xor((int)give.x, 8); got.y = (unsigned)__shfl_xor((int)give.y, 8); got.z = (unsigned)__shfl_xor((int)give.z, 8); got.w = (unsigned)__shfl_xor((int)give.w, 8);
                bf16* pa = O + (size_t)(rg + (fr & 7)) * ldc + colb + (lo ? 0 : 32);
                *(u32x4*)pa = lo ? w[0] : got;
                *(u32x4*)(pa + (size_t)8 * ldc) = lo ? got : w[1]; }
    }
};
struct EpiGate8 {
    static constexpr bool PERM = true; static constexpr bool ADJ = false;
    unsigned char* G8; RsTab SS;
    __device__ __forceinline__ void operator()(const f32x4 (&acc)[2][2][4][2], const Unit& u, int wr, int wc, int fr, int fq) const {
        const int row0 = u.pm * 256 + wr * 64 + fr, col0 = u.pn * 256 + wc * 32 + 8 * fq;
#pragma unroll
        for (int ai = 0; ai < 2; ++ai)
#pragma unroll
            for (int m = 0; m < 4; ++m) { const int row = row0 + ai * 128 + m * 16; unsigned char* rowp = G8 + (size_t)row * P_GS + col0; const float rs = rs_get(SS, row);
#pragma unroll
                for (int bj = 0; bj < 2; ++bj) { const f32x4 v0 = acc[ai][bj][m][0] * rs, v1 = acc[ai][bj][m][1] * rs;
                    unsigned b[8];
#pragma unroll
                    for (int j = 0; j < 4; ++j) { b[j] = max((unsigned)(sigmoidf_(v0[j]) * 255.f + 0.5f), 1u); b[4 + j] = max((unsigned)(sigmoidf_(v1[j]) * 255.f + 0.5f), 1u); }
                    u32x2 w; w.x = b[0] | (b[1] << 8) | (b[2] << 16) | (b[3] << 24); w.y = b[4] | (b[5] << 8) | (b[6] << 16) | (b[7] << 24);
                    *(u32x2*)(rowp + bj * 128) = w; } }
    }
};
__device__ __forceinline__ void rope4(f32x4& v, const f32x4 cs) {
    const float a0 = v[0] * cs[0] - v[1] * cs[1], b0 = v[1] * cs[0] + v[0] * cs[1], a1 = v[2] * cs[2] - v[3] * cs[3], b1 = v[3] * cs[2] + v[2] * cs[3];
    v[0] = a0; v[1] = b0; v[2] = a1; v[3] = b1;
}
struct EpiIn1 {
    static constexpr bool PERM = true; static constexpr bool ADJ = false;
    bf16* QKVA; bf16* CLR; const float* ropeA; const float* ropeC; RsTab SS;
    __device__ __forceinline__ void operator()(const f32x4 (&acc)[2][2][4][2], const Unit& u, int wr, int wc, int fr, int fq) const {
        const int row0 = u.pm * 256 + wr * 64 + fr;
        const bool isA = u.pn < 9;
        bf16* base = isA ? QKVA : CLR; const int ldc = isA ? P_QKVA : P_CLR; const int colt = isA ? u.pn * 256 : (u.pn - 9) * 256;
        const int col0 = colt + wc * 32 + 8 * fq;
        const bool ropeq = (u.pn < 6) && ((wc & 1) == 0) && (fq < 2);
        const bool ropek = (u.pn == 11) && (wc < 2);
        const float qs = (u.pn < 3) ? QSCALE_A : 1.f;
        f32x4 cs[8][2];
        if (ropeq || ropek) { const float* rp = ropeq ? ropeA + 8 * fq : ropeC + 32 * wc + 8 * fq; const int rstride = ropeq ? 16 : 64;
#pragma unroll
            for (int r = 0; r < 8; ++r) { const int pos = (row0 + (r >> 2) * 128 + (r & 3) * 16) & (SEQ - 1); cs[r][0] = *(const f32x4*)(rp + pos * rstride); cs[r][1] = *(const f32x4*)(rp + pos * rstride + 4); } }
        else {
#pragma unroll
            for (int r = 0; r < 8; ++r) { cs[r][0] = (f32x4){1.f, 0.f, 1.f, 0.f}; cs[r][1] = (f32x4){1.f, 0.f, 1.f, 0.f}; } }
#pragma unroll
        for (int ai = 0; ai < 2; ++ai)
#pragma unroll
            for (int m = 0; m < 4; ++m) { const int row = row0 + ai * 128 + m * 16; bf16* rowp = base + (size_t)row * ldc + col0; const float rs = rs_get(SS, row);
#pragma unroll
                for (int bj = 0; bj < 2; ++bj) { f32x4 v0 = acc[ai][bj][m][0] * rs, v1 = acc[ai][bj][m][1] * rs;
                    if (ropeq || (ropek && bj == 1)) { rope4(v0, cs[ai * 4 + m][0]); rope4(v1, cs[ai * 4 + m][1]); }
                    v0 = v0 * qs; v1 = v1 * qs;
                    u32x4 w; w.x = pg8::cvt_pk_bf16(v0[0], v0[1]); w.y = pg8::cvt_pk_bf16(v0[2], v0[3]); w.z = pg8::cvt_pk_bf16(v1[0], v1[1]); w.w = pg8::cvt_pk_bf16(v1[2], v1[3]);
                    *(u32x4*)(rowp + bj * 128) = w; } }
    }
};
struct EpiQC {
    static constexpr bool PERM = true; static constexpr bool ADJ = false;
    bf16* QC; const float* ropeC;
    __device__ __forceinline__ void operator()(const f32x4 (&acc)[2][2][4][2], const Unit& u, int wr, int wc, int fr, int fq) const {
        const int row0 = u.pm * 256 + wr * 64 + fr;
#pragma unroll
        for (int bj = 0; bj < 2; ++bj) { const int cu = u.pn * 256 + bj * 128 + wc * 32;
            if (cu >= P_QC) continue;
            const int col0 = cu + 8 * fq; const int ub = cu % 192; const bool rp = ub >= 128; const int d0 = ub + 8 * fq;
            f32x4 cs[8][2];
            if (rp) {
#pragma unroll
                for (int r = 0; r < 8; ++r) { const int pos = (row0 + (r >> 2) * 128 + (r & 3) * 16) & (SEQ - 1); cs[r][0] = *(const f32x4*)(ropeC + pos * 64 + (d0 - 128)); cs[r][1] = *(const f32x4*)(ropeC + pos * 64 + (d0 - 128) + 4); } }
            else {
#pragma unroll
                for (int r = 0; r < 8; ++r) { cs[r][0] = (f32x4){1.f, 0.f, 1.f, 0.f}; cs[r][1] = (f32x4){1.f, 0.f, 1.f, 0.f}; } }
#pragma unroll
            for (int ai = 0; ai < 2; ++ai)
#pragma unroll
                for (int m = 0; m < 4; ++m) { const int row = row0 + ai * 128 + m * 16;
                    f32x4 v0 = acc[ai][bj][m][0], v1 = acc[ai][bj][m][1];
                    if (rp) { rope4(v0, cs[ai * 4 + m][0]); rope4(v1, cs[ai * 4 + m][1]); }
                    v0 = v0 * QSCALE_C; v1 = v1 * QSCALE_C;
                    u32x4 w; w.x = pg8::cvt_pk_bf16(v0[0], v0[1]); w.y = pg8::cvt_pk_bf16(v0[2], v0[3]); w.z = pg8::cvt_pk_bf16(v1[0], v1[1]); w.w = pg8::cvt_pk_bf16(v1[2], v1[3]);
                    *(u32x4*)(QC + (size_t)row * P_QC + col0) = w; } }
    }
};
template <bool FIRST> struct EpiMerge {
    static constexpr bool PERM = true; static constexpr bool ADJ = false;
    static constexpr int LA = 4;
    bf16* MG; const unsigned char* GS; int goff;
    __device__ __forceinline__ void operator()(const f32x4 (&acc)[2][2][4][2], const Unit& u, int wr, int wc, int fr, int fq) const {
        const unsigned row0 = u.pm * 256 + wr * 64 + fr, col0 = u.pn * 256 + wc * 32 + 8 * fq;
        u32x2 gi[8][2]; u32x4 oi[8][2];
#pragma unroll
        for (int it = 0; it < 8 + LA; ++it) {
            if (it >= LA) { const int r = it - LA;
#pragma unroll
                for (int bj = 0; bj < 2; ++bj) { const u32x2 gw = gi[r][bj]; const u32x4 ow = oi[r][bj]; const f32x4 v0 = acc[r >> 2][bj][r & 3][0], v1 = acc[r >> 2][bj][r & 3][1]; float g[8], q[8];
#pragma unroll
                    for (int jj = 0; jj < 4; ++jj) { g[jj] = (float)((gw.x >> (8 * jj)) & 255u) * (1.f / 255.f); g[4 + jj] = (float)((gw.y >> (8 * jj)) & 255u) * (1.f / 255.f); }
                    q[0] = bflo(ow.x) + g[0] * v0[0]; q[1] = bfhi(ow.x) + g[1] * v0[1]; q[2] = bflo(ow.y) + g[2] * v0[2]; q[3] = bfhi(ow.y) + g[3] * v0[3];
                    q[4] = bflo(ow.z) + g[4] * v1[0]; q[5] = bfhi(ow.z) + g[5] * v1[1]; q[6] = bflo(ow.w) + g[6] * v1[2]; q[7] = bfhi(ow.w) + g[7] * v1[3];
                    u32x4 w; w.x = pg8::cvt_pk_bf16(q[0], q[1]); w.y = pg8::cvt_pk_bf16(q[2], q[3]); w.z = pg8::cvt_pk_bf16(q[4], q[5]); w.w = pg8::cvt_pk_bf16(q[6], q[7]); oi[r][bj] = w; } }
            if (it < 8) { const unsigned row = row0 + (it >> 2) * 128 + (it & 3) * 16;
#pragma unroll
                for (int bj = 0; bj < 2; ++bj) { gi[it][bj] = *(const u32x2*)(GS + row * (unsigned)P_GS + goff + col0 + bj * 128); oi[it][bj] = (u32x4){0u, 0u, 0u, 0u}; if (!FIRST) oi[it][bj] = *(const u32x4*)(MG + row * (unsigned)DM + col0 + bj * 128); } }
            if (it >= LA) { const int r = it - LA; const unsigned row = row0 + (r >> 2) * 128 + (r & 3) * 16;
#pragma unroll
                for (int bj = 0; bj < 2; ++bj) *(u32x4*)(MG + row * (unsigned)DM + col0 + bj * 128) = oi[r][bj]; }
        }
    }
};
struct EpiMerge3 {
    static constexpr bool PERM = true; static constexpr bool ADJ = false;
    bf16* MG; const unsigned char* GS;
    __device__ __forceinline__ void operator()(f32x4 (&acc)[2][2][4][2], const Unit& u, int seg, int wr, int wc, int fr, int fq) const {
        const unsigned row0 = u.pm * 256 + wr * 64 + fr, col0 = u.pn * 256 + wc * 32 + 8 * fq;
        if (seg < 2) { const unsigned go = (unsigned)seg * 1024u + col0;
#pragma unroll
            for (int r = 0; r < 8; ++r) { const unsigned row = row0 + (r >> 2) * 128 + (r & 3) * 16;
#pragma unroll
                for (int bj = 0; bj < 2; ++bj) { const u32x2 ga = *(const u32x2*)(GS + row * (unsigned)P_GS + go + bj * 128), gb = *(const u32x2*)(GS + row * (unsigned)P_GS + go + 1024 + bj * 128);
#pragma unroll
                    for (int jj = 0; jj < 4; ++jj) {
                        acc[r >> 2][bj][r & 3][0][jj] *= (float)((ga.x >> (8 * jj)) & 255u) * __builtin_amdgcn_rcpf((float)((gb.x >> (8 * jj)) & 255u));
                        acc[r >> 2][bj][r & 3][1][jj] *= (float)((ga.y >> (8 * jj)) & 255u) * __builtin_amdgcn_rcpf((float)((gb.y >> (8 * jj)) & 255u)); } } }
        } else {
#pragma unroll
            for (int r = 0; r < 8; ++r) { const unsigned row = row0 + (r >> 2) * 128 + (r & 3) * 16;
#pragma unroll
                for (int bj = 0; bj < 2; ++bj) { const u32x2 gw = *(const u32x2*)(GS + row * (unsigned)P_GS + 2048 + col0 + bj * 128); const f32x4 v0 = acc[r >> 2][bj][r & 3][0], v1 = acc[r >> 2][bj][r & 3][1]; float q[8];
#pragma unroll
                    for (int jj = 0; jj < 4; ++jj) { q[jj] = v0[jj] * ((float)((gw.x >> (8 * jj)) & 255u) * (1.f / 255.f)); q[4 + jj] = v1[jj] * ((float)((gw.y >> (8 * jj)) & 255u) * (1.f / 255.f)); }
                    u32x4 w; w.x = pg8::cvt_pk_bf16(q[0], q[1]); w.y = pg8::cvt_pk_bf16(q[2], q[3]); w.z = pg8::cvt_pk_bf16(q[4], q[5]); w.w = pg8::cvt_pk_bf16(q[6], q[7]);
                    *(u32x4*)(MG + row * (unsigned)DM + col0 + bj * 128) = w; } }
        }
    }
};
struct EpiPle {
    static constexpr bool PERM = true; static constexpr bool ADJ = false;
    static constexpr int LA = 3;
    const bf16* XI; const bf16* PP; RsTab SS; bf16* XO; float* SSo;
    __device__ __forceinline__ void operator()(const f32x4 (&acc)[2][2][4][2], const Unit& u, int wr, int wc, int fr, int fq) const {
        const unsigned row0 = u.pm * 256 + wr * 64 + fr, col0 = u.pn * 256 + wc * 32 + 8 * fq;
        u32x4 xi[8][2], pi[8][2];
#pragma unroll
        for (int it = 0; it < 8 + LA; ++it) {
            if (it < 8) { const unsigned off = (row0 + (it >> 2) * 128 + (it & 3) * 16) * (unsigned)DM + col0;
#pragma unroll
                for (int bj = 0; bj < 2; ++bj) { pi[it][bj] = *(const u32x4*)(PP + off + bj * 128); xi[it][bj] = *(const u32x4*)(XI + off + bj * 128); } }
            if (it >= LA) { const int r = it - LA; const unsigned row = row0 + (r >> 2) * 128 + (r & 3) * 16; const float rs = rs_get(SS, (int)row); float ssq = 0.f;
#pragma unroll
                for (int bj = 0; bj < 2; ++bj) { const unsigned off = row * (unsigned)DM + col0 + bj * 128; const u32x4 pw = pi[r][bj], w = xi[r][bj];
                    const f32x4 v0 = acc[r >> 2][bj][r & 3][0] * rs, v1 = acc[r >> 2][bj][r & 3][1] * rs; f32x4 x0, x1;
                    x0[0] = pg8::f16lo(w.x) + sigmoidf_(v0[0]) * bflo(pw.x); x0[1] = pg8::f16hi(w.x) + sigmoidf_(v0[1]) * bfhi(pw.x); x0[2] = pg8::f16lo(w.y) + sigmoidf_(v0[2]) * bflo(pw.y); x0[3] = pg8::f16hi(w.y) + sigmoidf_(v0[3]) * bfhi(pw.y);
                    x1[0] = pg8::f16lo(w.z) + sigmoidf_(v1[0]) * bflo(pw.z); x1[1] = pg8::f16hi(w.z) + sigmoidf_(v1[1]) * bfhi(pw.z); x1[2] = pg8::f16lo(w.w) + sigmoidf_(v1[2]) * bflo(pw.w); x1[3] = pg8::f16hi(w.w) + sigmoidf_(v1[3]) * bfhi(pw.w);
                    ssq += ((x0[0] * x0[0] + x0[1] * x0[1]) + (x0[2] * x0[2] + x0[3] * x0[3])) + ((x1[0] * x1[0] + x1[1] * x1[1]) + (x1[2] * x1[2] + x1[3] * x1[3]));
                    u32x4 o; o.x = pg8::cvt_pk_f16(x0[0], x0[1]); o.y = pg8::cvt_pk_f16(x0[2], x0[3]); o.z = pg8::cvt_pk_f16(x1[0], x1[1]); o.w = pg8::cvt_pk_f16(x1[2], x1[3]);
                    *(u32x4*)(XO + off) = o; }
                ssq += __shfl_xor(ssq, 16); ssq += __shfl_xor(ssq, 32);
                if (fq == 0) SSo[row * 16u + u.pn * 4 + wc] = ssq; }
        }
    }
};

template <int MAP> __device__ __forceinline__ int wmap(int n) {
    if (MAP == 0) return n;
    if (MAP == 1) { const int t = n >> 8, c = n & 255; return (c < 128) ? 128 * t + c : DFF + 128 * t + (c - 128); }
    if (MAP == 2) {
        if (n < 2304) { const int p = n & 63; if (n < 1536 && p < 16) return (n - p) + (p >> 1) + 8 * (p & 1); return n; }
        if (n < 2688) return O_CQ + (n - 2304);
        if (n < 2944) return O_CKV + (n - 2688);
        if (n < 3008) { const int p = n - 2944; return O_CKR + (p >> 1) + 32 * (p & 1); }
        return -1; }
    if (MAP == 3) return O_B + n;
    if (MAP == 4) return O_G + n;
    if (MAP == 5) { if (n >= 1152) return -1; const int h = n / 192, d = n % 192; if (d < 128) return n; const int p = d - 128; return 192 * h + 128 + (p >> 1) + 32 * (p & 1); }
    return n;
}
template <int MAP, bool F16 = false> __device__ __forceinline__ void wt_item(const float* W, int K, int Nsrc, int Ndst, bf16* WT, LAS float* scr, int item, int lane, const float* gain = nullptr) {
    const int nblk = Ndst / 32, kb = item / nblk, nb = item % nblk, k0 = 64 * kb, n0 = 32 * nb;
    const int sc = wmap<MAP>(n0 + (lane & 31));
#pragma unroll 8
    for (int i = 0; i < 32; ++i) { const int kk = 2 * i + (lane >> 5); const float gk = gain ? gain[k0 + kk] : 1.f; scr[kk * 33 + (lane & 31)] = (sc >= 0) ? W[(size_t)(k0 + kk) * Nsrc + sc] * gk : 0.f; }
    LDS_WAIT(); asm volatile("" ::: "memory");
    const int c = lane & 7;
#pragma unroll
    for (int j = 0; j < 4; ++j) { const int n = (lane >> 3) + 8 * j; const LAS float* s = scr + (8 * c) * 33 + n;
        u32x4 o;
        if (F16) { o.x = pg8::cvt_pk_f16(s[0 * 33], s[1 * 33]); o.y = pg8::cvt_pk_f16(s[2 * 33], s[3 * 33]); o.z = pg8::cvt_pk_f16(s[4 * 33], s[5 * 33]); o.w = pg8::cvt_pk_f16(s[6 * 33], s[7 * 33]); }
        else { o.x = pk2(s[0 * 33], s[1 * 33]); o.y = pk2(s[2 * 33], s[3 * 33]); o.z = pk2(s[4 * 33], s[5 * 33]); o.w = pk2(s[6 * 33], s[7 * 33]); }
        *(GAS u32x4*)(WT + (size_t)(n0 + n) * K + k0 + 8 * c) = o; }
    LDS_WAIT(); asm volatile("" ::: "memory");
}

__device__ __forceinline__ void rms_row_to_bf16(const float* xrow, const float* gain, bf16* orow, int lane) {
    const GAS f32x4* xr = (const GAS f32x4*)xrow + lane; const GAS f32x4* gr = (const GAS f32x4*)gain + lane;
    f32x4 v[4]; float s = 0.f;
#pragma unroll
    for (int j = 0; j < 4; ++j) { v[j] = xr[64 * j]; s += (v[j].x * v[j].x + v[j].y * v[j].y) + (v[j].z * v[j].z + v[j].w * v[j].w); }
    const float rstd = 1.f / sqrtf(wave_sum(s) * (1.f / DM) + EPS);
    GAS unsigned long long* o8 = (GAS unsigned long long*)orow + lane;
#pragma unroll
    for (int j = 0; j < 4; ++j) { const f32x4 g = gr[64 * j]; o8[64 * j] = (unsigned long long)pk2(v[j].x * rstd * g.x, v[j].y * rstd * g.y) | ((unsigned long long)pk2(v[j].z * rstd * g.z, v[j].w * rstd * g.w) << 32); }
}


typedef short s16x4 __attribute__((ext_vector_type(4)));
typedef short bf16x8 __attribute__((ext_vector_type(8)));
typedef float f32x16 __attribute__((ext_vector_type(16)));
__device__ __forceinline__ s16x4 vtr(const LAS unsigned char* p) { return __builtin_amdgcn_ds_read_tr16_b64_v4i16((LAS s16x4*)p); }
__device__ __forceinline__ int crow(int reg, int hf) { return (reg & 3) + 8 * (reg >> 2) + 4 * hf; }
__device__ __forceinline__ bf16x8 pack8(const f32x16& s, int o) {
    u32x4 w; w.x = pg8::cvt_pk_bf16(s[o], s[o + 1]); w.y = pg8::cvt_pk_bf16(s[o + 2], s[o + 3]); w.z = pg8::cvt_pk_bf16(s[o + 4], s[o + 5]); w.w = pg8::cvt_pk_bf16(s[o + 6], s[o + 7]); return __builtin_bit_cast(bf16x8, w);
}
#define MFMA32(a, b, c) __builtin_amdgcn_mfma_f32_32x32x16_bf16((a), (b), (c), 0, 0, 0)

__device__ __forceinline__ void mla_phase(LAS unsigned char* lds, const bf16* QC, const bf16* KVC, const bf16* CLR, bf16* CO, int vcu, int G, int tid, int lane, int wave) {
    constexpr int KP = 400, VP = 320, KB = 64 * KP, VB = 64 * VP; constexpr float MLA_THR = 8.f;
    LAS unsigned char* Kl = lds; LAS unsigned char* Vl = lds + 2 * KB;
    static_assert(2 * KB + 3 * VB <= PHASE_LDS, "mla LDS map");
    const int r = lane & 31, hf = lane >> 5; const bool trail = wave >= 4;
#define MLA_OFFS int t_o = tid; asm volatile("" : "+v"(t_o)); const int srow = t_o >> 4, sch = t_o & 15, prow = t_o >> 3, pch = t_o & 7; \
    const int noff = srow * P_KVC + sch * 8, poff = prow * P_CLR + pch * 8, kd0 = srow * KP + sch * 16, vd0 = srow * VP + sch * 16, pd0 = prow * KP + 256 + pch * 16; (void)noff; (void)poff; (void)kd0; (void)vd0; (void)pd0;
    for (int pi = vcu; pi < 768; pi += G) {
        const int bh = pi >> 3, sft = pi & 7, b = bh / 6, h = bh - 6 * b; const size_t rb = (size_t)b * SEQ;
        const bf16* kvb = KVC + rb * P_KVC + h * 256; const bf16* clb = CLR + rb * P_CLR + CLR_KR;
        for (int half = 0; half < 2; ++half) {
            const int qb = half ? 15 - sft : sft, q0w = qb * 256 + wave * 32, NT = 4 * (qb + 1);
            bf16x8 qf[12];
            { const bf16* qp = QC + (rb + q0w + r) * P_QC + h * 192 + 8 * hf;
#pragma unroll
              for (int s = 0; s < 12; ++s) qf[s] = *(const bf16x8*)(qp + 16 * s); }
            float m_ref = 0.f, l_run = 0.f; f32x16 OT[4];
            const bf16x8 kone = __builtin_bit_cast(bf16x8, (u32x4){hf == 0 ? 0x3F80u : 0u, 0u, 0u, 0u}); bf16x8 qm = __builtin_bit_cast(bf16x8, (u32x4){0u, 0u, 0u, 0u});
#pragma unroll
            for (int d = 0; d < 4; ++d)
#pragma unroll
                for (int e = 0; e < 16; ++e) OT[d][e] = 0.f;
            u32x4 kr[3], vr[2];
            bf16x8 p00, p01, p10, p11; bool pact = false;
#pragma unroll
            for (int e = 0; e < 8; ++e) { p00[e] = 0; p01[e] = 0; p10[e] = 0; p11[e] = 0; }
#define MLA_LOAD(t) do { MLA_OFFS const bf16* kt_ = kvb + (size_t)(t) * (64 * P_KVC) + noff; kr[0] = *(const u32x4*)(kt_); kr[1] = *(const u32x4*)(kt_ + 32 * P_KVC); vr[0] = *(const u32x4*)(kt_ + 128); vr[1] = *(const u32x4*)(kt_ + 32 * P_KVC + 128); \
                         kr[2] = *(const u32x4*)(clb + (size_t)(t) * (64 * P_CLR) + poff); } while (0)
#define MLA_STORE(kb_, vb_) do { MLA_OFFS *(LAS u32x4*)(Kl + (kb_) * KB + kd0) = kr[0]; *(LAS u32x4*)(Kl + (kb_) * KB + kd0 + 32 * KP) = kr[1]; *(LAS u32x4*)(Kl + (kb_) * KB + pd0) = kr[2]; \
                          *(LAS u32x4*)(Vl + (vb_) * VB + vd0) = vr[0]; *(LAS u32x4*)(Vl + (vb_) * VB + vd0 + 32 * VP) = vr[1]; } while (0)
#define MLA_PV(Vbuf) do { const LAS unsigned char* vp = (Vbuf) + (((lane & 15) >> 2) + 4 * hf) * VP + (16 * ((lane >> 4) & 1) + 4 * (lane & 3)) * 2; \
                _Pragma("unroll") for (int h_ = 0; h_ < 8; ++h_) { s16x4 vl_[2], vh_[2]; \
                    _Pragma("unroll") for (int q2 = 0; q2 < 2; ++q2) { vl_[q2] = vtr(vp + (16 * (2 * (h_ & 1) + q2)) * VP + 64 * (h_ >> 1)); vh_[q2] = vtr(vp + (16 * (2 * (h_ & 1) + q2) + 8) * VP + 64 * (h_ >> 1)); } \
                    const bf16x8 f0_ = {vl_[0][0], vl_[0][1], vl_[0][2], vl_[0][3], vh_[0][0], vh_[0][1], vh_[0][2], vh_[0][3]}, f1_ = {vl_[1][0], vl_[1][1], vl_[1][2], vl_[1][3], vh_[1][0], vh_[1][1], vh_[1][2], vh_[1][3]}; \
                    if (h_ & 1) { OT[h_ >> 1] = MFMA32(f0_, p10, OT[h_ >> 1]); OT[h_ >> 1] = MFMA32(f1_, p11, OT[h_ >> 1]); } else { OT[h_ >> 1] = MFMA32(f0_, p00, OT[h_ >> 1]); OT[h_ >> 1] = MFMA32(f1_, p01, OT[h_ >> 1]); } } } while (0)
            MLA_LOAD(0); MLA_STORE(0, 0); __syncthreads();
            int v3 = 0;
            for (int t = 0; t < NT; ++t) {
                const LAS unsigned char* Kb = Kl + (t & 1) * KB; const LAS unsigned char* Vb = Vl + v3 * VB; const int vprev = (v3 == 0) ? 2 : v3 - 1, vnext = (v3 == 2) ? 0 : v3 + 1;
                if (t + 1 < NT) MLA_LOAD(t + 1);
                if (trail && pact) MLA_PV(Vl + vprev * VB);
                const int kbase = 64 * t; const bool act = kbase <= q0w + 31;
                f32x16 s0, s1;
                if (act) {
#pragma unroll
                    for (int e = 0; e < 16; ++e) { s0[e] = 0.f; s1[e] = 0.f; }
                    const LAS unsigned char* kp = Kb + r * KP + hf * 16;
                    bf16x8 kf[2][2];
#define MLA_KRD(g, B) do { kf[B][0] = *(const LAS bf16x8*)(kp + (g) * 32); kf[B][1] = *(const LAS bf16x8*)(kp + 32 * KP + (g) * 32); } while (0)
                    MLA_KRD(0, 0);
#pragma unroll
                    for (int g = 0; g < 12; ++g) {
                        if (g + 1 < 12) { if (g & 1) MLA_KRD(g + 1, 0); else MLA_KRD(g + 1, 1); }
                        __builtin_amdgcn_sched_barrier(0);
                        s0 = MFMA32(kf[g & 1][0], qf[g], s0); s1 = MFMA32(kf[g & 1][1], qf[g], s1);
                        __builtin_amdgcn_sched_barrier(0);
                    }
#undef MLA_KRD
                    s0 = MFMA32(kone, qm, s0); s1 = MFMA32(kone, qm, s1);
                }
                if (act) {
                    if (kbase + 63 > q0w) { const int qq = q0w + r - kbase;
#pragma unroll
                        for (int e = 0; e < 16; ++e) { const int kk = crow(e, hf); if (kk > qq) s0[e] = -1e30f; if (kk + 32 > qq) s1[e] = -1e30f; } }
                    float tm = s0[0];
#pragma unroll
                    for (int e = 1; e < 16; ++e) tm = fmaxf(tm, s0[e]);
#pragma unroll
                    for (int e = 0; e < 16; ++e) tm = fmaxf(tm, s1[e]);
                    tm = fmaxf(tm, __shfl_xor(tm, 32));
                    if (t == 0 || __any(tm > MLA_THR)) {
                        const bool mv = (t == 0) || (tm > MLA_THR);
                        const float mnew = __builtin_bit_cast(float, f2bf(m_ref + tm) << 16);
                        const float dl = mv ? mnew - m_ref : 0.f; m_ref += dl;
#pragma unroll
                        for (int e = 0; e < 16; ++e) { s0[e] -= dl; s1[e] -= dl; }
                        if (t > 0) { const float al = __builtin_amdgcn_exp2f(-dl); l_run *= al;
#pragma unroll
                            for (int d = 0; d < 4; ++d)
#pragma unroll
                                for (int e = 0; e < 16; ++e) OT[d][e] *= al; }
                        qm = __builtin_bit_cast(bf16x8, (u32x4){hf == 0 ? f2bf(-m_ref) : 0u, 0u, 0u, 0u});
                    }
                    float ls = 0.f;
#pragma unroll
                    for (int e = 0; e < 16; ++e) { s0[e] = __builtin_amdgcn_exp2f(s0[e]); s1[e] = __builtin_amdgcn_exp2f(s1[e]); ls += s0[e] + s1[e]; }
                    l_run += ls;
                    p00 = pack8(s0, 0); p01 = pack8(s0, 8); p10 = pack8(s1, 0); p11 = pack8(s1, 8);
                    if (!trail) MLA_PV(Vb);
                }
                pact = act;
                if (t + 1 < NT) MLA_STORE((t + 1) & 1, vnext);
                v3 = vnext;
                __syncthreads();
            }
            if (trail && pact) MLA_PV(Vl + ((v3 == 0) ? 2 : v3 - 1) * VB);
#undef MLA_LOAD
#undef MLA_STORE
#undef MLA_PV
            l_run += __shfl_xor(l_run, 32);
            const float il = 1.f / l_run;
            bf16* op = CO + (rb + q0w + r) * 768 + h * 128 + 4 * hf;
#pragma unroll
            for (int d = 0; d < 4; ++d)
#pragma unroll
                for (int g4 = 0; g4 < 4; ++g4) { u32x2 w; w.x = pg8::cvt_pk_bf16(OT[d][4 * g4] * il, OT[d][4 * g4 + 1] * il); w.y = pg8::cvt_pk_bf16(OT[d][4 * g4 + 2] * il, OT[d][4 * g4 + 3] * il); *(u32x2*)(op + 32 * d + 8 * g4) = w; }
            __syncthreads();
        }
    }
}
#undef MLA_OFFS
__device__ __forceinline__ void dwa_phase(LAS unsigned char* lds, const bf16* QKVA, bf16* AOG, float* LSE, int vcu, int G, int tid, int lane, int wave) {
    constexpr int KP = 144, VP = 128, KBY = 384 * KP;
    LAS unsigned char* Kl = lds; LAS unsigned char* Vl = lds + KBY;
    const int r = lane & 31, hf = lane >> 5;
    for (int u = vcu * 12; u < vcu * 12 + 12 && u < 3072; ++u) {
        const int v16 = u & 15, hh = (u >> 4) & 3, bg = u >> 6, g = bg % 3, b = bg / 3;
        const int dil = (g == 0) ? 1 : (g == 1) ? 4 : 16, res = (g == 0) ? 0 : (g == 1) ? (v16 >> 2) : v16, qb = (g == 0) ? v16 : (g == 1) ? (v16 & 3) : 0;
        const int head = 4 * g + hh; const size_t rb = (size_t)b * SEQ; const int j0 = 256 * qb - 128;
        const bf16* kb_ = QKVA + rb * P_QKVA + 768 + head * 64; const bf16* vb_ = QKVA + rb * P_QKVA + 1536 + head * 64;
        u32x4 kr[6], vr[6];
#pragma unroll
        for (int i = 0; i < 6; ++i) { const int c = tid + 512 * i, jw = c >> 3, ch = c & 7, jj = j0 + jw; const bool ok = jj >= 0; const size_t off = (size_t)(ok ? jj * dil + res : 0) * P_QKVA + ch * 8;
            kr[i] = ok ? *(const u32x4*)(kb_ + off) : (u32x4){0u, 0u, 0u, 0u}; vr[i] = ok ? *(const u32x4*)(vb_ + off) : (u32x4){0u, 0u, 0u, 0u}; }
        const int jq0 = 256 * qb + 32 * wave;
        bf16x8 qf[4];
        { const bf16* qp = QKVA + (rb + (size_t)(jq0 + r) * dil + res) * P_QKVA + head * 64 + 8 * hf;
#pragma unroll
          for (int s = 0; s < 4; ++s) qf[s] = *(const bf16x8*)(qp + 16 * s); }
#pragma unroll
        for (int i = 0; i < 6; ++i) { const int c = tid + 512 * i, jw = c >> 3, ch = c & 7; *(LAS u32x4*)(Kl + jw * KP + ch * 16) = kr[i]; *(LAS u32x4*)(Vl + jw * VP + ch * 16) = vr[i]; }
        __syncthreads();
        f32x16 st[5];
        const LAS unsigned char* kp = Kl + (32 * wave + r) * KP + hf * 16;
#pragma unroll
        for (int c = 0; c < 5; ++c) {
#pragma unroll
            for (int e = 0; e < 16; ++e) st[c][e] = 0.f;
#pragma unroll
            for (int s = 0; s < 4; ++s) { const bf16x8 kf = *(const LAS bf16x8*)(kp + 32 * c * KP + s * 32); st[c] = MFMA32(kf, qf[s], st[c]); } }
        float tm = -1e30f;
#pragma unroll
        for (int c = 0; c < 5; ++c)
#pragma unroll
            for (int e = 0; e < 16; ++e) { const int kk = 32 * c + crow(e, hf); const int dj = r + 128 - kk; const bool ok = (dj >= 0) && (dj <= 128) && (jq0 - 128 + kk >= 0); st[c][e] = ok ? st[c][e] : -1e30f; tm = fmaxf(tm, st[c][e]); }
        tm = fmaxf(tm, __shfl_xor(tm, 32));
        float ls = 0.f;
#pragma unroll
        for (int c = 0; c < 5; ++c)
#pragma unroll
            for (int e = 0; e < 16; ++e) { st[c][e] = __builtin_amdgcn_exp2f(st[c][e] - tm); ls += st[c][e]; }
        ls += __shfl_xor(ls, 32);
        f32x16 OT[2];
#pragma unroll
        for (int d = 0; d < 2; ++d)
#pragma unroll
            for (int e = 0; e < 16; ++e) OT[d][e] = 0.f;
        const LAS unsigned char* vp = Vl + (32 * wave + ((lane & 15) >> 2) + 4 * hf) * VP + (16 * ((lane >> 4) & 1) + 4 * (lane & 3)) * 2;
#pragma unroll
        for (int c = 0; c < 5; ++c)
#pragma unroll
            for (int s2 = 0; s2 < 2; ++s2) { const bf16x8 pf = pack8(st[c], 8 * s2);
#pragma unroll
                for (int d = 0; d < 2; ++d) { const s16x4 lo = vtr(vp + (32 * c + 16 * s2) * VP + 64 * d), hi = vtr(vp + (32 * c + 16 * s2 + 8) * VP + 64 * d);
                    const bf16x8 vf = {lo[0], lo[1], lo[2], lo[3], hi[0], hi[1], hi[2], hi[3]}; OT[d] = MFMA32(vf, pf, OT[d]); } }
        const float il = 1.f / ls; const size_t orow = rb + (size_t)(jq0 + r) * dil + res;
        bf16* op = AOG + ((size_t)g * MTOK + orow) * 256 + hh * 64 + 4 * hf;
#pragma unroll
        for (int d = 0; d < 2; ++d)
#pragma unroll
            for (int g4 = 0; g4 < 4; ++g4) { u32x2 w; w.x = pg8::cvt_pk_bf16(OT[d][4 * g4] * il, OT[d][4 * g4 + 1] * il); w.y = pg8::cvt_pk_bf16(OT[d][4 * g4 + 2] * il, OT[d][4 * g4 + 3] * il); *(u32x2*)(op + 32 * d + 8 * g4) = w; }
        if (hf == 0) LSE[((size_t)g * MTOK + orow) * 4 + hh] = tm + __builtin_amdgcn_logf(ls);
        __syncthreads();
    }
}

__device__ __forceinline__ void hgrn_phase(LAS unsigned char* lds, bf16* BIN, bf16* BO, const float* lbw, const float* gn, float* SH, int vcu, int G, int tid, int lane, int wave) {
    constexpr int PQ = 272, PK = 80, PO = 400;
    constexpr int O_QT = 0, O_KT = 32 * PQ, O_QI = 2 * 32 * PQ, O_KE = 3 * 32 * PQ, O_VT = O_KE + 128 * PK, O_DEC = O_VT + 96 * PK, O_ST = O_DEC + 512, STB = 96 * PQ, O_OB = O_ST + 2 * STB, OBB = 32 * PO, PG = 208, O_GB = O_OB + 2 * OBB, GBB = 32 * PG;
    static_assert(O_GB + 2 * GBB <= PHASE_LDS, "hgrn LDS map");
    for (int unit = vcu; unit < BATCH * 8 * 2; unit += G) {
        const int chain = unit >> 1, half = unit & 1, b = chain >> 3, head = chain & 7, nbeg = half * (SEQ / 64);
        int lane_o = lane; asm volatile("" : "+v"(lane_o));
        const int dl0 = lane_o & 15, tseg0 = lane_o >> 4, d0 = 16 * wave + dl0, r0 = lane_o & 31, hf0 = lane_o >> 5;
        const float lb = lbw[head * 128 + d0], olb = 1.f - lb;
        bf16* cbase = BIN + (size_t)b * SEQ * P_BIN;
        const unsigned zqo = (unsigned)((8 * tseg0) * P_BIN + head * 128 + d0);
        const unsigned vo0 = (unsigned)((tid >> 4) * P_BIN + 2048 + head * 96 + (tid & 15));
        const unsigned vl0 = (unsigned)((tid & 15) * PK + (tid >> 4) * 2);
        const unsigned gso = (unsigned)((tid / 12) * P_BIN + 2816 + head * 96 + (tid % 12) * 8);
        const unsigned gl0 = (unsigned)((tid / 12) * PG + (tid % 12) * 16);
        float run = 0.f;
        f32x16 Sv[3];
#pragma unroll
        for (int i = 0; i < 3; ++i)
#pragma unroll
            for (int e = 0; e < 16; ++e) Sv[i][e] = 0.f;
        for (int i = tid; i < STB / 4; i += 512) ((LAS unsigned*)(lds + O_ST))[i] = 0u;
        unsigned zrA[8], qrA[8], vrA[6], zrB[8], qrB[8], vrB[6];
        u32x4 ggA = (u32x4){0u, 0u, 0u, 0u}, ggB = (u32x4){0u, 0u, 0u, 0u};
        const f32x4 gna = *(const f32x4*)(gn + (tid % 12) * 8), gnb = *(const f32x4*)(gn + (tid % 12) * 8 + 4);
#define HG_LOAD(n, zr, qr, vr) do { const bf16* p_ = cbase + (size_t)(n) * 32 * P_BIN; _Pragma("unroll") for (int i = 0; i < 8; ++i) { qr[i] = p_[zqo + (unsigned)(i * P_BIN)]; zr[i] = p_[zqo + (unsigned)(i * P_BIN + 1024)]; } \
                        _Pragma("unroll") for (int k = 0; k < 6; ++k) vr[k] = p_[vo0 + 16u * k]; } while (0)
#define HG_LOADG(n, gg) do { if (half == 0 && tid < 384) gg = *(const u32x4*)(cbase + (size_t)(n) * 32 * P_BIN + gso); } while (0)
#define HG_GNORM(c) do { const LAS unsigned char* ob_ = lds + O_OB + ((c) & 1) * OBB + r * PO + hf * 192; const LAS unsigned char* gb_ = lds + O_GB + ((c) & 1) * GBB + r * PG + hf * 96; \
            float ss_ = 0.f; _Pragma("unroll") for (int i = 0; i < 12; ++i) { const f32x4 o_ = *(const LAS f32x4*)(ob_ + 16 * i); ss_ += (o_[0] * o_[0] + o_[1] * o_[1]) + (o_[2] * o_[2] + o_[3] * o_[3]); } \
            ss_ += __shfl_xor(ss_, 32); const float rs_ = 1.f / sqrtf(ss_ * (1.f / 96.f) + EPS); \
            asm volatile("" ::: "memory");     \
            bf16* op_ = BO + ((size_t)b * SEQ + (size_t)(c) * 32 + r) * 768 + head * 96 + 48 * hf; \
            _Pragma("unroll") for (int i = 0; i < 6; ++i) { const u32x4 gw_ = *(const LAS u32x4*)(gb_ + 16 * i); \
                const f32x4 oa_ = *(const LAS f32x4*)(ob_ + 32 * i), ob2_ = *(const LAS f32x4*)(ob_ + 32 * i + 16); \
                u32x4 w_; w_.x = pg8::cvt_pk_bf16(oa_[0] * rs_ * bflo(gw_.x), oa_[1] * rs_ * bfhi(gw_.x)); w_.y = pg8::cvt_pk_bf16(oa_[2] * rs_ * bflo(gw_.y), oa_[3] * rs_ * bfhi(gw_.y)); \
                w_.z = pg8::cvt_pk_bf16(ob2_[0] * rs_ * bflo(gw_.z), ob2_[1] * rs_ * bfhi(gw_.z)); w_.w = pg8::cvt_pk_bf16(ob2_[2] * rs_ * bflo(gw_.w), ob2_[3] * rs_ * bfhi(gw_.w)); \
                *(u32x4*)(op_ + 8 * i) = w_; } } while (0)
#define HG_RAW(c) do { const LAS unsigned char* ob_ = lds + O_OB + ((c) & 1) * OBB + r * PO + hf * 192; bf16* op_ = BO + ((size_t)b * SEQ + (size_t)(c) * 32 + r) * 768 + head * 96 + 48 * hf; \
            _Pragma("unroll") for (int i = 0; i < 6; ++i) { const f32x4 oa_ = *(const LAS f32x4*)(ob_ + 32 * i), ob2_ = *(const LAS f32x4*)(ob_ + 32 * i + 16); \
                u32x4 w_; w_.x = pg8::cvt_pk_bf16(oa_[0], oa_[1]); w_.y = pg8::cvt_pk_bf16(oa_[2], oa_[3]); w_.z = pg8::cvt_pk_bf16(ob2_[0], ob2_[1]); w_.w = pg8::cvt_pk_bf16(ob2_[2], ob2_[3]); *(u32x4*)(op_ + 8 * i) = w_; } } while (0)
#define HG_STEP(n, zr, qr, vr, gg) do { \
            int ln_ = lane; asm volatile("" : "+v"(ln_));     \
            const int r = ln_ & 31, hf = ln_ >> 5, dl = ln_ & 15, tseg = ln_ >> 4, d = 16 * wave + dl; (void)r; (void)hf; \
            _Pragma("unroll") for (int i = 0; i < 8; ++i) asm volatile("" : "+v"(zr[i]), "+v"(qr[i]));     \
            _Pragma("unroll") for (int k = 0; k < 6; ++k) asm volatile("" : "+v"(vr[k])); \
            float lf[8], kk[8], qv[8]; \
            _Pragma("unroll") for (int i = 0; i < 8; ++i) { const float z = __builtin_bit_cast(float, zr[i] << 16); const float sg = sigmoidf_(z); const float f = lb + olb * sg; kk[i] = olb * (1.f - sg); lf[i] = __builtin_amdgcn_logf(f); qv[i] = __builtin_bit_cast(float, qr[i] << 16); } \
            _Pragma("unroll") for (int i = 1; i < 8; ++i) lf[i] += lf[i - 1]; \
            const float T = lf[7]; \
            const float T0 = __shfl(T, dl), T1 = __shfl(T, dl + 16), T2 = __shfl(T, dl + 32), T3 = __shfl(T, dl + 48); \
            const float ref = T0 + T1, total = ref + T2 + T3; \
            const float pre = (tseg == 0) ? 0.f : (tseg == 1) ? T0 : (tseg == 2) ? ref : ref + T2; \
            const float eref = __builtin_amdgcn_exp2f(ref), etr = __builtin_amdgcn_exp2f(total - ref); \
            unsigned kew[4]; const float erun = half ? __builtin_amdgcn_exp2f(run) * eref : 0.f; \
            _Pragma("unroll") for (int i = 0; i < 8; i += 2) { const float e1a = __builtin_amdgcn_exp2f(pre + lf[i] - ref), e1b = __builtin_amdgcn_exp2f(pre + lf[i + 1] - ref); const float r1a = __builtin_amdgcn_rcpf(e1a), r1b = __builtin_amdgcn_rcpf(e1b); \
                const float qta = qv[i] * e1a, qtb = qv[i + 1] * e1b, kta = kk[i] * r1a, ktb = kk[i + 1] * r1b; \
                const unsigned wq = pg8::cvt_pk_bf16(qta, qtb), wk = pg8::cvt_pk_bf16(kta, ktb), wi = pg8::cvt_pk_bf16(qta * eref, qtb * eref); kew[i >> 1] = pg8::cvt_pk_bf16(kta * etr, ktb * etr); \
                const int t = 8 * tseg + i; \
                if (half) { bf16* qd_ = cbase + (size_t)(n) * 32 * P_BIN + (zqo + (unsigned)(i * P_BIN)); const unsigned wd_ = pg8::cvt_pk_bf16(qta * erun, qtb * erun); qd_[0] = (bf16)(wd_ & 0xffffu); qd_[P_BIN] = (bf16)(wd_ >> 16); } \
                *(LAS bf16*)(lds + O_QT + t * PQ + d * 2) = (bf16)(wq & 0xffffu); *(LAS bf16*)(lds + O_QT + (t + 1) * PQ + d * 2) = (bf16)(wq >> 16); \
                *(LAS bf16*)(lds + O_KT + t * PQ + d * 2) = (bf16)(wk & 0xffffu); *(LAS bf16*)(lds + O_KT + (t + 1) * PQ + d * 2) = (bf16)(wk >> 16); \
                *(LAS bf16*)(lds + O_QI + t * PQ + d * 2) = (bf16)(wi & 0xffffu); *(LAS bf16*)(lds + O_QI + (t + 1) * PQ + d * 2) = (bf16)(wi >> 16); } \
            *(LAS u32x4*)(lds + O_KE + d * PK + tseg * 16) = (u32x4){kew[0], kew[1], kew[2], kew[3]}; \
            if (tseg == 0) *(LAS float*)(lds + O_DEC + d * 4) = __builtin_amdgcn_exp2f(total); \
            run += total; \
            _Pragma("unroll") for (int k = 0; k < 6; ++k) *(LAS bf16*)(lds + O_VT + vl0 + 16 * PK * k) = (bf16)vr[k]; \
            if (half == 0 && tid < 384) { const float g0_ = bflo(gg.x), g1_ = bfhi(gg.x), g2_ = bflo(gg.y), g3_ = bfhi(gg.y), g4_ = bflo(gg.z), g5_ = bfhi(gg.z), g6_ = bflo(gg.w), g7_ = bfhi(gg.w); u32x4 sw_; \
                sw_.x = pg8::cvt_pk_bf16(gna[0] * g0_ * sigmoidf_(g0_), gna[1] * g1_ * sigmoidf_(g1_)); sw_.y = pg8::cvt_pk_bf16(gna[2] * g2_ * sigmoidf_(g2_), gna[3] * g3_ * sigmoidf_(g3_)); \
                sw_.z = pg8::cvt_pk_bf16(gnb[0] * g4_ * sigmoidf_(g4_), gnb[1] * g5_ * sigmoidf_(g5_)); sw_.w = pg8::cvt_pk_bf16(gnb[2] * g6_ * sigmoidf_(g6_), gnb[3] * g7_ * sigmoidf_(g7_)); \
                *(LAS u32x4*)(lds + O_GB + ((n) & 1) * GBB + gl0) = sw_; }     \
            __syncthreads(); \
            const LAS unsigned char* STc = lds + O_ST + ((n) & 1) * STB; LAS unsigned char* STn = lds + O_ST + (((n) + 1) & 1) * STB; \
            if (wave < 3) { \
                const int vb = wave; \
                  \
                bf16x8 fa[2][2], fb[2][2]; \
                const LAS unsigned char* ktp = lds + O_KT + r * PQ + hf * 16; const LAS unsigned char* qtp = lds + O_QT + r * PQ + hf * 16; \
                const LAS unsigned char* stp = STc + (32 * vb + r) * PQ + hf * 16; const LAS unsigned char* qip = lds + O_QI + r * PQ + hf * 16; \
                const LAS unsigned char* vp = lds + O_VT + (32 * vb + r) * PK + hf * 8; \
                const u32x2 a0 = *(const LAS u32x2*)(vp), a1 = *(const LAS u32x2*)(vp + 16), b0 = *(const LAS u32x2*)(vp + 32), b1 = *(const LAS u32x2*)(vp + 48); \
                fa[0][0] = *(const LAS bf16x8*)(ktp); fb[0][0] = *(const LAS bf16x8*)(qtp); fa[0][1] = *(const LAS bf16x8*)(ktp + 32); fb[0][1] = *(const LAS bf16x8*)(qtp + 32); \
                f32x16 at, ot; \
                _Pragma("unroll") for (int e = 0; e < 16; ++e) { at[e] = 0.f; ot[e] = 0.f; } \
                bf16x8 pa0, pa1; \
                _Pragma("unroll") for (int g = 0; g < 8; ++g) { \
                    if (g + 1 < 8) { const int n_ = g + 1, B_ = n_ & 1; const LAS unsigned char* pa_ = (n_ < 4) ? ktp + n_ * 64 : stp + (n_ - 4) * 64; const LAS unsigned char* pb_ = (n_ < 4) ? qtp + n_ * 64 : qip + (n_ - 4) * 64; \
                        fa[B_][0] = *(const LAS bf16x8*)(pa_); fb[B_][0] = *(const LAS bf16x8*)(pb_); fa[B_][1] = *(const LAS bf16x8*)(pa_ + 32); fb[B_][1] = *(const LAS bf16x8*)(pb_ + 32); } \
                    __builtin_amdgcn_sched_barrier(0); \
                    if (g < 4) { at = MFMA32(fa[g & 1][0], fb[g & 1][0], at); at = MFMA32(fa[g & 1][1], fb[g & 1][1], at); } \
                    else { ot = MFMA32(fa[g & 1][0], fb[g & 1][0], ot); ot = MFMA32(fa[g & 1][1], fb[g & 1][1], ot); } \
                    if (g == 3) { _Pragma("unroll") for (int e = 0; e < 16; ++e) at[e] = (crow(e, hf) <= r) ? at[e] : 0.f; pa0 = pack8(at, 0); pa1 = pack8(at, 8); } \
                    __builtin_amdgcn_sched_barrier(0); } \
                { const bf16x8 v0 = __builtin_bit_cast(bf16x8, (u32x4){a0.x, a0.y, a1.x, a1.y}), v1 = __builtin_bit_cast(bf16x8, (u32x4){b0.x, b0.y, b1.x, b1.y}); \
                  ot = MFMA32(v0, pa0, ot); ot = MFMA32(v1, pa1, ot); } \
                LAS unsigned char* obw = lds + O_OB + ((n) & 1) * OBB + r * PO + (32 * vb + 4 * hf) * 4; \
                _Pragma("unroll") for (int g4 = 0; g4 < 4; ++g4) *(LAS f32x4*)(obw + 32 * g4) = (f32x4){ot[4 * g4], ot[4 * g4 + 1], ot[4 * g4 + 2], ot[4 * g4 + 3]}; \
            } else if (wave == 3) { \
                if ((n) > nbeg) { if (half) HG_RAW((n) - 1); else HG_GNORM((n) - 1); } \
            } else { \
                const int db = wave - 4; \
                float dec[16]; \
                _Pragma("unroll") for (int g4 = 0; g4 < 4; ++g4) { const f32x4 dv = *(const LAS f32x4*)(lds + O_DEC + (32 * db + 8 * g4 + 4 * hf) * 4); dec[4 * g4] = dv[0]; dec[4 * g4 + 1] = dv[1]; dec[4 * g4 + 2] = dv[2]; dec[4 * g4 + 3] = dv[3]; } \
                const bf16x8 ke0 = *(const LAS bf16x8*)(lds + O_KE + (32 * db + r) * PK + hf * 16), ke1 = *(const LAS bf16x8*)(lds + O_KE + (32 * db + r) * PK + 32 + hf * 16); \
                _Pragma("unroll") for (int vb = 0; vb < 3; ++vb) { \
                    _Pragma("unroll") for (int e = 0; e < 16; ++e) Sv[vb][e] *= dec[e]; \
                    const bf16x8 v0 = *(const LAS bf16x8*)(lds + O_VT + (32 * vb + r) * PK + hf * 16), v1 = *(const LAS bf16x8*)(lds + O_VT + (32 * vb + r) * PK + 32 + hf * 16); \
                    Sv[vb] = MFMA32(ke0, v0, Sv[vb]); Sv[vb] = MFMA32(ke1, v1, Sv[vb]); \
                    _Pragma("unroll") for (int g4 = 0; g4 < 4; ++g4) { u32x2 w; w.x = pg8::cvt_pk_bf16(Sv[vb][4 * g4], Sv[vb][4 * g4 + 1]); w.y = pg8::cvt_pk_bf16(Sv[vb][4 * g4 + 2], Sv[vb][4 * g4 + 3]); \
                        *(LAS u32x2*)(STn + (32 * vb + r) * PQ + (32 * db + 8 * g4 + 4 * hf) * 2) = w; } } \
            } \
            __syncthreads(); } while (0)
        HG_LOAD(nbeg, zrA, qrA, vrA); HG_LOADG(nbeg, ggA);
        const int nend = nbeg + SEQ / 64;
#pragma unroll 1
        for (int n = nbeg; n < nend; ++n) {
            if (n + 1 < nend) { HG_LOAD(n + 1, zrB, qrB, vrB); HG_LOADG(n + 1, ggB); }
            HG_STEP(n, zrA, qrA, vrA, ggA);
            ggA = ggB;
#pragma unroll
            for (int i = 0; i < 8; ++i) { zrA[i] = zrB[i]; qrA[i] = qrB[i]; }
#pragma unroll
            for (int k = 0; k < 6; ++k) vrA[k] = vrB[k];
        }
        { const int r = r0, hf = hf0; if (wave == 3) { if (half) HG_RAW(nend - 1); else HG_GNORM(nend - 1); }
          if (half == 0 && wave >= 4) { const int db = wave - 4; float* sp = SH + (size_t)chain * (128 * 96);
#pragma unroll
              for (int vb = 0; vb < 3; ++vb)
#pragma unroll
                  for (int e = 0; e < 16; ++e) sp[(32 * db + crow(e, hf)) * 96 + 32 * vb + r] = Sv[vb][e]; } }
        __syncthreads();
#undef HG_LOAD
#undef HG_LOADG
#undef HG_STEP
#undef HG_GNORM
#undef HG_RAW
    }
}

__device__ __forceinline__ RsTab rs_preload(LAS unsigned char* lds, const float* SS, const pg8::StaticOrder& S, int tid) {
    LAS float* tab = (LAS float*)(lds + RS_OFF); pg8::Unit u; RsTab T; T.tab = tab; T.g0 = 0;
    if (!S.next(0, u)) return T;
    T.g0 = u.pm >> 3; int last = -1;
    for (int i = 0; S.next(i, u); ++i) { const int gid = u.pm >> 3; if (gid == last) continue; last = gid;
        if (tid < 256 && gid - T.g0 < RS_SLOTS) tab[((gid - T.g0) << 8) + tid] = row_rstd(SS, u.pm * 256 + tid); }
    __syncthreads();
    return T;
}

__device__ __forceinline__ void hgrn_fix_phase(LAS unsigned char* lds, const bf16* BIN, bf16* BO, const float* gn, const float* SH, int vcu, int G, int tid, int lane, int wave) {
    constexpr int PQ = 272;
    const int r = lane & 31, hf = lane >> 5;
    for (int unit = vcu; unit < BATCH * 8 * 2; unit += G) {
        const int chain = unit >> 1, sub = unit & 1, b = chain >> 3, head = chain & 7;
        __syncthreads();
        { const float* sp = SH + (size_t)chain * (128 * 96);
          for (int i = tid; i < 128 * 96; i += 512) { const int d = i / 96, v = i - 96 * d; *(LAS bf16*)(lds + v * PQ + d * 2) = (bf16)f2bf(sp[i]); } }
        __syncthreads();
        for (int j = 0; j < 4; ++j) {
            const int n = SEQ / 64 + 32 * sub + 4 * wave + j; const size_t row = (size_t)b * SEQ + (size_t)n * 32 + r;
            bf16x8 qd[8];
            { const bf16* qp = BIN + row * P_BIN + head * 128 + 8 * hf;
#pragma unroll
              for (int kd = 0; kd < 8; ++kd) qd[kd] = *(const bf16x8*)(qp + 16 * kd); }
            f32x16 ot[3]; float ss = 0.f;
            bf16* op = BO + row * 768 + head * 96 + 4 * hf; const bf16* gp = BIN + row * P_BIN + 2816 + head * 96 + 4 * hf;
#pragma unroll
            for (int vb = 0; vb < 3; ++vb) {
#pragma unroll
                for (int e = 0; e < 16; ++e) ot[vb][e] = 0.f;
#pragma unroll
                for (int kd = 0; kd < 8; ++kd) { const bf16x8 sf = *(const LAS bf16x8*)(lds + (32 * vb + r) * PQ + kd * 32 + hf * 16); ot[vb] = MFMA32(sf, qd[kd], ot[vb]); }
#pragma unroll
                for (int g4 = 0; g4 < 4; ++g4) { const u32x2 w = *(const u32x2*)(op + 32 * vb + 8 * g4); ot[vb][4 * g4] += bflo(w.x); ot[vb][4 * g4 + 1] += bfhi(w.x); ot[vb][4 * g4 + 2] += bflo(w.y); ot[vb][4 * g4 + 3] += bfhi(w.y); }
#pragma unroll
                for (int e = 0; e < 16; ++e) ss += ot[vb][e] * ot[vb][e]; }
            ss += __shfl_xor(ss, 32);
            const float rs = 1.f / sqrtf(ss * (1.f / 96.f) + EPS);
#pragma unroll
            for (int vb = 0; vb < 3; ++vb)
#pragma unroll
                for (int g4 = 0; g4 < 4; ++g4) { const u32x2 gw = *(const u32x2*)(gp + 32 * vb + 8 * g4); const f32x4 ga = *(const f32x4*)(gn + 32 * vb + 8 * g4 + 4 * hf);
                    const float g0 = bflo(gw.x), g1 = bfhi(gw.x), g2 = bflo(gw.y), g3 = bfhi(gw.y);
                    u32x2 w; w.x = pg8::cvt_pk_bf16(ot[vb][4 * g4] * rs * ga[0] * (g0 * sigmoidf_(g0)), ot[vb][4 * g4 + 1] * rs * ga[1] * (g1 * sigmoidf_(g1)));
                    w.y = pg8::cvt_pk_bf16(ot[vb][4 * g4 + 2] * rs * ga[2] * (g2 * sigmoidf_(g2)), ot[vb][4 * g4 + 3] * rs * ga[3] * (g3 * sigmoidf_(g3)));
                    *(u32x2*)(op + 32 * vb + 8 * g4) = w; }
        }
    }
}

typedef const unsigned char __attribute__((address_space(4)))* karg_ptr;
__device__ __forceinline__ const float* karg_in(int k) { karg_ptr kp = (karg_ptr)__builtin_amdgcn_kernarg_segment_ptr(); asm volatile("" : "+s"(kp)); return *(const float* const __attribute__((address_space(4)))*)(kp + 8 * k); }
__device__ __forceinline__ unsigned char* karg_ws() { karg_ptr kp = (karg_ptr)__builtin_amdgcn_kernarg_segment_ptr(); asm volatile("" : "+s"(kp)); return *(unsigned char* const __attribute__((address_space(4)))*)(kp + 200); }
__device__ __forceinline__ float* karg_out() { karg_ptr kp = (karg_ptr)__builtin_amdgcn_kernarg_segment_ptr(); asm volatile("" : "+s"(kp)); return *(float* const __attribute__((address_space(4)))*)(kp + 192); }
constexpr int NPH = 19, NPHASES = DEPTH * NPH + 1;
struct Args { const float* in[24]; float* out; unsigned char* ws; int ph_lo, ph_hi; };
static_assert(sizeof(Args) == 24 * 8 + 8 + 8 + 8, "Args has no padding");

__global__ void __launch_bounds__(512, 2) mk_fwd(Args args) {
    extern __shared__ __attribute__((aligned(16))) unsigned char lds_raw[];
    LAS unsigned char* lds = (LAS unsigned char*)lds_raw;
    volatile LAS unsigned* MISC = (volatile LAS unsigned*)(lds + MISC_OFF);
    const int tid0 = threadIdx.x, lane0 = tid0 & 63, wave0 = __builtin_amdgcn_readfirstlane(tid0 >> 6);
    const int G0 = gridDim.x, bx0 = blockIdx.x;
    const int vcu0 = (G0 % 8 == 0) ? (bx0 % 8) * (G0 / 8) + bx0 / 8 : bx0;
    const int gw0 = vcu0 * 8 + wave0, NGW0 = G0 * 8;
#define PH_LOCALS int z_ = 0; asm volatile("" : "+v"(z_)); int lane = (int)__builtin_amdgcn_mbcnt_hi(~0u, __builtin_amdgcn_mbcnt_lo(~0u, (unsigned)z_)), wave = wave0, tid = wave0 * 64 + lane, G = G0, bx = bx0, vcu = vcu0, gw = gw0, NGW = NGW0;   \
    asm volatile("" : "+v"(tid), "+v"(lane), "+s"(wave), "+s"(G), "+s"(bx), "+s"(vcu), "+s"(gw), "+s"(NGW)); (void)tid; (void)lane; (void)wave; (void)G; (void)bx; (void)vcu; (void)gw; (void)NGW;
    for (int u = tid0; u < (LDS_BYTES - LDSCTL_OFF) / 4; u += 512) ((LAS unsigned*)(lds + LDSCTL_OFF))[u] = 0u;
    __syncthreads();
    const int lo = args.ph_lo, hi = args.ph_hi;
    if (hi - lo > 1) (void)xcd_barrier_post((unsigned*)(karg_ws() + WS_CTL) + CW_BAR, MISC + 8);
#define IN(k) (lo <= (k) && (k) < hi)
#define INP(p) ((((PH_MASK) >> (p)) & 1u) && IN(pb + (p)))
#define SEAM(k) do { if (IN(k) && IN((k) + 1)) { XcdBarrier b_; b_.bar = (unsigned*)(karg_ws() + WS_CTL) + CW_BAR; b_.x = xb_xcc_id(); b_.st = (volatile LAS unsigned*)(lds + MISC_OFF) + 8; int zb_ = 0; asm volatile("" : "+v"(zb_)); \
    const bool ld_ = (wave0 == 0) && ((int)__builtin_amdgcn_mbcnt_hi(~0u, __builtin_amdgcn_mbcnt_lo(~0u, (unsigned)zb_)) == 0); xcd_barrier(b_, ld_); } } while (0)

#define X (karg_out())
#define WSP(T, off) ((T*)(karg_ws() + (off)))
#define ropeA WSP(float, WS_ROPEA)
#define ropeC WSP(float, WS_ROPEC)
#define LBW WSP(float, WS_LB)
#define W1U WSP(bf16, WS_W + W_1U)
#define W1D WSP(bf16, WS_W + W_1D)
#define WIN1 WSP(bf16, WS_W + W_IN1)
#define WINB WSP(bf16, WS_W + W_INB)
#define WING WSP(bf16, WS_W + W_ING)
#define WQB WSP(bf16, WS_W + W_QB)
#define WKVB WSP(bf16, WS_W + W_KVB)
#define WA WSP(bf16, WS_W + W_A)
#define WBb WSP(bf16, WS_W + W_B)
#define WC WSP(bf16, WS_W + W_C)
#define WO WSP(bf16, WS_W + W_O)
#define W2U WSP(bf16, WS_W + W_2U)
#define W2D WSP(bf16, WS_W + W_2D)
#define WPG WSP(bf16, WS_W + W_PG)
#define WPP WSP(bf16, WS_W + W_PP)
#define XN WSP(bf16, WS_XN)
#define XBE WSP(bf16, WS_XBE)
#define XBO WSP(bf16, WS_XBO)
#define SS0 WSP(float, WS_SS0)
#define SS1 WSP(float, WS_SS1)
#define MG WSP(bf16, WS_MG)
#define H WSP(bf16, WS_H)
#define QKVA WSP(bf16, WS_QKVA)
#define CLR WSP(bf16, WS_CLR)
#define QC WSP(bf16, WS_QC)
#define CO WSP(bf16, WS_CO)
#define KVC WSP(bf16, WS_KVC)
#define AOUT WSP(bf16, WS_AOUT)
#define AOG WSP(bf16, WS_AOG)
#define LSEB WSP(float, WS_LSE)
#define SHB WSP(float, WS_SH)
#define BIN WSP(bf16, WS_BIN)
#define BO WSP(bf16, WS_BO)
#define GS WSP(unsigned char, WS_GS)
#define PB WSP(bf16, WS_PB)
#define PP WSP(bf16, WS_PP)

#define WPREP(LY, SEL) do { \
            int ln_w = lane, wv_w = wave, gw_w = gw; asm volatile("" : "+v"(ln_w), "+s"(wv_w), "+s"(gw_w)); \
            LAS float* scr = (LAS float*)(lds + wv_w * 16384); \
            bf16* const w1U = W1U; bf16* const w1D = W1D; bf16* const wIN1 = WIN1; bf16* const wINB = WINB; bf16* const wING = WING; bf16* const wQB = WQB; bf16* const wKVB = WKVB; bf16* const wA = WA; \
            bf16* const wB = WBb; bf16* const wC = WC; bf16* const wO = WO; bf16* const w2U = W2U; bf16* const w2D = W2D; bf16* const wPG = WPG; bf16* const wPP = WPP; \
            const float* w1u = karg_in(3) + (size_t)(LY) * DM * 2 * DFF; const float* w1d = karg_in(4) + (size_t)(LY) * DFF * DM; const float* win = karg_in(6) + (size_t)(LY) * DM * INW; \
            const float* wqb = karg_in(10) + (size_t)(LY) * 384 * 1152; const float* wkvb = karg_in(12) + (size_t)(LY) * 256 * 1536; \
            const float* wa = karg_in(13) + (size_t)(LY) * 256 * DM; const float* wbb = karg_in(14) + (size_t)(LY) * 768 * DM; const float* wcc = karg_in(15) + (size_t)(LY) * 768 * DM; \
            const float* wo = karg_in(16) + (size_t)(LY) * DM * DM; const float* w2u = karg_in(18) + (size_t)(LY) * DM * 2 * DFF; const float* w2d = karg_in(19) + (size_t)(LY) * DFF * DM; \
            const float* wpg = karg_in(21) + (size_t)(LY) * DM * DM; const float* wpp = karg_in(22) + (size_t)(LY) * PLE * DM; \
            const float* gn1 = karg_in(2) + (LY) * DM; const float* gnm = karg_in(5) + (LY) * DM; const float* gn2 = karg_in(17) + (LY) * DM; const float* gnp = karg_in(20) + (LY) * DM; \
            constexpr int I_U = (1024 / 64) * (5632 / 32), I_D = (2816 / 64) * (1024 / 32), I_1 = 16 * (N_IN1 / 32), I_B = 16 * (N_INB / 32), I_G = 16 * (N_ING / 32), I_Q = 6 * (N_QB / 32), I_KV = 4 * (1536 / 32), \
                          I_A = 4 * 32, I_BC = 12 * 32, I_O = 16 * 32, I_PP = 4 * 32; \
            constexpr int NITEMS = 2 * I_U + 2 * I_D + I_1 + I_B + I_G + I_Q + I_KV + I_A + 2 * I_BC + 2 * I_O + I_PP; \
            for (int it = gw_w; it < NITEMS; it += NGW) { \
                int r = it; \
                if (r < I_U) { if ((SEL) != 2) wt_item<1, true>(w1u, 1024, 5632, 5632, w1U, scr, r, ln_w, gn1); continue; } r -= I_U; \
                if (r < I_U) { if ((SEL) != 2) wt_item<1, true>(w2u, 1024, 5632, 5632, w2U, scr, r, ln_w, gn2); continue; } r -= I_U; \
                if (r < I_D) { if ((SEL) != 2) wt_item<0>(w1d, 2816, 1024, 1024, w1D, scr, r, ln_w); continue; } r -= I_D; \
                if (r < I_D) { if ((SEL) != 2) wt_item<0>(w2d, 2816, 1024, 1024, w2D, scr, r, ln_w); continue; } r -= I_D; \
                if (r < I_1) { if ((SEL) != 2) wt_item<2, true>(win, 1024, INW, N_IN1, wIN1, scr, r, ln_w, gnm); continue; } r -= I_1; \
                if (r < I_B) { if ((SEL) != 2) wt_item<3, true>(win, 1024, INW, N_INB, wINB, scr, r, ln_w, gnm); continue; } r -= I_B; \
                if (r < I_G) { if ((SEL) != 2) wt_item<4, true>(win, 1024, INW, N_ING, wING, scr, r, ln_w, gnm); continue; } r -= I_G; \
                if (r < I_Q) { if ((SEL) != 2) wt_item<5>(wqb, 384, 1152, N_QB, wQB, scr, r, ln_w); continue; } r -= I_Q; \
                if (r < I_KV) { if ((SEL) != 2) wt_item<0>(wkvb, 256, 1536, 1536, wKVB, scr, r, ln_w); continue; } r -= I_KV; \
                if (r < I_A) { if ((SEL) != 2) wt_item<0>(wa, 256, 1024, 1024, wA, scr, r, ln_w); continue; } r -= I_A; \
                if (r < I_BC) { if ((SEL) != 2) wt_item<0>(wbb, 768, 1024, 1024, wB, scr, r, ln_w); continue; } r -= I_BC; \
                if (r < I_BC) { if ((SEL) != 2) wt_item<0>(wcc, 768, 1024, 1024, wC, scr, r, ln_w); continue; } r -= I_BC; \
                if (r < I_O) { if ((SEL) != 2) wt_item<0>(wo, 1024, 1024, 1024, wO, scr, r, ln_w); continue; } r -= I_O; \
                if (r < I_O) { if ((SEL) != 1) wt_item<0, true>(wpg, 1024, 1024, 1024, wPG, scr, r, ln_w, gnp); continue; } r -= I_O; \
                if ((SEL) != 1) wt_item<0>(wpp, 256, 1024, 1024, wPP, scr, r, ln_w); \
            } \
            } while (0)
    for (int Lyr = 0; Lyr < DEPTH; ++Lyr) {
        const int pb = Lyr * NPH;
        if (hi <= pb || lo >= pb + NPH) continue;

        if (Lyr == 0 && INP(0)) for (int rep_ = 0; rep_ < 1 + (int)((MK_DUP >> 0) & 1u); ++rep_) { PH_LOCALS
            WPREP(Lyr, 0);
            if (Lyr == 0) {
                const int gt = vcu * 512 + tid, NGT = G * 512; float* rA = ropeA; float* rC = ropeC; float* lbw_ = LBW;
                for (int i = gt; i < SEQ * 8; i += NGT) { const int pos = i >> 3, f = i & 7; const float inv = 1.0f / powf(500000.0f, (float)(2 * f) / 16.0f); const float ang = (float)pos * inv;
                    rA[2 * i] = cosf(ang); rA[2 * i + 1] = sinf(ang); }
                for (int i = gt; i < SEQ * 32; i += NGT) { const int pos = i >> 5, f = i & 31; const float inv = 1.0f / powf(10000.0f, (float)(2 * f) / 64.0f); const float ang = (float)pos * inv;
                    rC[2 * i] = cosf(ang); rC[2 * i + 1] = sinf(ang); }
                const float* lg = karg_in(7);
                for (int c = gt; c < 1024; c += NGT) { const float a0 = lg[c], a1 = lg[1024 + c], a2 = lg[2048 + c], a3 = lg[3072 + c];
                    const float mx = fmaxf(fmaxf(a0, a1), fmaxf(a2, a3)); const float e0 = expf(a0 - mx), e1 = expf(a1 - mx), e2 = expf(a2 - mx), e3 = expf(a3 - mx); const float inv = 1.f / (e0 + e1 + e2 + e3);
                    lbw_[c] = 0.f; lbw_[1024 + c] = e1 * inv; lbw_[2048 + c] = (e1 + e2) * inv; lbw_[3072 + c] = (e1 + e2 + e3) * inv; }
            }
            if (Lyr == 0) {
                const float* xin = karg_in(0); bf16* xb = XBO; float* ss = SS1;
                for (int m0 = gw; m0 < MTOK; m0 += 2 * NGW) {
                    f32x4 v[2][4]; float sq[2];
#pragma unroll
                    for (int q = 0; q < 2; ++q) { const GAS f32x4* xr = (const GAS f32x4*)(xin + (size_t)(m0 + q * NGW) * DM) + lane;
#pragma unroll
                        for (int j = 0; j < 4; ++j) v[q][j] = xr[64 * j]; }
#pragma unroll
                    for (int q = 0; q < 2; ++q) { GAS unsigned long long* o8 = (GAS unsigned long long*)(xb + (size_t)(m0 + q * NGW) * DM) + lane; float t = 0.f;
#pragma unroll
                        for (int j = 0; j < 4; ++j) { const f32x4 u = v[q][j]; t += (u.x * u.x + u.y * u.y) + (u.z * u.z + u.w * u.w); o8[64 * j] = (unsigned long long)pg8::cvt_pk_f16(u.x, u.y) | ((unsigned long long)pg8::cvt_pk_f16(u.z, u.w) << 32); }
                        sq[q] = t; }
#pragma unroll
                    for (int q = 0; q < 2; ++q) { const float t = wave_sum(sq[q]); if (lane < 16) ss[(size_t)(m0 + q * NGW) * 16 + lane] = (lane == 0) ? t : 0.f; } }
            }
        }
        if (Lyr == 0) SEAM(pb + 0);
        if (INP(1)) for (int rep_ = 0; rep_ < 1 + (int)((MK_DUP >> 1) & 1u); ++rep_) { PH_LOCALS pg8::Gemm g{XBO, W1U, MTOK, 2 * DFF, DM, DM}; pg8::StaticOrder S; S.init(MTOK, 2 * DFF, G, bx); EpiSwiglu E{H, rs_preload(lds, SS1, S, tid)}; pg8::gemm_phase<EpiSwiglu, pg8::StaticOrder, true, true>(lds, g, S, E, tid);
            if (Lyr > 0) WPREP(Lyr, 2); }
        SEAM(pb + 1);
        if (INP(2)) for (int rep_ = 0; rep_ < 1 + (int)((MK_DUP >> 2) & 1u); ++rep_) { PH_LOCALS pg8::Gemm g{H, W1D, MTOK, DM, DFF, DFF}; pg8::StaticOrder S; S.init(MTOK, DM, G, bx); EpiResid E{XBO, XBE, rep_ ? 0.f : 0.5f, SS0}; pg8::gemm_phase<EpiResid, pg8::StaticOrder>(lds, g, S, E, tid); }
        SEAM(pb + 2);
        if (INP(4)) for (int rep_ = 0; rep_ < 1 + (int)((MK_DUP >> 4) & 1u); ++rep_) { PH_LOCALS pg8::Gemm g{XBE, WIN1, MTOK, N_IN1, DM, DM}; pg8::StaticOrder S; S.init(MTOK, N_IN1, G, bx); EpiIn1 E{QKVA, CLR, ropeA, ropeC, rs_preload(lds, SS0, S, tid)}; pg8::gemm_phase<EpiIn1, pg8::StaticOrder, true, true>(lds, g, S, E, tid); }
        SEAM(pb + 4);
        if (INP(5)) for (int rep_ = 0; rep_ < 1 + (int)((MK_DUP >> 5) & 1u); ++rep_) { PH_LOCALS
            const float* gq = karg_in(9) + Lyr * 384; const float* gkv = karg_in(11) + Lyr * 256; bf16* const clr = CLR; const bf16* const qkva = QKVA; bf16* const aout = AOUT;
            if (rep_ == 0) {
                float gqr[6], gkr[4];
#pragma unroll
                for (int j = 0; j < 6; ++j) gqr[j] = gq[6 * lane + j];
#pragma unroll
                for (int j = 0; j < 4; ++j) gkr[j] = gkv[4 * lane + j];
                for (int m0 = gw; m0 < MTOK; m0 += 4 * NGW) {
                    unsigned a[4][3], b[4][2]; float s1[4], s2[4];
#pragma unroll
                    for (int q = 0; q < 4; ++q) { const unsigned* row = (const unsigned*)(clr + (size_t)(m0 + q * NGW) * P_CLR);
#pragma unroll
                        for (int j = 0; j < 3; ++j) a[q][j] = row[3 * lane + j];
#pragma unroll
                        for (int j = 0; j < 2; ++j) b[q][j] = (row + CLR_KV / 2)[2 * lane + j]; }
#pragma unroll
                    for (int q = 0; q < 4; ++q) { float t1 = 0.f, t2 = 0.f;
#pragma unroll
                        for (int j = 0; j < 3; ++j) { const float x = bflo(a[q][j]), y = bfhi(a[q][j]); t1 += x * x + y * y; }
#pragma unroll
                        for (int j = 0; j < 2; ++j) { const float x = bflo(b[q][j]), y = bfhi(b[q][j]); t2 += x * x + y * y; }
                        s1[q] = t1; s2[q] = t2; }
#pragma unroll
                    for (int o = 1; o < 64; o <<= 1) {
#pragma unroll
                        for (int q = 0; q < 4; ++q) { s1[q] += __shfl_xor(s1[q], o); s2[q] += __shfl_xor(s2[q], o); } }
#pragma unroll
                    for (int q = 0; q < 4; ++q) { unsigned* row = (unsigned*)(clr + (size_t)(m0 + q * NGW) * P_CLR);
                        const float r1 = 1.f / sqrtf(s1[q] * (1.f / 384.f) + EPS), r2 = 1.f / sqrtf(s2[q] * (1.f / 256.f) + EPS);
#pragma unroll
                        for (int j = 0; j < 3; ++j) row[3 * lane + j] = pk2(bflo(a[q][j]) * r1 * gqr[2 * j], bfhi(a[q][j]) * r1 * gqr[2 * j + 1]);
#pragma unroll
                        for (int j = 0; j < 2; ++j) (row + CLR_KV / 2)[2 * lane + j] = pk2(bflo(b[q][j]) * r2 * gkr[2 * j], bfhi(b[q][j]) * r2 * gkr[2 * j + 1]); }
                }
            }
#if MK_NAIVE_A
            for (int task = gw; task < MTOK * 4; task += NGW) {
                const int m = task >> 2, hh = task & 3, t = m & (SEQ - 1);
                float sc[3][3]; float mx = -1e30f;
#pragma unroll
                for (int g = 0; g < 3; ++g) { const int dil = (g == 0) ? 1 : (g == 1) ? 4 : 16; const int head = 4 * g + hh;
                    const u32x4* qp = (const u32x4*)(qkva + (size_t)m * P_QKVA + head * 64);
#pragma unroll
                    for (int kk = 0; kk < 3; ++kk) { const int i = lane + 64 * kk; const bool valid = (i <= 128) && (t - i * dil >= 0);
                        float s = -1e30f;
                        if (valid) { const u32x4* kp = (const u32x4*)(qkva + (size_t)(m - i * dil) * P_QKVA + 768 + head * 64); s = 0.f;
                            for (int c = 0; c < 8; ++c) { const u32x4 qv = qp[c], kv = kp[c];
                                s += bflo(qv.x) * bflo(kv.x) + bfhi(qv.x) * bfhi(kv.x) + bflo(qv.y) * bflo(kv.y) + bfhi(qv.y) * bfhi(kv.y) + bflo(qv.z) * bflo(kv.z) + bfhi(qv.z) * bfhi(kv.z) + bflo(qv.w) * bflo(kv.w) + bfhi(qv.w) * bfhi(kv.w); } }
                        sc[g][kk] = s; mx = fmaxf(mx, s); } }
                mx = wave_max(mx);
                float l = 0.f;
#pragma unroll
                for (int g = 0; g < 3; ++g)
#pragma unroll
                    for (int kk = 0; kk < 3; ++kk) { const float p = (sc[g][kk] > -1e29f) ? __builtin_amdgcn_exp2f(sc[g][kk] - mx) : 0.f; sc[g][kk] = p; l += p; }
                l = wave_sum(l);
                float o = 0.f;
#pragma unroll
                for (int g = 0; g < 3; ++g) { const int dil = (g == 0) ? 1 : (g == 1) ? 4 : 16; const int head = 4 * g + hh;
#pragma unroll
                    for (int kk = 0; kk < 3; ++kk) { const int nn = (kk < 2) ? 64 : 1;
                        for (int ii = 0; ii < nn; ++ii) { const int i = 64 * kk + ii; if (t - i * dil < 0) break;
                            const float p = __shfl(sc[g][kk], ii); o += p * bf2f(qkva[(size_t)(m - i * dil) * P_QKVA + 1536 + head * 64 + lane]); } } }
                aout[(size_t)m * 256 + hh * 64 + lane] = (bf16)f2bf(o / l);
            }
        #else
            dwa_phase(lds, qkva, AOG, LSEB, vcu, G, tid, lane, wave);
#endif
        }
        SEAM(pb + 5);
        if (INP(6)) for (int rep_ = 0; rep_ < 1 + (int)((MK_DUP >> 6) & 1u); ++rep_) { PH_LOCALS
#if !MK_NAIVE_A
            { const bf16* const aog = AOG; const float* const lse = LSEB; bf16* const aout = AOUT;
              for (int m0 = gw; m0 < MTOK; m0 += 4 * NGW) { const int hh = lane >> 4;
                  float l0[4], l1[4], l2[4]; u32x2 a[4], b[4], c[4];
#pragma unroll
                  for (int q = 0; q < 4; ++q) { const size_t m = (size_t)(m0 + q * NGW);
                      l0[q] = lse[m * 4 + hh]; l1[q] = lse[((size_t)MTOK + m) * 4 + hh]; l2[q] = lse[((size_t)2 * MTOK + m) * 4 + hh];
                      a[q] = *(const u32x2*)(aog + m * 256 + 4 * lane); b[q] = *(const u32x2*)(aog + ((size_t)MTOK + m) * 256 + 4 * lane); c[q] = *(const u32x2*)(aog + ((size_t)2 * MTOK + m) * 256 + 4 * lane); }
#pragma unroll
                  for (int q = 0; q < 4; ++q) { const size_t m = (size_t)(m0 + q * NGW); const float mx = fmaxf(l0[q], fmaxf(l1[q], l2[q]));
                      const float w0 = __builtin_amdgcn_exp2f(l0[q] - mx), w1 = __builtin_amdgcn_exp2f(l1[q] - mx), w2 = __builtin_amdgcn_exp2f(l2[q] - mx); const float inv = 1.f / (w0 + w1 + w2);
                      u32x2 o; o.x = pk2((w0 * bflo(a[q].x) + w1 * bflo(b[q].x) + w2 * bflo(c[q].x)) * inv, (w0 * bfhi(a[q].x) + w1 * bfhi(b[q].x) + w2 * bfhi(c[q].x)) * inv);
                      o.y = pk2((w0 * bflo(a[q].y) + w1 * bflo(b[q].y) + w2 * bflo(c[q].y)) * inv, (w0 * bfhi(a[q].y) + w1 * bfhi(b[q].y) + w2 * bfhi(c[q].y)) * inv);
                      *(u32x2*)(aout + m * 256 + 4 * lane) = o; } } }
#endif
            { pg8::Gemm g{CLR, WQB, MTOK, N_QB, 384, P_CLR}; pg8::StaticOrder S; S.init(MTOK, N_QB, G, bx); EpiQC E{QC, ropeC}; pg8::gemm_phase<EpiQC, pg8::StaticOrder>(lds, g, S, E, tid); }
            { pg8::Gemm g{CLR + CLR_KV, WKVB, MTOK, 1536, 256, P_CLR}; pg8::StaticOrder S; S.init(MTOK, 1536, G, bx); EpiBf16<0, false> E{KVC, P_KVC, RsTab{nullptr, 0}}; pg8::gemm_phase<EpiBf16<0, false>, pg8::StaticOrder>(lds, g, S, E, tid); }
        }
        SEAM(pb + 6);
        if (INP(7)) for (int rep_ = 0; rep_ < 1 + (int)((MK_DUP >> 7) & 1u); ++rep_) { PH_LOCALS
#if MK_NAIVE_C
            LAS float* Sb = (LAS float*)(lds + wave * 16384); const bf16* const qc = QC; const bf16* const kvc = KVC; const bf16* const clr = CLR; bf16* const co = CO;
            for (int task = gw; task < MTOK * 6; task += NGW) {
                const int m = task / 6, h = task - 6 * m, t = m & (SEQ - 1); const size_t rb = (size_t)(m - t);
                const u32x4* qp = (const u32x4*)(qc + (size_t)m * P_QC + h * 192);
                float mx = -1e30f;
                for (int k0 = 0; k0 <= t; k0 += 64) { const int key = k0 + lane; float s = -1e30f;
                    if (key <= t) { const u32x4* kp = (const u32x4*)(kvc + (rb + key) * P_KVC + h * 256); const u32x4* rp = (const u32x4*)(clr + (rb + key) * P_CLR + CLR_KR); s = 0.f;
                        for (int c = 0; c < 24; ++c) { const u32x4 qv = qp[c]; const u32x4 kv = (c < 16) ? kp[c] : rp[c - 16];
                            s += bflo(qv.x) * bflo(kv.x) + bfhi(qv.x) * bfhi(kv.x) + bflo(qv.y) * bflo(kv.y) + bfhi(qv.y) * bfhi(kv.y) + bflo(qv.z) * bflo(kv.z) + bfhi(qv.z) * bfhi(kv.z) + bflo(qv.w) * bflo(kv.w) + bfhi(qv.w) * bfhi(kv.w); } }
                    Sb[key] = s; mx = fmaxf(mx, s); }
                mx = wave_max(mx);
                float l = 0.f;
                for (int k0 = 0; k0 <= t; k0 += 64) { const int key = k0 + lane; const float s = Sb[key]; const float p = (key <= t) ? __builtin_amdgcn_exp2f(s - mx) : 0.f; Sb[key] = p; l += p; }
                l = wave_sum(l);
                LDS_WAIT();
                float o0 = 0.f, o1 = 0.f;
                for (int key = 0; key <= t; ++key) { const float p = Sb[key]; const unsigned v = *(const unsigned*)(kvc + (rb + key) * P_KVC + h * 256 + 128 + 2 * lane); o0 += p * bflo(v); o1 += p * bfhi(v); }
                const float il = 1.f / l;
                *(unsigned*)(co + (size_t)m * 768 + h * 128 + 2 * lane) = pk2(o0 * il, o1 * il);
                LDS_WAIT();
            }
        #else
            mla_phase(lds, QC, KVC, CLR, CO, vcu, G, tid, lane, wave);
#endif
        }
        SEAM(pb + 7);
        if (INP(8)) for (int rep_ = 0; rep_ < 1 + (int)((MK_DUP >> 8) & 1u); ++rep_) { PH_LOCALS pg8::Gemm g{XBE, WINB, MTOK, N_INB, DM, DM}; pg8::StaticOrder S; S.init(MTOK, N_INB, G, bx); EpiBf16<0, true> E{BIN, P_BIN, rs_preload(lds, SS0, S, tid)}; pg8::gemm_phase<EpiBf16<0, true>, pg8::StaticOrder, true, true>(lds, g, S, E, tid); }
        SEAM(pb + 8);
        if (INP(9)) for (int rep_ = 0; rep_ < 1 + (int)((MK_DUP >> 9) & 1u); ++rep_) { PH_LOCALS
#if MK_NAIVE_B
            LAS float* Fs = (LAS float*)lds; LAS float* Ks = Fs + 16 * 128; LAS float* Qs = Ks + 16 * 128; LAS float* Vs = Qs + 16 * 128; LAS float* Os = Vs + 16 * 48;
            const float* lbw = LBW + Lyr * 1024; const bf16* const bin = BIN; bf16* const bo = BO;
            for (int unit = bx; unit < BATCH * 8 * 2; unit += G) {
                const int half = unit & 1, chain = unit >> 1, b = chain >> 3, head = chain & 7;
                const int col = tid >> 3, seg = tid & 7;
                float st[16];
#pragma unroll
                for (int j = 0; j < 16; ++j) st[j] = 0.f;
                const int et = tid >> 5, ed = (tid & 31) * 4;
                f32x4 lb4 = *(const f32x4*)(lbw + head * 128 + ed);
                for (int t0 = 0; t0 < SEQ; t0 += 16) {
                    const size_t row0 = (size_t)b * SEQ + t0;
                    { const bf16* rp = bin + (row0 + et) * P_BIN; const u32x2 qw = *(const u32x2*)(rp + head * 128 + ed); const u32x2 zw = *(const u32x2*)(rp + 1024 + head * 128 + ed);
                      const float z[4] = {bflo(zw.x), bfhi(zw.x), bflo(zw.y), bfhi(zw.y)}; f32x4 f, k;
#pragma unroll
                      for (int j = 0; j < 4; ++j) { const float sg = sigmoidf_(z[j]); f[j] = lb4[j] + (1.f - lb4[j]) * sg; k[j] = (1.f - lb4[j]) * (1.f - sg); }
                      *(LAS f32x4*)(Fs + et * 128 + ed) = f; *(LAS f32x4*)(Ks + et * 128 + ed) = k; *(LAS f32x4*)(Qs + et * 128 + ed) = (f32x4){bflo(qw.x), bfhi(qw.x), bflo(qw.y), bfhi(qw.y)}; }
                    for (int idx = tid; idx < 16 * 48; idx += 512) { const int tt = idx / 48, c = idx - 48 * tt; Vs[idx] = bf2f(bin[(row0 + tt) * P_BIN + 2048 + head * 96 + 48 * half + c]); }
                    __syncthreads();
                    if (tid < 384) {
                        for (int tt = 0; tt < 16; ++tt) { const float vv = Vs[tt * 48 + col]; float o = 0.f;
#pragma unroll
                            for (int j4 = 0; j4 < 4; ++j4) { const f32x4 f = *(const LAS f32x4*)(Fs + tt * 128 + seg * 16 + 4 * j4), k = *(const LAS f32x4*)(Ks + tt * 128 + seg * 16 + 4 * j4), q = *(const LAS f32x4*)(Qs + tt * 128 + seg * 16 + 4 * j4);
#pragma unroll
                                for (int j = 0; j < 4; ++j) { st[4 * j4 + j] = f[j] * st[4 * j4 + j] + k[j] * vv; o += q[j] * st[4 * j4 + j]; } }
                            o += __shfl_xor(o, 1); o += __shfl_xor(o, 2); o += __shfl_xor(o, 4);
                            if (seg == 0) Os[tt * 48 + col] = o; }
                    }
                    __syncthreads();
                    for (int idx = tid; idx < 16 * 48; idx += 512) { const int tt = idx / 48, c = idx - 48 * tt; bo[(row0 + tt) * 768 + head * 96 + 48 * half + c] = (bf16)f2bf(Os[idx]); }
                }
                __syncthreads();
            }
        #else
            hgrn_phase(lds, BIN, BO, LBW + Lyr * 1024, karg_in(8) + Lyr * 96, SHB, vcu, G, tid, lane, wave);
#endif
        }
        SEAM(pb + 9);
#if !MK_NAIVE_B
        if (INP(10)) for (int rep_ = 0; rep_ < 1; ++rep_) { PH_LOCALS hgrn_fix_phase(lds, BIN, BO, karg_in(8) + Lyr * 96, SHB, vcu, G, tid, lane, wave); }
        SEAM(pb + 10);
#endif
#if MK_NAIVE_B
        if (INP(10)) for (int rep_ = 0; rep_ < 1 + (int)((MK_DUP >> 10) & 1u); ++rep_) { PH_LOCALS
            const float* gn = karg_in(8) + Lyr * 96; bf16* const bo = BO; const bf16* const bin = BIN;
            for (int m = gw; m < MTOK; m += NGW) {
                bf16* orow = bo + (size_t)m * 768 + 12 * lane; const bf16* grow = bin + (size_t)m * P_BIN + 2816 + 12 * lane;
                u32x2 a[3], gg[3]; float s = 0.f;
#pragma unroll
                for (int j = 0; j < 3; ++j) { a[j] = ((const u32x2*)orow)[j]; gg[j] = ((const u32x2*)grow)[j]; const float x0 = bflo(a[j].x), x1 = bfhi(a[j].x), x2 = bflo(a[j].y), x3 = bfhi(a[j].y); s += x0 * x0 + x1 * x1 + x2 * x2 + x3 * x3; }
                s += __shfl_xor(s, 1); s += __shfl_xor(s, 2); s += __shfl_xor(s, 4);
                const float rstd = 1.f / sqrtf(s * (1.f / 96.f) + EPS);
                const int e0 = (12 * lane) % 96;
#pragma unroll
                for (int j = 0; j < 3; ++j) { const float x[4] = {bflo(a[j].x), bfhi(a[j].x), bflo(a[j].y), bfhi(a[j].y)}; const float gv[4] = {bflo(gg[j].x), bfhi(gg[j].x), bflo(gg[j].y), bfhi(gg[j].y)}; float r[4];
#pragma unroll
                    for (int e = 0; e < 4; ++e) r[e] = x[e] * rstd * gn[e0 + 4 * j + e] * (gv[e] * sigmoidf_(gv[e]));
                    u32x2 w; w.x = pk2(r[0], r[1]); w.y = pk2(r[2], r[3]); ((u32x2*)orow)[j] = w; }
            }
        }
        SEAM(pb + 10);
#endif
        if (INP(11)) for (int rep_ = 0; rep_ < 1 + (int)((MK_DUP >> 11) & 1u); ++rep_) { PH_LOCALS pg8::Gemm g{XBE, WING, MTOK, N_ING, DM, DM}; pg8::StaticOrder S; S.init(MTOK, N_ING, G, bx); EpiGate8 E{GS, rs_preload(lds, SS0, S, tid)}; pg8::gemm_phase<EpiGate8, pg8::StaticOrder, true, true>(lds, g, S, E, tid); }
        SEAM(pb + 11);
        if (INP(12)) for (int rep_ = 0; rep_ < 1 + (int)((MK_DUP >> 12) & 1u); ++rep_) { PH_LOCALS
            { pg8::Gemm3 g{AOUT, BO, CO, WA, WBb, WC, 256, 768, 768}; pg8::StaticOrder S; S.init(MTOK, DM, G, bx); EpiMerge3 E{MG, GS}; pg8::gemm_phase_ms<EpiMerge3, pg8::StaticOrder>(lds, g, S, E, tid); }
        }
        SEAM(pb + 12);
        if (INP(13)) for (int rep_ = 0; rep_ < 1 + (int)((MK_DUP >> 13) & 1u); ++rep_) { PH_LOCALS pg8::Gemm g{MG, WO, MTOK, DM, DM, DM}; pg8::StaticOrder S; S.init(MTOK, DM, G, bx); EpiResid E{XBE, XBO, rep_ ? 0.f : 1.0f, SS1}; pg8::gemm_phase<EpiResid, pg8::StaticOrder>(lds, g, S, E, tid);
            const f32x4* pp = (const f32x4*)(karg_in(1) + (size_t)Lyr * MTOK * PLE); u32x2* po = (u32x2*)PB;
            for (size_t i = (size_t)vcu * 512 + tid; i < (size_t)MTOK * PLE / 4; i += (size_t)G * 512 * 8) { f32x4 v[8];
#pragma unroll
                for (int q = 0; q < 8; ++q) v[q] = pp[i + (size_t)q * G * 512];
#pragma unroll
                for (int q = 0; q < 8; ++q) { u32x2 w; w.x = pk2(v[q].x, v[q].y); w.y = pk2(v[q].z, v[q].w); po[i + (size_t)q * G * 512] = w; } } }
        SEAM(pb + 13);
        if (INP(15)) for (int rep_ = 0; rep_ < 1 + (int)((MK_DUP >> 15) & 1u); ++rep_) { PH_LOCALS pg8::Gemm g{XBO, W2U, MTOK, 2 * DFF, DM, DM}; pg8::StaticOrder S; S.init(MTOK, 2 * DFF, G, bx); EpiSwiglu E{H, rs_preload(lds, SS1, S, tid)}; pg8::gemm_phase<EpiSwiglu, pg8::StaticOrder, true, true>(lds, g, S, E, tid); }
        SEAM(pb + 15);
        if (INP(16)) for (int rep_ = 0; rep_ < 1 + (int)((MK_DUP >> 16) & 1u); ++rep_) { PH_LOCALS pg8::Gemm g{H, W2D, MTOK, DM, DFF, DFF}; pg8::StaticOrder S; S.init(MTOK, DM, G, bx); EpiResid E{XBO, XBE, rep_ ? 0.f : 0.5f, SS0}; pg8::gemm_phase<EpiResid, pg8::StaticOrder>(lds, g, S, E, tid); }
        SEAM(pb + 16);
        if (INP(18)) for (int rep_ = 0; rep_ < 1 + (int)((MK_DUP >> 18) & 1u); ++rep_) { PH_LOCALS
            { pg8::Gemm g{PB, WPP, MTOK, DM, PLE, PLE}; pg8::StaticOrder S; S.init(MTOK, DM, G, bx); EpiBf16<0, false> E{PP, DM, RsTab{nullptr, 0}}; pg8::gemm_phase<EpiBf16<0, false>, pg8::StaticOrder>(lds, g, S, E, tid); }
            { pg8::Gemm g{XBE, WPG, MTOK, DM, DM, DM}; pg8::StaticOrder S; S.init(MTOK, DM, G, bx); EpiPle E{XBE, PP, rs_preload(lds, SS0, S, tid), XBO, SS1}; pg8::gemm_phase<EpiPle, pg8::StaticOrder, true, true>(lds, g, S, E, tid); }
            if (Lyr + 1 < DEPTH) WPREP(Lyr + 1, 1);
        }
        SEAM(pb + 18);
    }
    if (IN(DEPTH * NPH)) { PH_LOCALS
        const float* gf = karg_in(23); float* const xo = X; const bf16* const xb = XBO;
        f32x4 gv[4];
#pragma unroll
        for (int j = 0; j < 4; ++j) gv[j] = ((const GAS f32x4*)gf + lane)[64 * j];
        for (int m0 = gw; m0 < MTOK; m0 += 4 * NGW) {
            u32x2 w[4][4];
#pragma unroll
            for (int q = 0; q < 4; ++q) { const GAS u32x2* xr = (const GAS u32x2*)(xb + (size_t)(m0 + q * NGW) * DM) + lane;
#pragma unroll
                for (int j = 0; j < 4; ++j) w[q][j] = xr[64 * j]; }
            float sq[4];
#pragma unroll
            for (int q = 0; q < 4; ++q) { float t = 0.f;
#pragma unroll
                for (int j = 0; j < 4; ++j) { const float x0 = pg8::f16lo(w[q][j].x), x1 = pg8::f16hi(w[q][j].x), x2 = pg8::f16lo(w[q][j].y), x3 = pg8::f16hi(w[q][j].y); t += (x0 * x0 + x1 * x1) + (x2 * x2 + x3 * x3); }
                sq[q] = t; }
#pragma unroll
            for (int o = 1; o < 64; o <<= 1) {
#pragma unroll
                for (int q = 0; q < 4; ++q) sq[q] += __shfl_xor(sq[q], o); }
#pragma unroll
            for (int q = 0; q < 4; ++q) { GAS f32x4* orow = (GAS f32x4*)(xo + (size_t)(m0 + q * NGW) * DM) + lane; const float rstd = 1.f / sqrtf(sq[q] * (1.f / DM) + EPS);
#pragma unroll
                for (int j = 0; j < 4; ++j) { const f32x4 v = (f32x4){pg8::f16lo(w[q][j].x), pg8::f16hi(w[q][j].x), pg8::f16lo(w[q][j].y), pg8::f16hi(w[q][j].y)}; orow[64 * j] = v * rstd * gv[j]; } }
        }
    }
#undef IN
#undef SEAM
}
#undef X
#undef WSP
#undef ropeA
#undef ropeC
#undef LBW
#undef W1U
#undef W1D
#undef WIN1
#undef WINB
#undef WING
#undef WQB
#undef WKVB
#undef WA
#undef WBb
#undef WC
#undef WO
#undef W2U
#undef W2D
#undef WPG
#undef WPP
#undef XN
#undef XBE
#undef XBO
#undef SS0
#undef SS1
#undef MG
#undef H
#undef QKVA
#undef CLR
#undef QC
#undef CO
#undef KVC
#undef AOUT
#undef AOG
#undef LSEB
#undef SHB
#undef BIN
#undef BO
#undef GS
#undef PB
#undef PP
#undef PH_LOCALS
#undef WPREP
#undef INP


#ifdef MK_CHECK
constexpr size_t WS_STASH = 978 * MiB;
constexpr int CHK_WORDS = 8192;
__device__ __forceinline__ unsigned hash_u(unsigned x) { x ^= x >> 16; x *= 0x7feb352du; x ^= x >> 15; x *= 0x846ca68bu; x ^= x >> 16; return x; }
__device__ __forceinline__ float dot_bw(const bf16* a, const float* W, int K, int ldw, int col) { float s = 0.f; for (int k = 0; k < K; ++k) s += bf2f(a[k]) * W[(size_t)k * ldw + col]; return s; }
__device__ __forceinline__ void chk_add(unsigned* ctl, int k, float got, float exp_, float atol) {
    const bool bad = !(fabsf(got - exp_) <= 0.05f * fabsf(exp_) + atol);
    atomicAdd(&ctl[CHK_WORDS + 2 * k + 1], 1u); if (bad) atomicAdd(&ctl[CHK_WORDS + 2 * k], 1u);
}
__device__ __forceinline__ void rope_pair(float x1, float x2, int pos, int f, float theta, int dim, bool second, float& out) {
    const float inv = 1.0f / powf(theta, (float)(2 * f) / (float)dim); const float ang = (float)pos * inv; const float c = cosf(ang), s = sinf(ang);
    out = second ? (x2 * c + x1 * s) : (x1 * c - x2 * s);
}
__global__ void __launch_bounds__(512) mk_check(Args args, int p, int Lyr) {
    unsigned char* ws = args.ws; unsigned* ctl = (unsigned*)(ws + WS_CTL);
    const unsigned gt = blockIdx.x * 512 + threadIdx.x; const unsigned h0 = hash_u(gt * 2654435761u + 977u * (unsigned)p + 1u), h1 = hash_u(h0 + 0x9e3779b9u), h2 = hash_u(h1 + 0x85ebca6bu);
    const int m = (int)(h0 % MTOK), pos = m & (SEQ - 1);
    float* X = args.out; float* XS = (float*)(ws + WS_STASH); bf16* BS = (bf16*)(ws + WS_STASH + 4 * MiB);
    const bf16* XN = (const bf16*)(ws + WS_XN); const bf16* H = (const bf16*)(ws + WS_H); const bf16* QKVA = (const bf16*)(ws + WS_QKVA); const bf16* CLR = (const bf16*)(ws + WS_CLR);
    const bf16* QC = (const bf16*)(ws + WS_QC); const bf16* KVC = (const bf16*)(ws + WS_KVC); const bf16* CO = (const bf16*)(ws + WS_CO); const bf16* AOUT = (const bf16*)(ws + WS_AOUT);
    const bf16* BIN = (const bf16*)(ws + WS_BIN); const bf16* BO = (const bf16*)(ws + WS_BO); const bf16* GS = (const bf16*)(ws + WS_GS); const bf16* MG = (const bf16*)(ws + WS_MG);
    const bf16* PB = (const bf16*)(ws + WS_PB); const float* LBW = (const float*)(ws + WS_LB);
    const float* win = args.in[6] + (size_t)Lyr * DM * INW;
    auto stashX = [&]() { for (size_t i = gt; i < (size_t)1024 * 1024; i += (size_t)gridDim.x * 512) { const size_t r = i >> 10, c = i & 1023; XS[i] = X[(r * 64) * DM + c]; } };
    if (p == 0 || p == 3 || p == 14 || p == 17) {
        const int gi = (p == 0) ? 2 : (p == 3) ? 5 : (p == 14) ? 17 : 20; const float* g = args.in[gi] + Lyr * DM; const float* x = (p == 0 && Lyr == 0) ? args.in[0] : X;
        const int c = h1 % DM; float ss = 0.f; for (int k = 0; k < DM; ++k) { const float v = x[(size_t)m * DM + k]; ss += v * v; }
        chk_add(ctl, p, bf2f(XN[(size_t)m * DM + c]), x[(size_t)m * DM + c] / sqrtf(ss / DM + EPS) * g[c], 0.03f);
        if (p == 0) {
            const bf16* Wb = (const bf16*)(ws + WS_W); const int which = h2 % 6; const unsigned r1 = hash_u(h2 + 17u), r2 = hash_u(r1 + 29u);
            if (which == 0) { const int n = r1 % N_ING, k = r2 % 1024; chk_add(ctl, 24, bf2f(Wb[W_ING / 2 + (size_t)n * 1024 + k]), bf2f((bf16)f2bf(win[(size_t)k * INW + O_G + n])), 1e-6f); }
            if (which == 1) { const int n = r1 % N_INB, k = r2 % 1024; chk_add(ctl, 25, bf2f(Wb[W_INB / 2 + (size_t)n * 1024 + k]), bf2f((bf16)f2bf(win[(size_t)k * INW + O_B + n])), 1e-6f); }
            if (which == 2) { const int n = r1 % 1024, k = r2 % DFF; chk_add(ctl, 26, bf2f(Wb[W_1D / 2 + (size_t)n * DFF + k]), bf2f((bf16)f2bf((args.in[4] + (size_t)Lyr * DFF * DM)[(size_t)k * DM + n])), 1e-6f); }
            if (which == 3) { const int n = r1 % 1024, k = r2 % 1024; chk_add(ctl, 27, bf2f(Wb[W_O / 2 + (size_t)n * 1024 + k]), bf2f((bf16)f2bf((args.in[16] + (size_t)Lyr * DM * DM)[(size_t)k * DM + n])), 1e-6f); }
            if (which == 4) { const int n = r1 % 1024, k = r2 % 768; chk_add(ctl, 28, bf2f(Wb[W_C / 2 + (size_t)n * 768 + k]), bf2f((bf16)f2bf((args.in[15] + (size_t)Lyr * 768 * DM)[(size_t)k * DM + n])), 1e-6f); }
            if (which == 5) { const int n = r1 % 1024, k = r2 % 1024; chk_add(ctl, 29, bf2f(Wb[W_PG / 2 + (size_t)n * 1024 + k]), bf2f((bf16)f2bf((args.in[21] + (size_t)Lyr * DM * DM)[(size_t)k * DM + n])), 1e-6f); }
        }
        if (p == 14 || p == 17) stashX();
        if (p == 17) { const float* pp = args.in[1] + (size_t)Lyr * MTOK * PLE; const int j = h2 % PLE; chk_add(ctl, 19, bf2f(PB[(size_t)m * PLE + j]), pp[(size_t)m * PLE + j], 0.03f); }
    } else if (p == 1 || p == 15) {
        const float* W = args.in[p == 1 ? 3 : 18] + (size_t)Lyr * DM * 2 * DFF; const int j = h1 % DFF;
        const float a = dot_bw(XN + (size_t)m * DM, W, DM, 2 * DFF, j), b = dot_bw(XN + (size_t)m * DM, W, DM, 2 * DFF, DFF + j);
        chk_add(ctl, p, bf2f(H[(size_t)m * DFF + j]), a / (1.f + expf(-a)) * b, 0.02f);
    } else if (p == 2 || p == 16) {
        const float* W = args.in[p == 2 ? 4 : 19] + (size_t)Lyr * DFF * DM; const int c = h1 % DM;
        if (p == 2 && Lyr == 0) { chk_add(ctl, p, X[(size_t)m * DM + c], args.in[0][(size_t)m * DM + c] + 0.5f * dot_bw(H + (size_t)m * DFF, W, DFF, DM, c), 0.03f); }
        else if (p == 16) { const int r = h0 % 1024; const size_t mm = (size_t)r * 64; chk_add(ctl, p, X[mm * DM + c], XS[(size_t)r * DM + c] + 0.5f * dot_bw(H + mm * DFF, W, DFF, DM, c), 0.03f); }
    } else if (p == 4) {
        const bf16* a = XN + (size_t)m * DM; const int kind = h1 % 4;
        if (kind < 3) { const int which = kind, head = (h1 >> 8) % 12, d = (h2 >> 4) % 64; const int cb = which * 768 + head * 64; float val; int phys = d;
            if (which < 2 && d < 16) { const int i = d & 7; const float x1 = dot_bw(a, win, DM, INW, cb + i), x2 = dot_bw(a, win, DM, INW, cb + i + 8); rope_pair(x1, x2, pos, i, 500000.0f, 16, d >= 8, val); phys = (d < 8) ? 2 * d : 2 * (d - 8) + 1; }
            else val = dot_bw(a, win, DM, INW, cb + d);
            if (which == 0) val *= QSCALE_A;
            chk_add(ctl, 4, bf2f(QKVA[(size_t)m * P_QKVA + cb + phys]), val, which == 0 ? 0.006f : 0.03f);
        } else { const int sub = (h1 >> 8) % 3;
            if (sub == 0) { const int j = h2 % 384; chk_add(ctl, 20, bf2f(CLR[(size_t)m * P_CLR + j]), dot_bw(a, win, DM, INW, O_CQ + j), 0.03f); }
            else if (sub == 1) { const int j = h2 % 256; chk_add(ctl, 20, bf2f(CLR[(size_t)m * P_CLR + 512 + j]), dot_bw(a, win, DM, INW, O_CKV + j), 0.03f); }
            else { const int d = h2 % 64, i = d & 31; const float x1 = dot_bw(a, win, DM, INW, O_CKR + i), x2 = dot_bw(a, win, DM, INW, O_CKR + i + 32); float val; rope_pair(x1, x2, pos, i, 10000.0f, 64, d >= 32, val);
                const int phys = (d < 32) ? 2 * d : 2 * (d - 32) + 1; chk_add(ctl, 21, bf2f(CLR[(size_t)m * P_CLR + 768 + phys]), val, 0.03f); } }
    } else if (p == 5) {
        { const float* gq = args.in[9] + Lyr * 384; const float* gkv = args.in[11] + Lyr * 256; float s = 0.f; for (int j = 0; j < 384; ++j) { const float v = bf2f(CLR[(size_t)m * P_CLR + j]) / gq[j]; s += v * v; }
          chk_add(ctl, 22, s / 384.f, 1.0f, 0.0f); float s2 = 0.f; for (int j = 0; j < 256; ++j) { const float v = bf2f(CLR[(size_t)m * P_CLR + 512 + j]) / gkv[j]; s2 += v * v; } chk_add(ctl, 22, s2 / 256.f, 1.0f, 0.0f); }
    } else if (p == 6) {
        {
        const int hh = h1 % 4, d = (h1 >> 8) % 64; float og[3], lse[3];
        for (int g = 0; g < 3; ++g) { const int dil = (g == 0) ? 1 : (g == 1) ? 4 : 16, head = 4 * g + hh; float mx = -1e30f, l = 0.f, o = 0.f;
            for (int i = 0; i <= 128 && pos - i * dil >= 0; ++i) { const bf16* q = QKVA + (size_t)m * P_QKVA + head * 64; const bf16* k = QKVA + (size_t)(m - i * dil) * P_QKVA + 768 + head * 64; float s = 0.f; for (int e = 0; e < 64; ++e) s += bf2f(q[e]) * bf2f(k[e]);
                s *= 0.6931471805599453f; const float mn = fmaxf(mx, s), al = expf(mx - mn), pp = expf(s - mn); l = l * al + pp; o = o * al + pp * bf2f(QKVA[(size_t)(m - i * dil) * P_QKVA + 1536 + head * 64 + d]); mx = mn; }
            og[g] = o / l; lse[g] = mx + logf(l); }
        const float ml = fmaxf(lse[0], fmaxf(lse[1], lse[2])); const float w0 = expf(lse[0] - ml), w1 = expf(lse[1] - ml), w2 = expf(lse[2] - ml);
        chk_add(ctl, 5, bf2f(AOUT[(size_t)m * 256 + hh * 64 + d]), (w0 * og[0] + w1 * og[1] + w2 * og[2]) / (w0 + w1 + w2), 0.01f);
        }
        const float* wqb = args.in[10] + (size_t)Lyr * 384 * 1152; const float* wkvb = args.in[12] + (size_t)Lyr * 256 * 1536; const bf16* a = CLR + (size_t)m * P_CLR;
        if (h1 & 1) { const int h = (h1 >> 4) % 6, d = (h2 >> 4) % 192; float val; int phys = d;
            if (d >= 128) { const int e = d - 128, i = e & 31; const float x1 = dot_bw(a, wqb, 384, 1152, h * 192 + 128 + i), x2 = dot_bw(a, wqb, 384, 1152, h * 192 + 128 + i + 32); rope_pair(x1, x2, pos, i, 10000.0f, 64, e >= 32, val); phys = 128 + ((e < 32) ? 2 * e : 2 * (e - 32) + 1); }
            else val = dot_bw(a, wqb, 384, 1152, h * 192 + d);
            chk_add(ctl, 6, bf2f(QC[(size_t)m * P_QC + h * 192 + phys]), val * QSCALE_C, 0.004f);
        } else { const int c = h2 % 1536; chk_add(ctl, 23, bf2f(KVC[(size_t)m * P_KVC + c]), dot_bw(a + 512, wkvb, 256, 1536, c), 0.03f); }
    } else if (p == 7) {
        if (gt < 16384) { const int h = h1 % 6, d = (h1 >> 8) % 128; const size_t rb = (size_t)(m - pos); float mx = -1e30f, l = 0.f, o = 0.f; const bf16* q = QC + (size_t)m * P_QC + h * 192;
            for (int key = 0; key <= pos; ++key) { const bf16* k = KVC + (rb + key) * P_KVC + h * 256; const bf16* r = CLR + (rb + key) * P_CLR + 768; float s = 0.f; for (int e = 0; e < 128; ++e) s += bf2f(q[e]) * bf2f(k[e]); for (int e = 0; e < 64; ++e) s += bf2f(q[128 + e]) * bf2f(r[e]);
                s *= 0.6931471805599453f; const float mn = fmaxf(mx, s), al = expf(mx - mn), pp = expf(s - mn); l = l * al + pp; o = o * al + pp * bf2f(k[128 + d]); mx = mn; }
            chk_add(ctl, 7, bf2f(CO[(size_t)m * 768 + h * 128 + d]), o / l, 0.01f); }
    } else if (p == 8) { const int c = h1 % N_INB; chk_add(ctl, 8, bf2f(BIN[(size_t)m * P_BIN + c]), dot_bw(XN + (size_t)m * DM, win, DM, INW, O_B + c), 0.03f);
    } else if (p == 9) {
        if (gt < 32768) { const int head = h1 % 8, vc = (h1 >> 8) % 96; const float* lb = LBW + Lyr * 1024 + head * 128; float o = 0.f;
            for (int d = 0; d < 128; ++d) { float prod = 1.f, acc = 0.f; const float lbd = lb[d];
                for (int s = pos; s >= 0 && s > pos - 512; --s) { const bf16* r = BIN + (size_t)(m - pos + s) * P_BIN; const float z = bf2f(r[1024 + head * 128 + d]); const float sg = 1.f / (1.f + expf(-z)); const float f = lbd + (1.f - lbd) * sg, k = (1.f - lbd) * (1.f - sg);
                    acc += prod * k * bf2f(r[2048 + head * 96 + vc]); prod *= f; if (prod < 1e-9f) break; }
                o += bf2f(BIN[(size_t)m * P_BIN + head * 128 + d]) * acc; }
            chk_add(ctl, 9, bf2f(BO[(size_t)m * 768 + head * 96 + vc]), o, 0.03f); }
        for (size_t i = gt; i < (size_t)1024 * 768; i += (size_t)gridDim.x * 512) { const size_t r = i / 768, c = i % 768; BS[i] = BO[(r * 64) * 768 + c]; }
    } else if (p == 10) { const int r = h0 % 1024, head = h1 % 8, e = (h1 >> 8) % 96; const size_t mm = (size_t)r * 64; const float* gn = args.in[8] + Lyr * 96; float s = 0.f; for (int j = 0; j < 96; ++j) { const float v = bf2f(BS[(size_t)r * 768 + head * 96 + j]); s += v * v; }
        const float gv = bf2f(BIN[mm * P_BIN + 2816 + head * 96 + e]); chk_add(ctl, 10, bf2f(BO[mm * 768 + head * 96 + e]), bf2f(BS[(size_t)r * 768 + head * 96 + e]) / sqrtf(s / 96.f + EPS) * gn[e] * gv / (1.f + expf(-gv)), 0.02f);
    } else if (p == 11) { const int c = h1 % N_ING; const float a = dot_bw(XN + (size_t)m * DM, win, DM, INW, O_G + c); chk_add(ctl, 11, bf2f(GS[(size_t)m * P_GS + c]), 1.f / (1.f + expf(-a)), 0.01f);
    } else if (p == 12) { const int c = h1 % DM; const float ya = dot_bw(AOUT + (size_t)m * 256, args.in[13] + (size_t)Lyr * 256 * DM, 256, DM, c), yb = dot_bw(BO + (size_t)m * 768, args.in[14] + (size_t)Lyr * 768 * DM, 768, DM, c), yc = dot_bw(CO + (size_t)m * 768, args.in[15] + (size_t)Lyr * 768 * DM, 768, DM, c);
        chk_add(ctl, 12, bf2f(MG[(size_t)m * DM + c]), bf2f(GS[(size_t)m * P_GS + c]) * ya + bf2f(GS[(size_t)m * P_GS + 1024 + c]) * yb + bf2f(GS[(size_t)m * P_GS + 2048 + c]) * yc, 0.02f); stashX();
    } else if (p == 13) { const int r = h0 % 1024, c = h1 % DM; const size_t mm = (size_t)r * 64; chk_add(ctl, 13, X[mm * DM + c], XS[(size_t)r * DM + c] + dot_bw(MG + mm * DM, args.in[16] + (size_t)Lyr * DM * DM, DM, DM, c), 0.03f);
    } else if (p == 18) { const int r = h0 % 1024, c = h1 % DM; const size_t mm = (size_t)r * 64; const float a = dot_bw(XN + mm * DM, args.in[21] + (size_t)Lyr * DM * DM, DM, DM, c), b = dot_bw(PB + mm * PLE, args.in[22] + (size_t)Lyr * PLE * DM, PLE, DM, c);
        chk_add(ctl, 18, X[mm * DM + c], XS[(size_t)r * DM + c] + b / (1.f + expf(-a)), 0.03f); }
}
__global__ void mk_verdict(Args args) {
    const unsigned* ctl = (const unsigned*)(args.ws + WS_CTL); float val = 0.f;
#ifdef MK_REPORT_K
    { const unsigned bad = ctl[CHK_WORDS + 2 * MK_REPORT_K], tot = ctl[CHK_WORDS + 2 * MK_REPORT_K + 1]; val = (tot == 0) ? 100.f : 3.f + 60.f * (float)bad / (float)tot; }
#else
    for (int k = 0; k < 32; ++k) { const unsigned bad = ctl[CHK_WORDS + 2 * k], tot = ctl[CHK_WORDS + 2 * k + 1]; if (bad > tot / 512 + 2) { val = 3.f * (k + 1); break; } }
#endif
    for (size_t i = (size_t)blockIdx.x * blockDim.x + threadIdx.x; i < (size_t)MTOK * DM; i += (size_t)gridDim.x * blockDim.x) args.out[i] = val;
}
#endif
extern "C" void kernel_launch(void* const* d_in, const int* in_sizes, int n_in, void* d_out, int out_size, void* d_ws, size_t ws_size, hipStream_t stream) {
    static int grid = 0;
    if (grid == 0) {
        if (n_in != 24 || in_sizes[0] != MTOK * DM || out_size != MTOK * DM || ws_size < WS_END + 8 * MiB) { fprintf(stderr, "kernel_launch: unexpected shapes (n_in %d, ws %zu); nothing launched\n", n_in, ws_size); grid = -1; return; }
        int dev = 0, cus = 0, per_cu = 0;
        if (hipGetDevice(&dev) != hipSuccess || hipDeviceGetAttribute(&cus, hipDeviceAttributeMultiprocessorCount, dev) != hipSuccess) { grid = -1; return; }
        if (hipFuncSetAttribute((const void*)mk_fwd, hipFuncAttributeMaxDynamicSharedMemorySize, LDS_BYTES) != hipSuccess) { fprintf(stderr, "kernel_launch: hipFuncSetAttribute failed\n"); grid = -1; return; }
        if (hipOccupancyMaxActiveBlocksPerMultiprocessor(&per_cu, (const void*)mk_fwd, 512, LDS_BYTES) != hipSuccess || per_cu < 1) fprintf(stderr, "kernel_launch: occupancy query reports %d\n", per_cu);
        (void)hipGetLastError();
        grid = cus;
        if (grid != 256) { fprintf(stderr, "kernel_launch: built for the 256-CU MI355X (unit deal of the GEMM phases, rstd tables); found %d CUs; nothing launched\n", grid); grid = -1; return; }
    }
    if (grid < 0) return;
    if (hipMemsetAsync((char*)d_ws + WS_CTL, 0, CTL_ZERO_BYTES, stream) != hipSuccess) return;
    Args a{};
    for (int i = 0; i < 24; ++i) a.in[i] = (const float*)d_in[i];
    a.out = (float*)d_out; a.ws = (unsigned char*)d_ws;
#if MK_N_LAUNCHES == 1
    a.ph_lo = 0; a.ph_hi = NPHASES;
    hipLaunchKernelGGL(mk_fwd, dim3(grid), dim3(512), LDS_BYTES, stream, a);
#elif defined(MK_CHECK)
    for (int p = 0; p < NPH * (MK_CHECK + 1); ++p) {
#ifdef MK_SKIP
        if ((MK_SKIP >> (p % NPH)) & 1u) continue;
#endif
        a.ph_lo = p; a.ph_hi = p + 1; hipLaunchKernelGGL(mk_fwd, dim3(grid), dim3(512), LDS_BYTES, stream, a);
        if (p / NPH == MK_CHECK) hipLaunchKernelGGL(mk_check, dim3(256), dim3(512), 0, stream, a, p % NPH, p / NPH); }
    hipLaunchKernelGGL(mk_verdict, dim3(1024), dim3(256), 0, stream, a);
#else
    for (int p = 0; p < NPHASES; ++p) { a.ph_lo = p; a.ph_hi = p + 1; hipLaunchKernelGGL(mk_fwd, dim3(grid), dim3(512), LDS_BYTES, stream, a); }
#endif
}
```

```cpp
#include <hip/hip_runtime.h>
#include <cstdio>
#include <cstdint>

#ifndef MK_DUP
#define MK_DUP 0u
#endif
#define MK_NAIVE_A 0
#define MK_NAIVE_C 0
#define MK_NAIVE_B 0
#ifndef PH_MASK
#define PH_MASK 0xFFFFFFFFu
#endif
#ifndef MK_N_LAUNCHES
#define MK_N_LAUNCHES 1
#endif

namespace pg8 {
#define PG8_LAS __attribute__((address_space(3)))
typedef unsigned short bf16_t;
typedef short bf16x8 __attribute__((ext_vector_type(8)));
typedef float f32x4 __attribute__((ext_vector_type(4)));
typedef unsigned u32x4 __attribute__((ext_vector_type(4)));
typedef unsigned u32x2 __attribute__((ext_vector_type(2)));
constexpr int BM = 256, BK = 64, HALF = 128, HTB = HALF * BK * 2  , STAGE_BYTES = 8 * HTB, NXCD = 8, WGM = 8;

__host__ __device__ __forceinline__ int lds_byte(int r, int c) { const int st = (r >> 4) * 2 + (c >> 5), rr = r & 15, cc = c & 31, ob = rr * 64 + cc * 2; return st * 1024 + (ob ^ (((ob >> 9) & 1) << 5)); }
__host__ __device__ __forceinline__ void stage_rc(int b, int& R, int& C) { const int st = b / 1024, sb = b % 1024, swz = sb ^ (((sb >> 9) & 1) << 5); R = (st >> 1) * 16 + swz / 64; C = (st & 1) * 32 + (swz % 64) / 2; }
__host__ __device__ __forceinline__ int perm32(int rho) { const int n = rho >> 4, i = rho & 15; return 8 * (i >> 2) + 4 * n + (i & 3); }

struct Unit { int pm, pn; };
struct Gemm { const bf16_t* A; const bf16_t* Bt; int M, N, K, lda; };

struct StaticOrder {
    int nM, nN, nwg, G, c;
    __host__ __device__ void init(int M, int N, int G_, int c_) { nM = M / BM; nN = N / BM; nwg = nM * nN; G = G_; c = c_; }
    __host__ __device__ bool next(int i, Unit& u) const {
        const long L = (long)i * G + c; if (L >= nwg) return false;
        int wgid = (int)L; { const int q = nwg / NXCD, r = nwg % NXCD, xcd = wgid % NXCD, off = wgid / NXCD; wgid = (xcd < r ? xcd * (q + 1) : r * (q + 1) + (xcd - r) * q) + off; }
        const int nig = WGM * nN, gid = wgid / nig, fm = gid * WGM, gsz = (nM - fm) < WGM ? (nM - fm) : WGM;
        u.pm = fm + ((wgid % nig) % gsz); u.pn = (wgid % nig) / gsz; return true;
    }
    __device__ __forceinline__ void a_ready(const Unit&) const {}
    __device__ __forceinline__ void done(const Unit&) const {}
};

typedef float f32x2_t __attribute__((ext_vector_type(2))); typedef __bf16 bf16x2_t __attribute__((ext_vector_type(2)));
__device__ __forceinline__ unsigned cvt_pk_bf16(float lo, float hi) { f32x2_t v = {lo, hi}; bf16x2_t b = __builtin_convertvector(v, bf16x2_t); return __builtin_bit_cast(unsigned, b); }
typedef _Float16 f16x2_t __attribute__((ext_vector_type(2))); typedef _Float16 f16x8_t __attribute__((ext_vector_type(8)));
__device__ __forceinline__ unsigned cvt_pk_f16(float lo, float hi) { f32x2_t v = {lo, hi}; f16x2_t h = __builtin_convertvector(v, f16x2_t); return __builtin_bit_cast(unsigned, h); }
__device__ __forceinline__ float f16lo(unsigned u) { return (float)__builtin_bit_cast(f16x2_t, u)[0]; }
__device__ __forceinline__ float f16hi(unsigned u) { return (float)__builtin_bit_cast(f16x2_t, u)[1]; }

template <class Epi, class Sched, bool ALIGN_EPI = true, bool F16 = false>
__device__ __forceinline__ void gemm_phase(PG8_LAS unsigned char* lds, const Gemm g, const Sched& S, const Epi& E, int tid_in) {
    int tid_ = tid_in; asm volatile("" : "+v"(tid_));
    const int tid = tid_, wid = __builtin_amdgcn_readfirstlane(tid >> 6), lane = tid & 63, wr = wid >> 2, wc = wid & 3, fr = lane & 15, fq = lane >> 4;
    const int K = g.K, nt = K / BK, lda = g.lda;
    unsigned voffA[2], voffB[2];
#pragma unroll
    for (int i = 0; i < 2; ++i) { int R, C; stage_rc(tid * 16 + i * 8192, R, C); const int Rb = Epi::PERM ? ((R & ~31) + perm32(R & 31)) : R;
        voffA[i] = (unsigned)(R * lda + C) * 2u; voffB[i] = (unsigned)(Rb * K + C) * 2u; }
    const size_t kstep = (size_t)(BK * 2);
    const size_t hstepA = (size_t)HALF * lda * 2, hstepB = (size_t)HALF * K * 2;
    const size_t tstepA = 2 * hstepA, tstepB = 2 * hstepB;
    const unsigned ldsw = (unsigned)wid * 1024u;
    const int aoff = lds_byte(wr * 64 + fr, fq * 8), boff = lds_byte(wc * 32 + fr, fq * 8);
#define PG8_SA(b, h) (((b) * 2 + (h)) * HTB)
#define PG8_SB(b, h) ((4 + (b) * 2 + (h)) * HTB)
#define PG8_STAGE(bufoff, gbase, voff) do { _Pragma("unroll") for (int _i = 0; _i < 2; ++_i) \
        __builtin_amdgcn_global_load_lds((const unsigned*)((const char*)(gbase) + (voff)[_i]), (PG8_LAS unsigned*)(lds + (bufoff) + ldsw + _i * 8192), 16, 0, 0); } while (0)
#define PG8_LDA(dst, b, h) do { _Pragma("unroll") for (int m = 0; m < 4; ++m) _Pragma("unroll") for (int k = 0; k < 2; ++k) dst[m][k] = *(const PG8_LAS bf16x8*)(lds + PG8_SA(b, h) + aoff + m * 2048 + k * 1024); } while (0)
#define PG8_LDB(dst, b, h) do { _Pragma("unroll") for (int n = 0; n < 2; ++n) _Pragma("unroll") for (int k = 0; k < 2; ++k) dst[n][k] = *(const PG8_LAS bf16x8*)(lds + PG8_SB(b, h) + boff + n * 2048 + k * 1024); } while (0)
#define PG8_MMA(ai, bj, At, Bt) do { __builtin_amdgcn_s_setprio(1); _Pragma("unroll") for (int m = 0; m < 4; ++m) _Pragma("unroll") for (int n = 0; n < 2; ++n) _Pragma("unroll") for (int k = 0; k < 2; ++k) \
        { if constexpr (F16) acc[ai][bj][m][n] = __builtin_amdgcn_mfma_f32_16x16x32_f16(__builtin_bit_cast(f16x8_t, Bt[n][k]), __builtin_bit_cast(f16x8_t, At[m][k]), acc[ai][bj][m][n], 0, 0, 0); \
          else acc[ai][bj][m][n] = __builtin_amdgcn_mfma_f32_16x16x32_bf16(Bt[n][k], At[m][k], acc[ai][bj][m][n], 0, 0, 0); } __builtin_amdgcn_s_setprio(0); } while (0)
#define PG8_WAIT_V(n) asm volatile("s_waitcnt vmcnt(" #n ")" ::: "memory")
#define PG8_WAIT_L(n) asm volatile("s_waitcnt lgkmcnt(" #n ")" ::: "memory")
#define PG8_BAR __builtin_amdgcn_s_barrier()
#define PG8_SCHED __builtin_amdgcn_sched_barrier(0)
    Unit cur, nxt; int ui = 0;
    if (!S.next(0, cur)) return;
    f32x4 acc[2][2][4][2];
#pragma unroll
    for (int a = 0; a < 2; ++a)
#pragma unroll
        for (int b = 0; b < 2; ++b)
#pragma unroll
            for (int m = 0; m < 4; ++m)
#pragma unroll
                for (int n = 0; n < 2; ++n) acc[a][b][m][n] = (f32x4){0.f, 0.f, 0.f, 0.f};
    bf16x8 At[4][2], B0[2][2], B1[2][2];
    const char* cA = (const char*)g.A + (size_t)cur.pm * tstepA; const char* cB = (const char*)g.Bt + (size_t)cur.pn * tstepB;
    S.a_ready(cur);
    PG8_STAGE(PG8_SB(0, 0), cB, voffB); PG8_STAGE(PG8_SB(0, 1), cB + hstepB, voffB); PG8_STAGE(PG8_SA(0, 0), cA, voffA); PG8_STAGE(PG8_SA(0, 1), cA + hstepA, voffA);
    if (wr == 1) PG8_BAR;
    PG8_WAIT_V(2); PG8_BAR;
    PG8_STAGE(PG8_SB(1, 0), cB + kstep, voffB); PG8_STAGE(PG8_SA(1, 0), cA + kstep, voffA); PG8_STAGE(PG8_SB(1, 1), cB + hstepB + kstep, voffB);
    PG8_WAIT_V(6); PG8_BAR;
    for (;;) {
        const bool has_next = S.next(ui + 1, nxt);
        const char* nA = has_next ? (const char*)g.A + (size_t)nxt.pm * tstepA : cA; const char* nB = has_next ? (const char*)g.Bt + (size_t)nxt.pn * tstepB : cB;
#pragma unroll 1
        for (int t = 0; t < nt; t += 2) {
            const bool last = (t == nt - 2);
            const char* a1 = cA + (size_t)(t + 1) * kstep;
            const char* a2 = last ? nA : cA + (size_t)(t + 2) * kstep; const char* b2 = last ? nB : cB + (size_t)(t + 2) * kstep;
            const char* a3 = a2 + kstep; const char* b3 = b2 + kstep;
            if (last && has_next) S.a_ready(nxt);
            PG8_LDB(B0, 0, 0); PG8_LDB(B1, 0, 1); PG8_SCHED; PG8_LDA(At, 0, 0); PG8_STAGE(PG8_SA(1, 1), a1 + hstepA, voffA);
            PG8_WAIT_V(8); PG8_WAIT_L(0); PG8_BAR; PG8_MMA(0, 0, At, B0); PG8_MMA(0, 1, At, B1); PG8_BAR; PG8_SCHED;
            PG8_LDA(At, 0, 1); PG8_STAGE(PG8_SB(0, 0), b2, voffB); PG8_STAGE(PG8_SB(0, 1), b2 + hstepB, voffB); PG8_STAGE(PG8_SA(0, 0), a2, voffA);
            PG8_WAIT_V(8); PG8_WAIT_L(0); PG8_BAR; PG8_MMA(1, 0, At, B0); PG8_MMA(1, 1, At, B1); PG8_BAR; PG8_SCHED;
            PG8_LDB(B0, 1, 0); PG8_LDB(B1, 1, 1); PG8_SCHED; PG8_LDA(At, 1, 0); PG8_STAGE(PG8_SA(0, 1), a2 + hstepA, voffA);
            PG8_WAIT_V(8); PG8_WAIT_L(0); PG8_BAR; PG8_MMA(0, 0, At, B0); PG8_MMA(0, 1, At, B1); PG8_BAR; PG8_SCHED;
            PG8_LDA(At, 1, 1); PG8_STAGE(PG8_SB(1, 0), b3, voffB); PG8_STAGE(PG8_SB(1, 1), b3 + hstepB, voffB); PG8_STAGE(PG8_SA(1, 0), a3, voffA);
            PG8_WAIT_V(8); PG8_WAIT_L(0); PG8_BAR; PG8_MMA(1, 0, At, B0); PG8_MMA(1, 1, At, B1); PG8_BAR; PG8_SCHED;
        }
        if constexpr (ALIGN_EPI) { if (wr == 0) PG8_BAR; }
        E(acc, cur, wr, wc, fr, fq);
        if (!has_next) break;
#pragma unroll
        for (int a = 0; a < 2; ++a)
#pragma unroll
            for (int b = 0; b < 2; ++b)
#pragma unroll
                for (int m = 0; m < 4; ++m)
#pragma unroll
                    for (int n = 0; n < 2; ++n) acc[a][b][m][n] = (f32x4){0.f, 0.f, 0.f, 0.f};
        cur = nxt; cA = nA; cB = nB; ++ui;
        if constexpr (ALIGN_EPI) { if (wr == 1) PG8_BAR; }
    }
    PG8_WAIT_V(0);
    if constexpr (!ALIGN_EPI) { if (wr == 0) PG8_BAR; }
    PG8_BAR;
#undef PG8_SA
#undef PG8_SB
#undef PG8_STAGE
#undef PG8_LDA
#undef PG8_LDB
#undef PG8_MMA
#undef PG8_WAIT_V
#undef PG8_WAIT_L
#undef PG8_BAR
#undef PG8_SCHED
}
struct Gemm3 { const bf16_t* A0; const bf16_t* A1; const bf16_t* A2; const bf16_t* B0; const bf16_t* B1; const bf16_t* B2; int K0, K1, K2; };
template <class Epi, class Sched>
__device__ __forceinline__ void gemm_phase_ms(PG8_LAS unsigned char* lds, const Gemm3 g, const Sched& S, const Epi& E, int tid_in) {
    constexpr bool ALIGN_EPI = true, F16 = false;
    int tid_ = tid_in; asm volatile("" : "+v"(tid_));
    const int tid = tid_, wid = __builtin_amdgcn_readfirstlane(tid >> 6), lane = tid & 63, wr = wid >> 2, wc = wid & 3, fr = lane & 15, fq = lane >> 4;
#define PG8_VOFF(vA_, vB_, K_) do { int R_, C_; stage_rc(tid * 16, R_, C_); const int Rb_ = Epi::PERM ? ((R_ & ~31) + perm32(R_ & 31)) : R_; vA_ = (unsigned)(R_ * (K_) + C_) * 2u; vB_ = (unsigned)(Rb_ * (K_) + C_) * 2u; } while (0)
#define PG8_SEGK(sg) ((sg) == 0 ? g.K0 : (sg) == 1 ? g.K1 : g.K2)
#define PG8_SEGA(sg) ((const char*)((sg) == 0 ? g.A0 : (sg) == 1 ? g.A1 : g.A2))
#define PG8_SEGB(sg) ((const char*)((sg) == 0 ? g.B0 : (sg) == 1 ? g.B1 : g.B2))
    const size_t kstep = (size_t)(BK * 2);
    const unsigned ldsw = (unsigned)wid * 1024u;
    const int aoff = lds_byte(wr * 64 + fr, fq * 8), boff = lds_byte(wc * 32 + fr, fq * 8);
#define PG8_SA(b, h) (((b) * 2 + (h)) * HTB)
#define PG8_SB(b, h) ((4 + (b) * 2 + (h)) * HTB)
#define PG8_STAGE(bufoff, gbase, voff, s64) do { __builtin_amdgcn_global_load_lds((const unsigned*)((const char*)(gbase) + (voff)), (PG8_LAS unsigned*)(lds + (bufoff) + ldsw), 16, 0, 0); \
        __builtin_amdgcn_global_load_lds((const unsigned*)((const char*)(gbase) + (s64) + (voff)), (PG8_LAS unsigned*)(lds + (bufoff) + ldsw + 8192), 16, 0, 0); } while (0)
#define PG8_LDA(dst, b, h) do { _Pragma("unroll") for (int m = 0; m < 4; ++m) _Pragma("unroll") for (int k = 0; k < 2; ++k) dst[m][k] = *(const PG8_LAS bf16x8*)(lds + PG8_SA(b, h) + aoff + m * 2048 + k * 1024); } while (0)
#define PG8_LDB(dst, b, h) do { _Pragma("unroll") for (int n = 0; n < 2; ++n) _Pragma("unroll") for (int k = 0; k < 2; ++k) dst[n][k] = *(const PG8_LAS bf16x8*)(lds + PG8_SB(b, h) + boff + n * 2048 + k * 1024); } while (0)
#define PG8_MMA(ai, bj, At, Bt) do { __builtin_amdgcn_s_setprio(1); _Pragma("unroll") for (int m = 0; m < 4; ++m) _Pragma("unroll") for (int n = 0; n < 2; ++n) _Pragma("unroll") for (int k = 0; k < 2; ++k) \
        { if constexpr (F16) acc[ai][bj][m][n] = __builtin_amdgcn_mfma_f32_16x16x32_f16(__builtin_bit_cast(f16x8_t, Bt[n][k]), __builtin_bit_cast(f16x8_t, At[m][k]), acc[ai][bj][m][n], 0, 0, 0); \
          else acc[ai][bj][m][n] = __builtin_amdgcn_mfma_f32_16x16x32_bf16(Bt[n][k], At[m][k], acc[ai][bj][m][n], 0, 0, 0); } __builtin_amdgcn_s_setprio(0); } while (0)
#define PG8_WAIT_V(n) asm volatile("s_waitcnt vmcnt(" #n ")" ::: "memory")
#define PG8_WAIT_L(n) asm volatile("s_waitcnt lgkmcnt(" #n ")" ::: "memory")
#define PG8_BAR __builtin_amdgcn_s_barrier()
#define PG8_SCHED __builtin_amdgcn_sched_barrier(0)
    Unit cur, nxt; int ui = 0, seg = 0;
    if (!S.next(0, cur)) return;
    f32x4 acc[2][2][4][2];
#pragma unroll
    for (int a = 0; a < 2; ++a)
#pragma unroll
        for (int b = 0; b < 2; ++b)
#pragma unroll
            for (int m = 0; m < 4; ++m)
#pragma unroll
                for (int n = 0; n < 2; ++n) acc[a][b][m][n] = (f32x4){0.f, 0.f, 0.f, 0.f};
    bf16x8 At[4][2], B0[2][2], B1[2][2];
    int Kc = PG8_SEGK(0); int nt = Kc / BK; size_t hstep = (size_t)HALF * Kc * 2;
    unsigned voffA, voffB; PG8_VOFF(voffA, voffB, Kc);
    const char* cA = PG8_SEGA(0) + (size_t)cur.pm * 2 * hstep; const char* cB = PG8_SEGB(0) + (size_t)cur.pn * 2 * hstep;
    S.a_ready(cur);
    PG8_STAGE(PG8_SB(0, 0), cB, voffB, (hstep >> 1)); PG8_STAGE(PG8_SB(0, 1), cB + hstep, voffB, (hstep >> 1)); PG8_STAGE(PG8_SA(0, 0), cA, voffA, (hstep >> 1)); PG8_STAGE(PG8_SA(0, 1), cA + hstep, voffA, (hstep >> 1));
    if (wr == 1) PG8_BAR;
    PG8_WAIT_V(2); PG8_BAR;
    PG8_STAGE(PG8_SB(1, 0), cB + kstep, voffB, (hstep >> 1)); PG8_STAGE(PG8_SA(1, 0), cA + kstep, voffA, (hstep >> 1)); PG8_STAGE(PG8_SB(1, 1), cB + hstep + kstep, voffB, (hstep >> 1));
    PG8_WAIT_V(6); PG8_BAR;
    for (;;) {
        const int nseg = (seg == 2) ? 0 : seg + 1; nxt = cur;
        const bool has_next = (seg < 2) ? true : S.next(ui + 1, nxt);
        const int Kn = has_next ? PG8_SEGK(nseg) : Kc; const size_t hstepN = (size_t)HALF * Kn * 2;
        unsigned voffAn, voffBn; PG8_VOFF(voffAn, voffBn, Kn);
        const char* nA = has_next ? PG8_SEGA(nseg) + (size_t)nxt.pm * 2 * hstepN : cA; const char* nB = has_next ? PG8_SEGB(nseg) + (size_t)nxt.pn * 2 * hstepN : cB;
#pragma unroll 1
        for (int t = 0; t < nt; t += 2) {
            const bool last = (t == nt - 2);
            const char* a1 = cA + (size_t)(t + 1) * kstep;
            const char* a2 = last ? nA : cA + (size_t)(t + 2) * kstep; const char* b2 = last ? nB : cB + (size_t)(t + 2) * kstep;
            const char* a3 = a2 + kstep; const char* b3 = b2 + kstep;
            const size_t hs2 = last ? hstepN : hstep;
            const unsigned vA2 = last ? voffAn : voffA, vB2 = last ? voffBn : voffB; const size_t q2 = hs2 >> 1;
            PG8_LDB(B0, 0, 0); PG8_LDB(B1, 0, 1); PG8_SCHED; PG8_LDA(At, 0, 0); PG8_STAGE(PG8_SA(1, 1), a1 + hstep, voffA, (hstep >> 1));
            PG8_WAIT_V(8); PG8_WAIT_L(0); PG8_BAR; PG8_MMA(0, 0, At, B0); PG8_MMA(0, 1, At, B1); PG8_BAR; PG8_SCHED;
            PG8_LDA(At, 0, 1); PG8_STAGE(PG8_SB(0, 0), b2, vB2, q2); PG8_STAGE(PG8_SB(0, 1), b2 + hs2, vB2, q2); PG8_STAGE(PG8_SA(0, 0), a2, vA2, q2);
            PG8_WAIT_V(8); PG8_WAIT_L(0); PG8_BAR; PG8_MMA(1, 0, At, B0); PG8_MMA(1, 1, At, B1); PG8_BAR; PG8_SCHED;
            PG8_LDB(B0, 1, 0); PG8_LDB(B1, 1, 1); PG8_SCHED; PG8_LDA(At, 1, 0); PG8_STAGE(PG8_SA(0, 1), a2 + hs2, vA2, q2);
            PG8_WAIT_V(8); PG8_WAIT_L(0); PG8_BAR; PG8_MMA(0, 0, At, B0); PG8_MMA(0, 1, At, B1); PG8_BAR; PG8_SCHED;
            PG8_LDA(At, 1, 1); PG8_STAGE(PG8_SB(1, 0), b3, vB2, q2); PG8_STAGE(PG8_SB(1, 1), b3 + hs2, vB2, q2); PG8_STAGE(PG8_SA(1, 0), a3, vA2, q2);
            PG8_WAIT_V(8); PG8_WAIT_L(0); PG8_BAR; PG8_MMA(1, 0, At, B0); PG8_MMA(1, 1, At, B1); PG8_BAR; PG8_SCHED;
        }
        if constexpr (ALIGN_EPI) { if (wr == 0) PG8_BAR; }
        E(acc, cur, seg, wr, wc, fr, fq);
        if (!has_next) break;
        if (seg == 2) {
#pragma unroll
        for (int a = 0; a < 2; ++a)
#pragma unroll
            for (int b = 0; b < 2; ++b)
#pragma unroll
                for (int m = 0; m < 4; ++m)
#pragma unroll
                    for (int n = 0; n < 2; ++n) acc[a][b][m][n] = (f32x4){0.f, 0.f, 0.f, 0.f};
        ++ui; }
        cur = nxt; cA = nA; cB = nB; seg = nseg; Kc = Kn; nt = Kc / BK; hstep = hstepN;
        voffA = voffAn; voffB = voffBn;
        if constexpr (ALIGN_EPI) { if (wr == 1) PG8_BAR; }
    }
    PG8_WAIT_V(0);
    if constexpr (!ALIGN_EPI) { if (wr == 0) PG8_BAR; }
    PG8_BAR;
#undef PG8_VOFF
#undef PG8_SEGK
#undef PG8_SEGA
#undef PG8_SEGB
#undef PG8_SA
#undef PG8_SB
#undef PG8_STAGE
#undef PG8_LDA
#undef PG8_LDB
#undef PG8_MMA
#undef PG8_WAIT_V
#undef PG8_WAIT_L
#undef PG8_BAR
#undef PG8_SCHED
}
}

typedef unsigned short bf16;
typedef float f32x4 __attribute__((ext_vector_type(4)));
typedef float f32x2 __attribute__((ext_vector_type(2)));
typedef unsigned u32x4 __attribute__((ext_vector_type(4)));
typedef unsigned u32x2 __attribute__((ext_vector_type(2)));
#define GAS __attribute__((address_space(1)))
#define LAS __attribute__((address_space(3)))

constexpr int BATCH = 16, SEQ = 4096, DM = 1024, MTOK = BATCH * SEQ, DEPTH = 4, DFF = 2816, PLE = 256, INW = 9664;
constexpr int O_CQ = 5888, O_CKV = 6272, O_CKR = 6528, O_G = 6592, O_B = 2304;
constexpr int N_IN1 = 3072, N_INB = 3584, N_ING = 3072, N_QB = 1280;
constexpr int P_QKVA = 2304, P_CLR = 768, CLR_KV = 384, CLR_KR = 640, P_QC = 1152, P_KVC = 1536, P_BIN = 3584, P_GS = 3072;
constexpr float EPS = 1e-6f, LOG2E = 1.4426950408889634f;
constexpr float QSCALE_A = 0.125f * LOG2E;
constexpr float QSCALE_C = 0.07216878364870322f * LOG2E;

constexpr size_t MiB = 1u << 20;
constexpr size_t WS_CTL = 0, CTL_ZERO_BYTES = 1 * MiB;
constexpr size_t WS_ROPEA = 1 * MiB, WS_ROPEC = 1 * MiB + 256 * 1024, WS_LB = 2 * MiB + 512 * 1024;
constexpr size_t WS_W = 4 * MiB;
constexpr size_t W_1U = 0, W_1D = 11 * MiB, W_IN1 = W_1D + 5632 * 1024, W_INB = 23 * MiB, W_ING = 30 * MiB, W_QB = 36 * MiB, W_KVB = 37 * MiB, W_A = 38 * MiB,
                 W_B = W_A + 512 * 1024, W_C = 40 * MiB, W_O = W_C + 1536 * 1024, W_2U = W_O + 2 * MiB, W_2D = W_2U + 11 * MiB, W_PG = 60 * MiB, W_PP = 62 * MiB;
static_assert(W_1U + (size_t)5632 * 1024 * 2 <= W_1D && W_1D + (size_t)1024 * 2816 * 2 <= W_IN1 && W_IN1 + (size_t)N_IN1 * 1024 * 2 <= W_INB && W_INB + (size_t)N_INB * 1024 * 2 <= W_ING &&
              W_ING + (size_t)N_ING * 1024 * 2 <= W_QB && W_QB + (size_t)N_QB * 384 * 2 <= W_KVB && W_KVB + (size_t)1536 * 256 * 2 <= W_A && W_A + 1024 * 256 * 2 <= W_B &&
              W_B + 1024 * 768 * 2 <= W_C && W_C + 1024 * 768 * 2 <= W_O && W_O + 1024 * 1024 * 2 <= W_2U && W_2U + (size_t)5632 * 1024 * 2 <= W_2D && W_2D + (size_t)1024 * 2816 * 2 <= W_PG &&
              W_PG + 1024 * 1024 * 2 <= W_PP && W_PP + 1024 * 256 * 2 <= 64 * MiB, "weight map");
constexpr size_t WS_XBE = 68 * MiB, WS_XBO = 196 * MiB, WS_XN = WS_XBE, WS_MG = 708 * MiB;
constexpr size_t WS_H = 324 * MiB, WS_QKVA = 196 * MiB, WS_CLR = 484 * MiB, WS_AOG = 612 * MiB, WS_LSE = 708 * MiB, WS_QC = 196 * MiB, WS_CO = 340 * MiB, WS_KVC = 744 * MiB,
                 WS_AOUT = 936 * MiB, WS_BIN = 484 * MiB, WS_BO = 196 * MiB, WS_GS = 484 * MiB, WS_PB = 936 * MiB, WS_PP = 708 * MiB, WS_SH = 292 * MiB, WS_SS0 = 968 * MiB, WS_SS1 = 972 * MiB, WS_END = 976 * MiB;
constexpr int CW_BAR = 4096;

constexpr int RING_BYTES = 131072, PHASE_LDS = 155648, LDSCTL_OFF = PHASE_LDS, MISC_OFF = LDSCTL_OFF + 320, LDS_BYTES = 163840;

#define RLX_AGENT __ATOMIC_RELAXED, __HIP_MEMORY_SCOPE_AGENT
#define LDS_WAIT() asm volatile("s_waitcnt lgkmcnt(0)" ::: "memory")
#define VM_WAIT() asm volatile("s_waitcnt vmcnt(0)" ::: "memory")
__device__ __forceinline__ unsigned f2bf(float f) { unsigned u = __builtin_bit_cast(unsigned, f); return (u + 0x7fffu + ((u >> 16) & 1u)) >> 16; }
__device__ __forceinline__ unsigned pk2(float lo, float hi) { return f2bf(lo) | (f2bf(hi) << 16); }
__device__ __forceinline__ float bflo(unsigned w) { return __builtin_bit_cast(float, w << 16); }
__device__ __forceinline__ float bfhi(unsigned w) { return __builtin_bit_cast(float, w & 0xffff0000u); }
__device__ __forceinline__ float bf2f(bf16 b) { return __builtin_bit_cast(float, (unsigned)b << 16); }
__device__ __forceinline__ float sigmoidf_(float x) { return __builtin_amdgcn_rcpf(1.f + __builtin_amdgcn_exp2f(-x * LOG2E)); }
__device__ __forceinline__ float wave_sum(float v) {
#pragma unroll
    for (int o = 1; o < 64; o <<= 1) v += __shfl_xor(v, o);
    return v;
}
__device__ __forceinline__ float wave_max(float v) {
#pragma unroll
    for (int o = 1; o < 64; o <<= 1) v = fmaxf(v, __shfl_xor(v, o));
    return v;
}

#define XB_TMO      128
#define XB_XCNT(j)  (256  + 64 * (j))
#define XB_XSUB(j)  (1280 + 64 * (j))
#define XB_XGEN(j)  (2304 + 64 * (j))
#define XB_TOP      3328
#define XB_TOPGEN   3392
#define XCD_BAR_WORDS 3456
#define XB_SPIN_CAP (1u << 25)
__device__ __forceinline__ unsigned xb_ld(unsigned* p)              { return __hip_atomic_load(p, __ATOMIC_RELAXED, __HIP_MEMORY_SCOPE_AGENT); }
__device__ __forceinline__ unsigned xb_add(unsigned* p, unsigned v) { return __hip_atomic_fetch_add(p, v, __ATOMIC_RELAXED, __HIP_MEMORY_SCOPE_AGENT); }
__device__ __forceinline__ unsigned xb_xcc_id() { return (unsigned)__builtin_amdgcn_s_getreg((3 << 11) | 20) & 0xFu; }
#define XB_SPIN(cond, bar) do { unsigned _sp = 0; while (cond) { __builtin_amdgcn_s_sleep(1); \
    if ((++_sp & 255u) == 0u) { if (xb_ld(&(bar)[XB_TMO])) break; if (_sp > XB_SPIN_CAP) { atomicAdd(&(bar)[XB_TMO], 1u); break; } } } } while (0)
struct XcdBarrier { unsigned* bar; unsigned x; volatile LAS unsigned* st; };
__device__ __forceinline__ XcdBarrier xcd_barrier_post(unsigned* bar, volatile LAS unsigned* st) {
    XcdBarrier b; b.bar = bar; b.x = xb_xcc_id(); b.st = st;
    if (threadIdx.x == 0) (void)xb_add(&bar[XB_XCNT(b.x)], 1u);
    return b;
}
__device__ __forceinline__ void xcd_barrier_complete(unsigned* bar, unsigned x, unsigned& nloc, unsigned& nx) {
    const unsigned G = gridDim.x * gridDim.y * gridDim.z;
    unsigned sum, cnt, mine, sp = 0u;
    for (;;) {
        sum = 0u; cnt = 0u; mine = 0u;
#pragma unroll
        for (unsigned j = 0; j < 16; ++j) { const unsigned c = xb_ld(&bar[XB_XCNT(j)]); sum += c; cnt += (c > 0u) ? 1u : 0u; mine = (j == x) ? c : mine; }
        if (sum == G) break;
        __builtin_amdgcn_s_sleep(1);
        if ((++sp & 255u) == 0u) { if (xb_ld(&bar[XB_TMO])) break; if (sp > XB_SPIN_CAP) { atomicAdd(&bar[XB_TMO], 1u); break; } }
    }
    nloc = mine > 0u ? mine : 1u; nx = cnt > 0u ? cnt : 1u;
}
__device__ __forceinline__ void xcd_barrier(const XcdBarrier& b, const bool leader) {
    asm volatile("s_waitcnt vmcnt(0)" ::: "memory");
    __syncthreads();
    if (leader) {
        unsigned* bar = b.bar;
        __builtin_amdgcn_s_waitcnt(0);
        unsigned nloc = b.st[0], nx = b.st[1];
        if (nloc == 0u) { xcd_barrier_complete(bar, b.x, nloc, nx); b.st[0] = nloc; b.st[1] = nx; }
        const unsigned old = xb_add(&bar[XB_XSUB(b.x)], 1u);
        const unsigned gen = old / nloc;
        if (old + 1u == (gen + 1u) * nloc) {
            __builtin_amdgcn_fence(__ATOMIC_RELEASE, "agent");
            asm volatile("s_waitcnt vmcnt(0)" ::: "memory");
            const unsigned og = xb_add(&bar[XB_TOP], 1u);
            const unsigned tg = og / nx;
            if (og + 1u == (tg + 1u) * nx) xb_add(&bar[XB_TOPGEN], 1u);
            else XB_SPIN(xb_ld(&bar[XB_TOPGEN]) == tg, bar);
            __builtin_amdgcn_fence(__ATOMIC_ACQUIRE, "agent");
            xb_add(&bar[XB_XGEN(b.x)], 1u);
            asm volatile("s_waitcnt vmcnt(0)" ::: "memory");
        } else {
            XB_SPIN(xb_ld(&bar[XB_XGEN(b.x)]) == gen, bar);
            __builtin_amdgcn_fence(__ATOMIC_ACQUIRE, "agent");
            asm volatile("s_waitcnt vmcnt(0)" ::: "memory");
        }
    }
    __syncthreads();
}

using pg8::Unit;
constexpr int RS_OFF = RING_BYTES, RS_SLOTS = 6;
struct RsTab { const LAS float* tab; int g0; };
__device__ __forceinline__ float rs_get(const RsTab& T, int row) { return T.tab[(((row >> 11) - T.g0) << 8) + (row & 255)]; }
__device__ __forceinline__ float row_rstd(const float* SS, int row) {
    const f32x4* p = (const f32x4*)(SS + (size_t)row * 16); const f32x4 a = p[0], b = p[1], c = p[2], d = p[3];
    const float s = (((a[0] + a[1]) + (a[2] + a[3])) + ((b[0] + b[1]) + (b[2] + b[3]))) + (((c[0] + c[1]) + (c[2] + c[3])) + ((d[0] + d[1]) + (d[2] + d[3])));
    return 1.f / sqrtf(s * (1.f / DM) + EPS);
}
struct EpiSwiglu {
    static constexpr bool PERM = true;
    bf16* H; RsTab SS;
    __device__ __forceinline__ void operator()(const f32x4 (&acc)[2][2][4][2], const Unit& u, int wr, int wc, int fr, int fq) const {
        const int row0 = u.pm * 256 + wr * 64 + fr, col0 = u.pn * 128 + wc * 32 + 8 * fq;
#pragma unroll
        for (int ai = 0; ai < 2; ++ai)
#pragma unroll
            for (int m = 0; m < 4; ++m) { const int row = row0 + ai * 128 + m * 16; const float rs = rs_get(SS, row);
                float h[8];
#pragma unroll
                for (int n = 0; n < 2; ++n)
#pragma unroll
                    for (int j = 0; j < 4; ++j) { const float g = acc[ai][0][m][n][j] * rs, uu = acc[ai][1][m][n][j] * rs; h[4 * n + j] = g * sigmoidf_(g) * uu; }
                u32x4 w; w.x = pg8::cvt_pk_bf16(h[0], h[1]); w.y = pg8::cvt_pk_bf16(h[2], h[3]); w.z = pg8::cvt_pk_bf16(h[4], h[5]); w.w = pg8::cvt_pk_bf16(h[6], h[7]);
                *(u32x4*)(H + (size_t)row * DFF + col0) = w; }
    }
};
struct EpiResid {
    static constexpr bool PERM = true;
    static constexpr int LA = 4;
    const bf16* XI; bf16* XO; float scale; float* SSo;
    __device__ __forceinline__ void operator()(const f32x4 (&acc)[2][2][4][2], const Unit& u, int wr, int wc, int fr, int fq) const {
        const unsigned row0 = u.pm * 256 + wr * 64 + fr, col0 = u.pn * 256 + wc * 32 + 8 * fq;
        float sc = scale; asm volatile("" : "+v"(sc));
        u32x4 xi[8][2];
#pragma unroll
        for (int it = 0; it < 8 + LA; ++it) {
            if (it < 8) { const unsigned off = (row0 + (it >> 2) * 128 + (it & 3) * 16) * (unsigned)DM + col0;
#pragma unroll
                for (int bj = 0; bj < 2; ++bj) xi[it][bj] = *(const u32x4*)(XI + off + bj * 128); }
            if (it >= LA) { const int r = it - LA; const unsigned row = row0 + (r >> 2) * 128 + (r & 3) * 16; float ssq = 0.f;
#pragma unroll
                for (int bj = 0; bj < 2; ++bj) { const unsigned off = row * (unsigned)DM + col0 + bj * 128; const u32x4 w = xi[r][bj]; const f32x4 a0 = acc[r >> 2][bj][r & 3][0], a1 = acc[r >> 2][bj][r & 3][1];
                    f32x4 x0, x1;
                    x0[0] = pg8::f16lo(w.x) + a0[0] * sc; x0[1] = pg8::f16hi(w.x) + a0[1] * sc; x0[2] = pg8::f16lo(w.y) + a0[2] * sc; x0[3] = pg8::f16hi(w.y) + a0[3] * sc;
                    x1[0] = pg8::f16lo(w.z) + a1[0] * sc; x1[1] = pg8::f16hi(w.z) + a1[1] * sc; x1[2] = pg8::f16lo(w.w) + a1[2] * sc; x1[3] = pg8::f16hi(w.w) + a1[3] * sc;
                    ssq += ((x0[0] * x0[0] + x0[1] * x0[1]) + (x0[2] * x0[2] + x0[3] * x0[3])) + ((x1[0] * x1[0] + x1[1] * x1[1]) + (x1[2] * x1[2] + x1[3] * x1[3]));
                    u32x4 o; o.x = pg8::cvt_pk_f16(x0[0], x0[1]); o.y = pg8::cvt_pk_f16(x0[2], x0[3]); o.z = pg8::cvt_pk_f16(x1[0], x1[1]); o.w = pg8::cvt_pk_f16(x1[2], x1[3]);
                    *(u32x4*)(XO + off) = o; }
                ssq += __shfl_xor(ssq, 16); ssq += __shfl_xor(ssq, 32);
                if (fq == 0) SSo[row * 16u + u.pn * 4 + wc] = ssq; }
        }
    }
};
template <int ACT, bool NORM> struct EpiBf16 {
    static constexpr bool PERM = true;
    bf16* O; int ldc; RsTab SS;
    __device__ __forceinline__ void operator()(const f32x4 (&acc)[2][2][4][2], const Unit& u, int wr, int wc, int fr, int fq) const {
        const int row0 = u.pm * 256 + wr * 64 + fr, col0 = u.pn * 256 + wc * 32 + 8 * fq;
#pragma unroll
        for (int ai = 0; ai < 2; ++ai)
#pragma unroll
            for (int m = 0; m < 4; ++m) { const int row = row0 + ai * 128 + m * 16; bf16* rowp = O + (size_t)row * ldc + col0; float rs = 1.f; if (NORM) rs = rs_get(SS, row);
#pragma unroll
                for (int bj = 0; bj < 2; ++bj) { f32x4 v0 = acc[ai][bj][m][0], v1 = acc[ai][bj][m][1];
                    if (NORM) { v0 = v0 * rs; v1 = v1 * rs; }
                    if (ACT == 1) {
#pragma unroll
                        for (int j = 0; j < 4; ++j) { v0[j] = sigmoidf_(v0[j]); v1[j] = sigmoidf_(v1[j]); } }
                    u32x4 w; w.x = pg8::cvt_pk_bf16(v0[0], v0[1]); w.y = pg8::cvt_pk_bf16(v0[2], v0[3]); w.z = pg8::cvt_pk_bf16(v1[0], v1[1]); w.w = pg8::cvt_pk_bf16(v1[2], v1[3]);
                    *(u32x4*)(rowp + bj * 128) = w; } }
    }
};
struct EpiGate8 {
    static constexpr bool PERM = true;
    unsigned char* G8; RsTab SS;
    __device__ __forceinline__ void operator()(const f32x4 (&acc)[2][2][4][2], const Unit& u, int wr, int wc, int fr, int fq) const {
        const int row0 = u.pm * 256 + wr * 64 + fr, col0 = u.pn * 256 + wc * 32 + 8 * fq;
#pragma unroll
        for (int ai = 0; ai < 2; ++ai)
#pragma unroll
            for (int m = 0; m < 4; ++m) { const int row = row0 + ai * 128 + m * 16; unsigned char* rowp = G8 + (size_t)row * P_GS + col0; const float rs = rs_get(SS, row);
#pragma unroll
                for (int bj = 0; bj < 2; ++bj) { const f32x4 v0 = acc[ai][bj][m][0] * rs, v1 = acc[ai][bj][m][1] * rs;
                    unsigned b[8];
#pragma unroll
                    for (int j = 0; j < 4; ++j) { b[j] = max((unsigned)(sigmoidf_(v0[j]) * 255.f + 0.5f), 1u); b[4 + j] = max((unsigned)(sigmoidf_(v1[j]) * 255.f + 0.5f), 1u); }
                    u32x2 w; w.x = b[0] | (b[1] << 8) | (b[2] << 16) | (b[3] << 24); w.y = b[4] | (b[5] << 8) | (b[6] << 16) | (b[7] << 24);
                    *(u32x2*)(rowp + bj * 128) = w; } }
    }
};
__device__ __forceinline__ void rope4(f32x4& v, const f32x4 cs) {
    const float a0 = v[0] * cs[0] - v[1] * cs[1], b0 = v[1] * cs[0] + v[0] * cs[1], a1 = v[2] * cs[2] - v[3] * cs[3], b1 = v[3] * cs[2] + v[2] * cs[3];
    v[0] = a0; v[1] = b0; v[2] = a1; v[3] = b1;
}
struct EpiIn1 {
    static constexpr bool PERM = true;
    bf16* QKVA; bf16* CLR; const float* ropeA; const float* ropeC; RsTab SS;
    __device__ __forceinline__ void operator()(const f32x4 (&acc)[2][2][4][2], const Unit& u, int wr, int wc, int fr, int fq) const {
        const int row0 = u.pm * 256 + wr * 64 + fr;
        const bool isA = u.pn < 9;
        bf16* base = isA ? QKVA : CLR; const int ldc = isA ? P_QKVA : P_CLR; const int colt = isA ? u.pn * 256 : (u.pn - 9) * 256;
        const int col0 = colt + wc * 32 + 8 * fq;
        const bool ropeq = (u.pn < 6) && ((wc & 1) == 0) && (fq < 2);
        const bool ropek = (u.pn == 11) && (wc < 2);
        const float qs = (u.pn < 3) ? QSCALE_A : 1.f;
        f32x4 cs[8][2];
        if (ropeq || ropek) { const float* rp = ropeq ? ropeA + 8 * fq : ropeC + 32 * wc + 8 * fq; const int rstride = ropeq ? 16 : 64;
#pragma unroll
            for (int r = 0; r < 8; ++r) { const int pos = (row0 + (r >> 2) * 128 + (r & 3) * 16) & (SEQ - 1); cs[r][0] = *(const f32x4*)(rp + pos * rstride); cs[r][1] = *(const f32x4*)(rp + pos * rstride + 4); } }
        else {
#pragma unroll
            for (int r = 0; r < 8; ++r) { cs[r][0] = (f32x4){1.f, 0.f, 1.f, 0.f}; cs[r][1] = (f32x4){1.f, 0.f, 1.f, 0.f}; } }
#pragma unroll
        for (int ai = 0; ai < 2; ++ai)
#pragma unroll
            for (int m = 0; m < 4; ++m) { const int row = row0 + ai * 128 + m * 16; bf16* rowp = base + (size_t)row * ldc + col0; const float rs = rs_get(SS, row);
#pragma unroll
                for (int bj = 0; bj < 2; ++bj) { f32x4 v0 = acc[ai][bj][m][0] * rs, v1 = acc[ai][bj][m][1] * rs;
                    if (ropeq || (ropek && bj == 1)) { rope4(v0, cs[ai * 4 + m][0]); rope4(v1, cs[ai * 4 + m][1]); }
                    v0 = v0 * qs; v1 = v1 * qs;
                    u32x4 w; w.x = pg8::cvt_pk_bf16(v0[0], v0[1]); w.y = pg8::cvt_pk_bf16(v0[2], v0[3]); w.z = pg8::cvt_pk_bf16(v1[0], v1[1]); w.w = pg8::cvt_pk_bf16(v1[2], v1[3]);
                    *(u32x4*)(rowp + bj * 128) = w; } }
    }
};
struct EpiQC {
    static constexpr bool PERM = true;
    bf16* QC; const float* ropeC;
    __device__ __forceinline__ void operator()(const f32x4 (&acc)[2][2][4][2], const Unit& u, int wr, int wc, int fr, int fq) const {
        const int row0 = u.pm * 256 + wr * 64 + fr;
#pragma unroll
        for (int bj = 0; bj < 2; ++bj) { const int cu = u.pn * 256 + bj * 128 + wc * 32;
            if (cu >= P_QC) continue;
            const int col0 = cu + 8 * fq; const int ub = cu % 192; const bool rp = ub >= 128; const int d0 = ub + 8 * fq;
            f32x4 cs[8][2];
            if (rp) {
#pragma unroll
                for (int r = 0; r < 8; ++r) { const int pos = (row0 + (r >> 2) * 128 + (r & 3) * 16) & (SEQ - 1); cs[r][0] = *(const f32x4*)(ropeC + pos * 64 + (d0 - 128)); cs[r][1] = *(const f32x4*)(ropeC + pos * 64 + (d0 - 128) + 4); } }
            else {
#pragma unroll
                for (int r = 0; r < 8; ++r) { cs[r][0] = (f32x4){1.f, 0.f, 1.f, 0.f}; cs[r][1] = (f32x4){1.f, 0.f, 1.f, 0.f}; } }
#pragma unroll
            for (int ai = 0; ai < 2; ++ai)
#pragma unroll
                for (int m = 0; m < 4; ++m) { const int row = row0 + ai * 128 + m * 16;
                    f32x4 v0 = acc[ai][bj][m][0], v1 = acc[ai][bj][m][1];
                    if (rp) { rope4(v0, cs[ai * 4 + m][0]); rope4(v1, cs[ai * 4 + m][1]); }
                    v0 = v0 * QSCALE_C; v1 = v1 * QSCALE_C;
                    u32x4 w; w.x = pg8::cvt_pk_bf16(v0[0], v0[1]); w.y = pg8::cvt_pk_bf16(v0[2], v0[3]); w.z = pg8::cvt_pk_bf16(v1[0], v1[1]); w.w = pg8::cvt_pk_bf16(v1[2], v1[3]);
                    *(u32x4*)(QC + (size_t)row * P_QC + col0) = w; } }
    }
};
template <bool FIRST> struct EpiMerge {
    static constexpr bool PERM = true;
    static constexpr int LA = 4;
    bf16* MG; const unsigned char* GS; int goff;
    __device__ __forceinline__ void operator()(const f32x4 (&acc)[2][2][4][2], const Unit& u, int wr, int wc, int fr, int fq) const {
        const unsigned row0 = u.pm * 256 + wr * 64 + fr, col0 = u.pn * 256 + wc * 32 + 8 * fq;
        u32x2 gi[8][2]; u32x4 oi[8][2];
#pragma unroll
        for (int it = 0; it < 8 + LA; ++it) {
            if (it >= LA) { const int r = it - LA;
#pragma unroll
                for (int bj = 0; bj < 2; ++bj) { const u32x2 gw = gi[r][bj]; const u32x4 ow = oi[r][bj]; const f32x4 v0 = acc[r >> 2][bj][r & 3][0], v1 = acc[r >> 2][bj][r & 3][1]; float g[8], q[8];
#pragma unroll
                    for (int jj = 0; jj < 4; ++jj) { g[jj] = (float)((gw.x >> (8 * jj)) & 255u) * (1.f / 255.f); g[4 + jj] = (float)((gw.y >> (8 * jj)) & 255u) * (1.f / 255.f); }
                    q[0] = bflo(ow.x) + g[0] * v0[0]; q[1] = bfhi(ow.x) + g[1] * v0[1]; q[2] = bflo(ow.y) + g[2] * v0[2]; q[3] = bfhi(ow.y) + g[3] * v0[3];
                    q[4] = bflo(ow.z) + g[4] * v1[0]; q[5] = bfhi(ow.z) + g[5] * v1[1]; q[6] = bflo(ow.w) + g[6] * v1[2]; q[7] = bfhi(ow.w) + g[7] * v1[3];
                    u32x4 w; w.x = pg8::cvt_pk_bf16(q[0], q[1]); w.y = pg8::cvt_pk_bf16(q[2], q[3]); w.z = pg8::cvt_pk_bf16(q[4], q[5]); w.w = pg8::cvt_pk_bf16(q[6], q[7]); oi[r][bj] = w; } }
            if (it < 8) { const unsigned row = row0 + (it >> 2) * 128 + (it & 3) * 16;
#pragma unroll
                for (int bj = 0; bj < 2; ++bj) { gi[it][bj] = *(const u32x2*)(GS + row * (unsigned)P_GS + goff + col0 + bj * 128); oi[it][bj] = (u32x4){0u, 0u, 0u, 0u}; if (!FIRST) oi[it][bj] = *(const u32x4*)(MG + row * (unsigned)DM + col0 + bj * 128); } }
            if (it >= LA) { const int r = it - LA; const unsigned row = row0 + (r >> 2) * 128 + (r & 3) * 16;
#pragma unroll
                for (int bj = 0; bj < 2; ++bj) *(u32x4*)(MG + row * (unsigned)DM + col0 + bj * 128) = oi[r][bj]; }
        }
    }
};
struct EpiMerge3 {
    static constexpr bool PERM = true;
    bf16* MG; const unsigned char* GS;
    __device__ __forceinline__ void operator()(f32x4 (&acc)[2][2][4][2], const Unit& u, int seg, int wr, int wc, int fr, int fq) const {
        const unsigned row0 = u.pm * 256 + wr * 64 + fr, col0 = u.pn * 256 + wc * 32 + 8 * fq;
        if (seg < 2) { const unsigned go = (unsigned)seg * 1024u + col0;
#pragma unroll
            for (int r = 0; r < 8; ++r) { const unsigned row = row0 + (r >> 2) * 128 + (r & 3) * 16;
#pragma unroll
                for (int bj = 0; bj < 2; ++bj) { const u32x2 ga = *(const u32x2*)(GS + row * (unsigned)P_GS + go + bj * 128), gb = *(const u32x2*)(GS + row * (unsigned)P_GS + go + 1024 + bj * 128);
#pragma unroll
                    for (int jj = 0; jj < 4; ++jj) {
                        acc[r >> 2][bj][r & 3][0][jj] *= (float)((ga.x >> (8 * jj)) & 255u) * __builtin_amdgcn_rcpf((float)((gb.x >> (8 * jj)) & 255u));
                        acc[r >> 2][bj][r & 3][1][jj] *= (float)((ga.y >> (8 * jj)) & 255u) * __builtin_amdgcn_rcpf((float)((gb.y >> (8 * jj)) & 255u)); } } }
        } else {
#pragma unroll
            for (int r = 0; r < 8; ++r) { const unsigned row = row0 + (r >> 2) * 128 + (r & 3) * 16;
#pragma unroll
                for (int bj = 0; bj < 2; ++bj) { const u32x2 gw = *(const u32x2*)(GS + row * (unsigned)P_GS + 2048 + col0 + bj * 128); const f32x4 v0 = acc[r >> 2][bj][r & 3][0], v1 = acc[r >> 2][bj][r & 3][1]; float q[8];
#pragma unroll
                    for (int jj = 0; jj < 4; ++jj) { q[jj] = v0[jj] * ((float)((gw.x >> (8 * jj)) & 255u) * (1.f / 255.f)); q[4 + jj] = v1[jj] * ((float)((gw.y >> (8 * jj)) & 255u) * (1.f / 255.f)); }
                    u32x4 w; w.x = pg8::cvt_pk_bf16(q[0], q[1]); w.y = pg8::cvt_pk_bf16(q[2], q[3]); w.z = pg8::cvt_pk_bf16(q[4], q[5]); w.w = pg8::cvt_pk_bf16(q[6], q[7]);
                    *(u32x4*)(MG + row * (unsigned)DM + col0 + bj * 128) = w; } }
        }
    }
};
struct EpiPle {
    static constexpr bool PERM = true;
    static constexpr int LA = 3;
    const bf16* XI; const bf16* PP; RsTab SS; bf16* XO; float* SSo;
    __device__ __forceinline__ void operator()(const f32x4 (&acc)[2][2][4][2], const Unit& u, int wr, int wc, int fr, int fq) const {
        const unsigned row0 = u.pm * 256 + wr * 64 + fr, col0 = u.pn * 256 + wc * 32 + 8 * fq;
        u32x4 xi[8][2], pi[8][2];
#pragma unroll
        for (int it = 0; it < 8 + LA; ++it) {
            if (it < 8) { const unsigned off = (row0 + (it >> 2) * 128 + (it & 3) * 16) * (unsigned)DM + col0;
#pragma unroll
                for (int bj = 0; bj < 2; ++bj) { pi[it][bj] = *(const u32x4*)(PP + off + bj * 128); xi[it][bj] = *(const u32x4*)(XI + off + bj * 128); } }
            if (it >= LA) { const int r = it - LA; const unsigned row = row0 + (r >> 2) * 128 + (r & 3) * 16; const float rs = rs_get(SS, (int)row); float ssq = 0.f;
#pragma unroll
                for (int bj = 0; bj < 2; ++bj) { const unsigned off = row * (unsigned)DM + col0 + bj * 128; const u32x4 pw = pi[r][bj], w = xi[r][bj];
                    const f32x4 v0 = acc[r >> 2][bj][r & 3][0] * rs, v1 = acc[r >> 2][bj][r & 3][1] * rs; f32x4 x0, x1;
                    x0[0] = pg8::f16lo(w.x) + sigmoidf_(v0[0]) * bflo(pw.x); x0[1] = pg8::f16hi(w.x) + sigmoidf_(v0[1]) * bfhi(pw.x); x0[2] = pg8::f16lo(w.y) + sigmoidf_(v0[2]) * bflo(pw.y); x0[3] = pg8::f16hi(w.y) + sigmoidf_(v0[3]) * bfhi(pw.y);
                    x1[0] = pg8::f16lo(w.z) + sigmoidf_(v1[0]) * bflo(pw.z); x1[1] = pg8::f16hi(w.z) + sigmoidf_(v1[1]) * bfhi(pw.z); x1[2] = pg8::f16lo(w.w) + sigmoidf_(v1[2]) * bflo(pw.w); x1[3] = pg8::f16hi(w.w) + sigmoidf_(v1[3]) * bfhi(pw.w);
                    ssq += ((x0[0] * x0[0] + x0[1] * x0[1]) + (x0[2] * x0[2] + x0[3] * x0[3])) + ((x1[0] * x1[0] + x1[1] * x1[1]) + (x1[2] * x1[2] + x1[3] * x1[3]));
                    u32x4 o; o.x = pg8::cvt_pk_f16(x0[0], x0[1]); o.y = pg8::cvt_pk_f16(x0[2], x0[3]); o.z = pg8::cvt_pk_f16(x1[0], x1[1]); o.w = pg8::cvt_pk_f16(x1[2], x1[3]);
                    *(u32x4*)(XO + off) = o; }
                ssq += __shfl_xor(ssq, 16); ssq += __shfl_xor(ssq, 32);
                if (fq == 0) SSo[row * 16u + u.pn * 4 + wc] = ssq; }
        }
    }
};

template <int MAP> __device__ __forceinline__ int wmap(int n) {
    if (MAP == 0) return n;
    if (MAP == 1) { const int t = n >> 8, c = n & 255; return (c < 128) ? 128 * t + c : DFF + 128 * t + (c - 128); }
    if (MAP == 2) {
        if (n < 2304) { const int p = n & 63; if (n < 1536 && p < 16) return (n - p) + (p >> 1) + 8 * (p & 1); return n; }
        if (n < 2688) return O_CQ + (n - 2304);
        if (n < 2944) return O_CKV + (n - 2688);
        if (n < 3008) { const int p = n - 2944; return O_CKR + (p >> 1) + 32 * (p & 1); }
        return -1; }
    if (MAP == 3) return O_B + n;
    if (MAP == 4) return O_G + n;
    if (MAP == 5) { if (n >= 1152) return -1; const int h = n / 192, d = n % 192; if (d < 128) return n; const int p = d - 128; return 192 * h + 128 + (p >> 1) + 32 * (p & 1); }
    return n;
}
template <int MAP, bool F16 = false> __device__ __forceinline__ void wt_item(const float* W, int K, int Nsrc, int Ndst, bf16* WT, LAS float* scr, int item, int lane, const float* gain = nullptr) {
    const int nblk = Ndst / 32, kb = item / nblk, nb = item % nblk, k0 = 64 * kb, n0 = 32 * nb;
    const int sc = wmap<MAP>(n0 + (lane & 31));
#pragma unroll 8
    for (int i = 0; i < 32; ++i) { const int kk = 2 * i + (lane >> 5); const float gk = gain ? gain[k0 + kk] : 1.f; scr[kk * 33 + (lane & 31)] = (sc >= 0) ? W[(size_t)(k0 + kk) * Nsrc + sc] * gk : 0.f; }
    LDS_WAIT(); asm volatile("" ::: "memory");
    const int c = lane & 7;
#pragma unroll
    for (int j = 0; j < 4; ++j) { const int n = (lane >> 3) + 8 * j; const LAS float* s = scr + (8 * c) * 33 + n;
        u32x4 o;
        if (F16) { o.x = pg8::cvt_pk_f16(s[0 * 33], s[1 * 33]); o.y = pg8::cvt_pk_f16(s[2 * 33], s[3 * 33]); o.z = pg8::cvt_pk_f16(s[4 * 33], s[5 * 33]); o.w = pg8::cvt_pk_f16(s[6 * 33], s[7 * 33]); }
        else { o.x = pk2(s[0 * 33], s[1 * 33]); o.y = pk2(s[2 * 33], s[3 * 33]); o.z = pk2(s[4 * 33], s[5 * 33]); o.w = pk2(s[6 * 33], s[7 * 33]); }
        *(GAS u32x4*)(WT + (size_t)(n0 + n) * K + k0 + 8 * c) = o; }
    LDS_WAIT(); asm volatile("" ::: "memory");
}

__device__ __forceinline__ void rms_row_to_bf16(const float* xrow, const float* gain, bf16* orow, int lane) {
    const GAS f32x4* xr = (const GAS f32x4*)xrow + lane; const GAS f32x4* gr = (const GAS f32x4*)gain + lane;
    f32x4 v[4]; float s = 0.f;
#pragma unroll
    for (int j = 0; j < 4; ++j) { v[j] = xr[64 * j]; s += (v[j].x * v[j].x + v[j].y * v[j].y) + (v[j].z * v[j].z + v[j].w * v[j].w); }
    const float rstd = 1.f / sqrtf(wave_sum(s) * (1.f / DM) + EPS);
    GAS unsigned long long* o8 = (GAS unsigned long long*)orow + lane;
#pragma unroll
    for (int j = 0; j < 4; ++j) { const f32x4 g = gr[64 * j]; o8[64 * j] = (unsigned long long)pk2(v[j].x * rstd * g.x, v[j].y * rstd * g.y) | ((unsigned long long)pk2(v[j].z * rstd * g.z, v[j].w * rstd * g.w) << 32); }
}


typedef short s16x4 __attribute__((ext_vector_type(4)));
typedef short bf16x8 __attribute__((ext_vector_type(8)));
typedef float f32x16 __attribute__((ext_vector_type(16)));
__device__ __forceinline__ s16x4 vtr(const LAS unsigned char* p) { return __builtin_amdgcn_ds_read_tr16_b64_v4i16((LAS s16x4*)p); }
__device__ __forceinline__ int crow(int reg, int hf) { return (reg & 3) + 8 * (reg >> 2) + 4 * hf; }
__device__ __forceinline__ bf16x8 pack8(const f32x16& s, int o) {
    u32x4 w; w.x = pg8::cvt_pk_bf16(s[o], s[o + 1]); w.y = pg8::cvt_pk_bf16(s[o + 2], s[o + 3]); w.z = pg8::cvt_pk_bf16(s[o + 4], s[o + 5]); w.w = pg8::cvt_pk_bf16(s[o + 6], s[o + 7]); return __builtin_bit_cast(bf16x8, w);
}
#define MFMA32(a, b, c) __builtin_amdgcn_mfma_f32_32x32x16_bf16((a), (b), (c), 0, 0, 0)

__device__ __forceinline__ void mla_phase(LAS unsigned char* lds, const bf16* QC, const bf16* KVC, const bf16* CLR, bf16* CO, int vcu, int G, int tid, int lane, int wave) {
    constexpr int KP = 400, VP = 320, KB = 64 * KP, VB = 64 * VP; constexpr float MLA_THR = 8.f;
    LAS unsigned char* Kl = lds; LAS unsigned char* Vl = lds + 2 * KB;
    static_assert(2 * KB + 3 * VB <= PHASE_LDS, "mla LDS map");
    const int r = lane & 31, hf = lane >> 5; const bool trail = wave >= 4;
#define MLA_OFFS int t_o = tid; asm volatile("" : "+v"(t_o)); const int srow = t_o >> 4, sch = t_o & 15, prow = t_o >> 3, pch = t_o & 7; \
    const int noff = srow * P_KVC + sch * 8, poff = prow * P_CLR + pch * 8, kd0 = srow * KP + sch * 16, vd0 = srow * VP + sch * 16, pd0 = prow * KP + 256 + pch * 16; (void)noff; (void)poff; (void)kd0; (void)vd0; (void)pd0;
    for (int pi = vcu; pi < 768; pi += G) {
        const int bh = pi >> 3, sft = pi & 7, b = bh / 6, h = bh - 6 * b; const size_t rb = (size_t)b * SEQ;
        const bf16* kvb = KVC + rb * P_KVC + h * 256; const bf16* clb = CLR + rb * P_CLR + CLR_KR;
        for (int half = 0; half < 2; ++half) {
            const int qb = half ? 15 - sft : sft, q0w = qb * 256 + wave * 32, NT = 4 * (qb + 1);
            bf16x8 qf[12];
            { const bf16* qp = QC + (rb + q0w + r) * P_QC + h * 192 + 8 * hf;
#pragma unroll
              for (int s = 0; s < 12; ++s) qf[s] = *(const bf16x8*)(qp + 16 * s); }
            float m_ref = 0.f, l_run = 0.f; f32x16 OT[4];
#pragma unroll
            for (int d = 0; d < 4; ++d)
#pragma unroll
                for (int e = 0; e < 16; ++e) OT[d][e] = 0.f;
            u32x4 kr[3], vr[2];
            bf16x8 p00, p01, p10, p11; bool pact = false;
#pragma unroll
            for (int e = 0; e < 8; ++e) { p00[e] = 0; p01[e] = 0; p10[e] = 0; p11[e] = 0; }
#define MLA_LOAD(t) do { MLA_OFFS const bf16* kt_ = kvb + (size_t)(t) * (64 * P_KVC) + noff; kr[0] = *(const u32x4*)(kt_); kr[1] = *(const u32x4*)(kt_ + 32 * P_KVC); vr[0] = *(const u32x4*)(kt_ + 128); vr[1] = *(const u32x4*)(kt_ + 32 * P_KVC + 128); \
                         kr[2] = *(const u32x4*)(clb + (size_t)(t) * (64 * P_CLR) + poff); } while (0)
#define MLA_STORE(kb_, vb_) do { MLA_OFFS *(LAS u32x4*)(Kl + (kb_) * KB + kd0) = kr[0]; *(LAS u32x4*)(Kl + (kb_) * KB + kd0 + 32 * KP) = kr[1]; *(LAS u32x4*)(Kl + (kb_) * KB + pd0) = kr[2]; \
                          *(LAS u32x4*)(Vl + (vb_) * VB + vd0) = vr[0]; *(LAS u32x4*)(Vl + (vb_) * VB + vd0 + 32 * VP) = vr[1]; } while (0)
#define MLA_PV(Vbuf) do { const LAS unsigned char* vp = (Vbuf) + (((lane & 15) >> 2) + 4 * hf) * VP + (16 * ((lane >> 4) & 1) + 4 * (lane & 3)) * 2; \
                _Pragma("unroll") for (int h_ = 0; h_ < 8; ++h_) { s16x4 vl_[2], vh_[2]; \
                    _Pragma("unroll") for (int q2 = 0; q2 < 2; ++q2) { vl_[q2] = vtr(vp + (16 * (2 * (h_ & 1) + q2)) * VP + 64 * (h_ >> 1)); vh_[q2] = vtr(vp + (16 * (2 * (h_ & 1) + q2) + 8) * VP + 64 * (h_ >> 1)); } \
                    const bf16x8 f0_ = {vl_[0][0], vl_[0][1], vl_[0][2], vl_[0][3], vh_[0][0], vh_[0][1], vh_[0][2], vh_[0][3]}, f1_ = {vl_[1][0], vl_[1][1], vl_[1][2], vl_[1][3], vh_[1][0], vh_[1][1], vh_[1][2], vh_[1][3]}; \
                    if (h_ & 1) { OT[h_ >> 1] = MFMA32(f0_, p10, OT[h_ >> 1]); OT[h_ >> 1] = MFMA32(f1_, p11, OT[h_ >> 1]); } else { OT[h_ >> 1] = MFMA32(f0_, p00, OT[h_ >> 1]); OT[h_ >> 1] = MFMA32(f1_, p01, OT[h_ >> 1]); } } } while (0)
            MLA_LOAD(0); MLA_STORE(0, 0); __syncthreads();
            int v3 = 0;
            for (int t = 0; t < NT; ++t) {
                const LAS unsigned char* Kb = Kl + (t & 1) * KB; const LAS unsigned char* Vb = Vl + v3 * VB; const int vprev = (v3 == 0) ? 2 : v3 - 1, vnext = (v3 == 2) ? 0 : v3 + 1;
                if (t + 1 < NT) MLA_LOAD(t + 1);
                if (trail && pact) MLA_PV(Vl + vprev * VB);
                const int kbase = 64 * t; const bool act = kbase <= q0w + 31;
                f32x16 s0, s1;
                if (act) {
#pragma unroll
                    for (int e = 0; e < 16; ++e) { s0[e] = -m_ref; s1[e] = -m_ref; }
                    const LAS unsigned char* kp = Kb + r * KP + hf * 16;
                    bf16x8 kf[2][2];
#define MLA_KRD(g, B) do { kf[B][0] = *(const LAS bf16x8*)(kp + (g) * 32); kf[B][1] = *(const LAS bf16x8*)(kp + 32 * KP + (g) * 32); } while (0)
                    MLA_KRD(0, 0);
#pragma unroll
                    for (int g = 0; g < 12; ++g) {
                        if (g + 1 < 12) { if (g & 1) MLA_KRD(g + 1, 0); else MLA_KRD(g + 1, 1); }
                        __builtin_amdgcn_sched_barrier(0);
                        s0 = MFMA32(kf[g & 1][0], qf[g], s0); s1 = MFMA32(kf[g & 1][1], qf[g], s1);
                        __builtin_amdgcn_sched_barrier(0);
                    }
#undef MLA_KRD
                }
                if (act) {
                    if (kbase + 63 > q0w) { const int qq = q0w + r - kbase;
#pragma unroll
                        for (int e = 0; e < 16; ++e) { const int kk = crow(e, hf); if (kk > qq) s0[e] = -1e30f; if (kk + 32 > qq) s1[e] = -1e30f; } }
                    float tm = s0[0];
#pragma unroll
                    for (int e = 1; e < 16; ++e) tm = fmaxf(tm, s0[e]);
#pragma unroll
                    for (int e = 0; e < 16; ++e) tm = fmaxf(tm, s1[e]);
                    tm = fmaxf(tm, __shfl_xor(tm, 32));
                    if (t == 0 || __any(tm > MLA_THR)) {
                        const bool mv = (t == 0) || (tm > MLA_THR);
                        const float mnew = m_ref + tm;
                        const float dl = mv ? mnew - m_ref : 0.f; m_ref += dl;
#pragma unroll
                        for (int e = 0; e < 16; ++e) { s0[e] -= dl; s1[e] -= dl; }
                        if (t > 0) { const float al = __builtin_amdgcn_exp2f(-dl); l_run *= al;
#pragma unroll
                            for (int d = 0; d < 4; ++d)
#pragma unroll
                                for (int e = 0; e < 16; ++e) OT[d][e] *= al; }
                    }
                    float ls = 0.f;
#pragma unroll
                    for (int e = 0; e < 16; ++e) { s0[e] = __builtin_amdgcn_exp2f(s0[e]); s1[e] = __builtin_amdgcn_exp2f(s1[e]); ls += s0[e] + s1[e]; }
                    l_run += ls;
                    p00 = pack8(s0, 0); p01 = pack8(s0, 8); p10 = pack8(s1, 0); p11 = pack8(s1, 8);
                    if (!trail) MLA_PV(Vb);
                }
                pact = act;
                if (t + 1 < NT) MLA_STORE((t + 1) & 1, vnext);
                v3 = vnext;
                __syncthreads();
            }
            if (trail && pact) MLA_PV(Vl + ((v3 == 0) ? 2 : v3 - 1) * VB);
#undef MLA_LOAD
#undef MLA_STORE
#undef MLA_PV
            l_run += __shfl_xor(l_run, 32);
            const float il = 1.f / l_run;
            bf16* op = CO + (rb + q0w + r) * 768 + h * 128 + 4 * hf;
#pragma unroll
            for (int d = 0; d < 4; ++d)
#pragma unroll
                for (int g4 = 0; g4 < 4; ++g4) { u32x2 w; w.x = pg8::cvt_pk_bf16(OT[d][4 * g4] * il, OT[d][4 * g4 + 1] * il); w.y = pg8::cvt_pk_bf16(OT[d][4 * g4 + 2] * il, OT[d][4 * g4 + 3] * il); *(u32x2*)(op + 32 * d + 8 * g4) = w; }
            __syncthreads();
        }
    }
}
#undef MLA_OFFS
__device__ __forceinline__ void dwa_phase(LAS unsigned char* lds, const bf16* QKVA, bf16* AOG, float* LSE, int vcu, int G, int tid, int lane, int wave) {
    constexpr int KP = 144, VP = 128, KBY = 384 * KP;
    LAS unsigned char* Kl = lds; LAS unsigned char* Vl = lds + KBY;
    const int r = lane & 31, hf = lane >> 5;
    for (int u = vcu * 12; u < vcu * 12 + 12 && u < 3072; ++u) {
        const int v16 = u & 15, hh = (u >> 4) & 3, bg = u >> 6, g = bg % 3, b = bg / 3;
        const int dil = (g == 0) ? 1 : (g == 1) ? 4 : 16, res = (g == 0) ? 0 : (g == 1) ? (v16 >> 2) : v16, qb = (g == 0) ? v16 : (g == 1) ? (v16 & 3) : 0;
        const int head = 4 * g + hh; const size_t rb = (size_t)b * SEQ; const int j0 = 256 * qb - 128;
        const bf16* kb_ = QKVA + rb * P_QKVA + 768 + head * 64; const bf16* vb_ = QKVA + rb * P_QKVA + 1536 + head * 64;
        u32x4 kr[6], vr[6];
#pragma unroll
        for (int i = 0; i < 6; ++i) { const int c = tid + 512 * i, jw = c >> 3, ch = c & 7, jj = j0 + jw; const bool ok = jj >= 0; const size_t off = (size_t)(ok ? jj * dil + res : 0) * P_QKVA + ch * 8;
            kr[i] = ok ? *(const u32x4*)(kb_ + off) : (u32x4){0u, 0u, 0u, 0u}; vr[i] = ok ? *(const u32x4*)(vb_ + off) : (u32x4){0u, 0u, 0u, 0u}; }
        const int jq0 = 256 * qb + 32 * wave;
        bf16x8 qf[4];
        { const bf16* qp = QKVA + (rb + (size_t)(jq0 + r) * dil + res) * P_QKVA + head * 64 + 8 * hf;
#pragma unroll
          for (int s = 0; s < 4; ++s) qf[s] = *(const bf16x8*)(qp + 16 * s); }
#pragma unroll
        for (int i = 0; i < 6; ++i) { const int c = tid + 512 * i, jw = c >> 3, ch = c & 7; *(LAS u32x4*)(Kl + jw * KP + ch * 16) = kr[i]; *(LAS u32x4*)(Vl + jw * VP + ch * 16) = vr[i]; }
        __syncthreads();
        f32x16 st[5];
        const LAS unsigned char* kp = Kl + (32 * wave + r) * KP + hf * 16;
#pragma unroll
        for (int c = 0; c < 5; ++c) {
#pragma unroll
            for (int e = 0; e < 16; ++e) st[c][e] = 0.f;
#pragma unroll
            for (int s = 0; s < 4; ++s) { const bf16x8 kf = *(const LAS bf16x8*)(kp + 32 * c * KP + s * 32); st[c] = MFMA32(kf, qf[s], st[c]); } }
        float tm = -1e30f;
#pragma unroll
        for (int c = 0; c < 5; ++c)
#pragma unroll
            for (int e = 0; e < 16; ++e) { const int kk = 32 * c + crow(e, hf); const int dj = r + 128 - kk; const bool ok = (dj >= 0) && (dj <= 128) && (jq0 - 128 + kk >= 0); st[c][e] = ok ? st[c][e] : -1e30f; tm = fmaxf(tm, st[c][e]); }
        tm = fmaxf(tm, __shfl_xor(tm, 32));
        float ls = 0.f;
#pragma unroll
        for (int c = 0; c < 5; ++c)
#pragma unroll
            for (int e = 0; e < 16; ++e) { st[c][e] = __builtin_amdgcn_exp2f(st[c][e] - tm); ls += st[c][e]; }
        ls += __shfl_xor(ls, 32);
        f32x16 OT[2];
#pragma unroll
        for (int d = 0; d < 2; ++d)
#pragma unroll
            for (int e = 0; e < 16; ++e) OT[d][e] = 0.f;
        const LAS unsigned char* vp = Vl + (32 * wave + ((lane & 15) >> 2) + 4 * hf) * VP + (16 * ((lane >> 4) & 1) + 4 * (lane & 3)) * 2;
#pragma unroll
        for (int c = 0; c < 5; ++c)
#pragma unroll
            for (int s2 = 0; s2 < 2; ++s2) { const bf16x8 pf = pack8(st[c], 8 * s2);
#pragma unroll
                for (int d = 0; d < 2; ++d) { const s16x4 lo = vtr(vp + (32 * c + 16 * s2) * VP + 64 * d), hi = vtr(vp + (32 * c + 16 * s2 + 8) * VP + 64 * d);
                    const bf16x8 vf = {lo[0], lo[1], lo[2], lo[3], hi[0], hi[1], hi[2], hi[3]}; OT[d] = MFMA32(vf, pf, OT[d]); } }
        const float il = 1.f / ls; const size_t orow = rb + (size_t)(jq0 + r) * dil + res;
        bf16* op = AOG + ((size_t)g * MTOK + orow) * 256 + hh * 64 + 4 * hf;
#pragma unroll
        for (int d = 0; d < 2; ++d)
#pragma unroll
            for (int g4 = 0; g4 < 4; ++g4) { u32x2 w; w.x = pg8::cvt_pk_bf16(OT[d][4 * g4] * il, OT[d][4 * g4 + 1] * il); w.y = pg8::cvt_pk_bf16(OT[d][4 * g4 + 2] * il, OT[d][4 * g4 + 3] * il); *(u32x2*)(op + 32 * d + 8 * g4) = w; }
        if (hf == 0) LSE[((size_t)g * MTOK + orow) * 4 + hh] = tm + __builtin_amdgcn_logf(ls);
        __syncthreads();
    }
}

__device__ __forceinline__ void hgrn_phase(LAS unsigned char* lds, bf16* BIN, bf16* BO, const float* lbw, const float* gn, float* SH, int vcu, int G, int tid, int lane, int wave) {
    constexpr int PQ = 272, PK = 80, PO = 400;
    constexpr int O_QT = 0, O_KT = 32 * PQ, O_QI = 2 * 32 * PQ, O_KE = 3 * 32 * PQ, O_VT = O_KE + 128 * PK, O_DEC = O_VT + 96 * PK, O_ST = O_DEC + 512, STB = 96 * PQ, O_OB = O_ST + 2 * STB, OBB = 32 * PO, PG = 208, O_GB = O_OB + 2 * OBB, GBB = 32 * PG;
    static_assert(O_GB + 2 * GBB <= PHASE_LDS, "hgrn LDS map");
    for (int unit = vcu; unit < BATCH * 8 * 2; unit += G) {
        const int chain = unit >> 1, half = unit & 1, b = chain >> 3, head = chain & 7, nbeg = half * (SEQ / 64);
        int lane_o = lane; asm volatile("" : "+v"(lane_o));
        const int dl0 = lane_o & 15, tseg0 = lane_o >> 4, d0 = 16 * wave + dl0, r0 = lane_o & 31, hf0 = lane_o >> 5;
        const float lb = lbw[head * 128 + d0], olb = 1.f - lb;
        bf16* cbase = BIN + (size_t)b * SEQ * P_BIN;
        const unsigned zqo = (unsigned)((8 * tseg0) * P_BIN + head * 128 + d0);
        const unsigned vo0 = (unsigned)((tid >> 4) * P_BIN + 2048 + head * 96 + (tid & 15));
        const unsigned vl0 = (unsigned)((tid & 15) * PK + (tid >> 4) * 2);
        const unsigned gso = (unsigned)((tid / 12) * P_BIN + 2816 + head * 96 + (tid % 12) * 8);
        const unsigned gl0 = (unsigned)((tid / 12) * PG + (tid % 12) * 16);
        float run = 0.f;
        f32x16 Sv[3];
#pragma unroll
        for (int i = 0; i < 3; ++i)
#pragma unroll
            for (int e = 0; e < 16; ++e) Sv[i][e] = 0.f;
        for (int i = tid; i < STB / 4; i += 512) ((LAS unsigned*)(lds + O_ST))[i] = 0u;
        unsigned zrA[8], qrA[8], vrA[6], zrB[8], qrB[8], vrB[6];
        u32x4 ggA = (u32x4){0u, 0u, 0u, 0u}, ggB = (u32x4){0u, 0u, 0u, 0u};
        const f32x4 gna = *(const f32x4*)(gn + (tid % 12) * 8), gnb = *(const f32x4*)(gn + (tid % 12) * 8 + 4);
#define HG_LOAD(n, zr, qr, vr) do { const bf16* p_ = cbase + (size_t)(n) * 32 * P_BIN; _Pragma("unroll") for (int i = 0; i < 8; ++i) { qr[i] = p_[zqo + (unsigned)(i * P_BIN)]; zr[i] = p_[zqo + (unsigned)(i * P_BIN + 1024)]; } \
                        _Pragma("unroll") for (int k = 0; k < 6; ++k) vr[k] = p_[vo0 + 16u * k]; } while (0)
#define HG_LOADG(n, gg) do { if (half == 0 && tid < 384) gg = *(const u32x4*)(cbase + (size_t)(n) * 32 * P_BIN + gso); } while (0)
#define HG_GNORM(c) do { const LAS unsigned char* ob_ = lds + O_OB + ((c) & 1) * OBB + r * PO + hf * 192; const LAS unsigned char* gb_ = lds + O_GB + ((c) & 1) * GBB + r * PG + hf * 96; \
            float ss_ = 0.f; _Pragma("unroll") for (int i = 0; i < 12; ++i) { const f32x4 o_ = *(const LAS f32x4*)(ob_ + 16 * i); ss_ += (o_[0] * o_[0] + o_[1] * o_[1]) + (o_[2] * o_[2] + o_[3] * o_[3]); } \
            ss_ += __shfl_xor(ss_, 32); const float rs_ = 1.f / sqrtf(ss_ * (1.f / 96.f) + EPS); \
            asm volatile("" ::: "memory");     \
            bf16* op_ = BO + ((size_t)b * SEQ + (size_t)(c) * 32 + r) * 768 + head * 96 + 48 * hf; \
            _Pragma("unroll") for (int i = 0; i < 6; ++i) { const u32x4 gw_ = *(const LAS u32x4*)(gb_ + 16 * i); \
                const f32x4 oa_ = *(const LAS f32x4*)(ob_ + 32 * i), ob2_ = *(const LAS f32x4*)(ob_ + 32 * i + 16); \
                u32x4 w_; w_.x = pg8::cvt_pk_bf16(oa_[0] * rs_ * bflo(gw_.x), oa_[1] * rs_ * bfhi(gw_.x)); w_.y = pg8::cvt_pk_bf16(oa_[2] * rs_ * bflo(gw_.y), oa_[3] * rs_ * bfhi(gw_.y)); \
                w_.z = pg8::cvt_pk_bf16(ob2_[0] * rs_ * bflo(gw_.z), ob2_[1] * rs_ * bfhi(gw_.z)); w_.w = pg8::cvt_pk_bf16(ob2_[2] * rs_ * bflo(gw_.w), ob2_[3] * rs_ * bfhi(gw_.w)); \
                *(u32x4*)(op_ + 8 * i) = w_; } } while (0)
#define HG_RAW(c) do { const LAS unsigned char* ob_ = lds + O_OB + ((c) & 1) * OBB + r * PO + hf * 192; bf16* op_ = BO + ((size_t)b * SEQ + (size_t)(c) * 32 + r) * 768 + head * 96 + 48 * hf; \
            _Pragma("unroll") for (int i = 0; i < 6; ++i) { const f32x4 oa_ = *(const LAS f32x4*)(ob_ + 32 * i), ob2_ = *(const LAS f32x4*)(ob_ + 32 * i + 16); \
                u32x4 w_; w_.x = pg8::cvt_pk_bf16(oa_[0], oa_[1]); w_.y = pg8::cvt_pk_bf16(oa_[2], oa_[3]); w_.z = pg8::cvt_pk_bf16(ob2_[0], ob2_[1]); w_.w = pg8::cvt_pk_bf16(ob2_[2], ob2_[3]); *(u32x4*)(op_ + 8 * i) = w_; } } while (0)
#define HG_STEP(n, zr, qr, vr, gg) do { \
            int ln_ = lane; asm volatile("" : "+v"(ln_));     \
            const int r = ln_ & 31, hf = ln_ >> 5, dl = ln_ & 15, tseg = ln_ >> 4, d = 16 * wave + dl; (void)r; (void)hf; \
            _Pragma("unroll") for (int i = 0; i < 8; ++i) asm volatile("" : "+v"(zr[i]), "+v"(qr[i]));     \
            _Pragma("unroll") for (int k = 0; k < 6; ++k) asm volatile("" : "+v"(vr[k])); \
            float lf[8], kk[8], qv[8]; \
            _Pragma("unroll") for (int i = 0; i < 8; ++i) { const float z = __builtin_bit_cast(float, zr[i] << 16); const float sg = sigmoidf_(z); const float f = lb + olb * sg; kk[i] = olb * (1.f - sg); lf[i] = __builtin_amdgcn_logf(f); qv[i] = __builtin_bit_cast(float, qr[i] << 16); } \
            _Pragma("unroll") for (int i = 1; i < 8; ++i) lf[i] += lf[i - 1]; \
            const float T = lf[7]; \
            const float T0 = __shfl(T, dl), T1 = __shfl(T, dl + 16), T2 = __shfl(T, dl + 32), T3 = __shfl(T, dl + 48); \
            const float ref = T0 + T1, total = ref + T2 + T3; \
            const float pre = (tseg == 0) ? 0.f : (tseg == 1) ? T0 : (tseg == 2) ? ref : ref + T2; \
            const float eref = __builtin_amdgcn_exp2f(ref), etr = __builtin_amdgcn_exp2f(total - ref); \
            unsigned kew[4]; const float erun = half ? __builtin_amdgcn_exp2f(run) * eref : 0.f; \
            _Pragma("unroll") for (int i = 0; i < 8; i += 2) { const float e1a = __builtin_amdgcn_exp2f(pre + lf[i] - ref), e1b = __builtin_amdgcn_exp2f(pre + lf[i + 1] - ref); const float r1a = __builtin_amdgcn_rcpf(e1a), r1b = __builtin_amdgcn_rcpf(e1b); \
                const float qta = qv[i] * e1a, qtb = qv[i + 1] * e1b, kta = kk[i] * r1a, ktb = kk[i + 1] * r1b; \
                const unsigned wq = pg8::cvt_pk_bf16(qta, qtb), wk = pg8::cvt_pk_bf16(kta, ktb), wi = pg8::cvt_pk_bf16(qta * eref, qtb * eref); kew[i >> 1] = pg8::cvt_pk_bf16(kta * etr, ktb * etr); \
                const int t = 8 * tseg + i; \
                if (half) { bf16* qd_ = cbase + (size_t)(n) * 32 * P_BIN + (zqo + (unsigned)(i * P_BIN)); const unsigned wd_ = pg8::cvt_pk_bf16(qta * erun, qtb * erun); qd_[0] = (bf16)(wd_ & 0xffffu); qd_[P_BIN] = (bf16)(wd_ >> 16); } \
                *(LAS bf16*)(lds + O_QT + t * PQ + d * 2) = (bf16)(wq & 0xffffu); *(LAS bf16*)(lds + O_QT + (t + 1) * PQ + d * 2) = (bf16)(wq >> 16); \
                *(LAS bf16*)(lds + O_KT + t * PQ + d * 2) = (bf16)(wk & 0xffffu); *(LAS bf16*)(lds + O_KT + (t + 1) * PQ + d * 2) = (bf16)(wk >> 16); \
                *(LAS bf16*)(lds + O_QI + t * PQ + d * 2) = (bf16)(wi & 0xffffu); *(LAS bf16*)(lds + O_QI + (t + 1) * PQ + d * 2) = (bf16)(wi >> 16); } \
            *(LAS u32x4*)(lds + O_KE + d * PK + tseg * 16) = (u32x4){kew[0], kew[1], kew[2], kew[3]}; \
            if (tseg == 0) *(LAS float*)(lds + O_DEC + d * 4) = __builtin_amdgcn_exp2f(total); \
            run += total; \
            _Pragma("unroll") for (int k = 0; k < 6; ++k) *(LAS bf16*)(lds + O_VT + vl0 + 16 * PK * k) = (bf16)vr[k]; \
            if (half == 0 && tid < 384) { const float g0_ = bflo(gg.x), g1_ = bfhi(gg.x), g2_ = bflo(gg.y), g3_ = bfhi(gg.y), g4_ = bflo(gg.z), g5_ = bfhi(gg.z), g6_ = bflo(gg.w), g7_ = bfhi(gg.w); u32x4 sw_; \
                sw_.x = pg8::cvt_pk_bf16(gna[0] * g0_ * sigmoidf_(g0_), gna[1] * g1_ * sigmoidf_(g1_)); sw_.y = pg8::cvt_pk_bf16(gna[2] * g2_ * sigmoidf_(g2_), gna[3] * g3_ * sigmoidf_(g3_)); \
                sw_.z = pg8::cvt_pk_bf16(gnb[0] * g4_ * sigmoidf_(g4_), gnb[1] * g5_ * sigmoidf_(g5_)); sw_.w = pg8::cvt_pk_bf16(gnb[2] * g6_ * sigmoidf_(g6_), gnb[3] * g7_ * sigmoidf_(g7_)); \
                *(LAS u32x4*)(lds + O_GB + ((n) & 1) * GBB + gl0) = sw_; }     \
            __syncthreads(); \
            const LAS unsigned char* STc = lds + O_ST + ((n) & 1) * STB; LAS unsigned char* STn = lds + O_ST + (((n) + 1) & 1) * STB; \
            if (wave < 3) { \
                const int vb = wave; \
                  \
                bf16x8 fa[2][2], fb[2][2]; \
                const LAS unsigned char* ktp = lds + O_KT + r * PQ + hf * 16; const LAS unsigned char* qtp = lds + O_QT + r * PQ + hf * 16; \
                const LAS unsigned char* stp = STc + (32 * vb + r) * PQ + hf * 16; const LAS unsigned char* qip = lds + O_QI + r * PQ + hf * 16; \
                const LAS unsigned char* vp = lds + O_VT + (32 * vb + r) * PK + hf * 8; \
                const u32x2 a0 = *(const LAS u32x2*)(vp), a1 = *(const LAS u32x2*)(vp + 16), b0 = *(const LAS u32x2*)(vp + 32), b1 = *(const LAS u32x2*)(vp + 48); \
                fa[0][0] = *(const LAS bf16x8*)(ktp); fb[0][0] = *(const LAS bf16x8*)(qtp); fa[0][1] = *(const LAS bf16x8*)(ktp + 32); fb[0][1] = *(const LAS bf16x8*)(qtp + 32); \
                f32x16 at, ot; \
                _Pragma("unroll") for (int e = 0; e < 16; ++e) { at[e] = 0.f; ot[e] = 0.f; } \
                bf16x8 pa0, pa1; \
                _Pragma("unroll") for (int g = 0; g < 8; ++g) { \
                    if (g + 1 < 8) { const int n_ = g + 1, B_ = n_ & 1; const LAS unsigned char* pa_ = (n_ < 4) ? ktp + n_ * 64 : stp + (n_ - 4) * 64; const LAS unsigned char* pb_ = (n_ < 4) ? qtp + n_ * 64 : qip + (n_ - 4) * 64; \
                        fa[B_][0] = *(const LAS bf16x8*)(pa_); fb[B_][0] = *(const LAS bf16x8*)(pb_); fa[B_][1] = *(const LAS bf16x8*)(pa_ + 32); fb[B_][1] = *(const LAS bf16x8*)(pb_ + 32); } \
                    __builtin_amdgcn_sched_barrier(0); \
                    if (g < 4) { at = MFMA32(fa[g & 1][0], fb[g & 1][0], at); at = MFMA32(fa[g & 1][1], fb[g & 1][1], at); } \
                    else { ot = MFMA32(fa[g & 1][0], fb[g & 1][0], ot); ot = MFMA32(fa[g & 1][1], fb[g & 1][1], ot); } \
                    if (g == 3) { _Pragma("unroll") for (int e = 0; e < 16; ++e) at[e] = (crow(e, hf) <= r) ? at[e] : 0.f; pa0 = pack8(at, 0); pa1 = pack8(at, 8); } \
                    __builtin_amdgcn_sched_barrier(0); } \
                { const bf16x8 v0 = __builtin_bit_cast(bf16x8, (u32x4){a0.x, a0.y, a1.x, a1.y}), v1 = __builtin_bit_cast(bf16x8, (u32x4){b0.x, b0.y, b1.x, b1.y}); \
                  ot = MFMA32(v0, pa0, ot); ot = MFMA32(v1, pa1, ot); } \
                LAS unsigned char* obw = lds + O_OB + ((n) & 1) * OBB + r * PO + (32 * vb + 4 * hf) * 4; \
                _Pragma("unroll") for (int g4 = 0; g4 < 4; ++g4) *(LAS f32x4*)(obw + 32 * g4) = (f32x4){ot[4 * g4], ot[4 * g4 + 1], ot[4 * g4 + 2], ot[4 * g4 + 3]}; \
            } else if (wave == 3) { \
                if ((n) > nbeg) { if (half) HG_RAW((n) - 1); else HG_GNORM((n) - 1); } \
            } else { \
                const int db = wave - 4; \
                float dec[16]; \
                _Pragma("unroll") for (int g4 = 0; g4 < 4; ++g4) { const f32x4 dv = *(const LAS f32x4*)(lds + O_DEC + (32 * db + 8 * g4 + 4 * hf) * 4); dec[4 * g4] = dv[0]; dec[4 * g4 + 1] = dv[1]; dec[4 * g4 + 2] = dv[2]; dec[4 * g4 + 3] = dv[3]; } \
                const bf16x8 ke0 = *(const LAS bf16x8*)(lds + O_KE + (32 * db + r) * PK + hf * 16), ke1 = *(const LAS bf16x8*)(lds + O_KE + (32 * db + r) * PK + 32 + hf * 16); \
                _Pragma("unroll") for (int vb = 0; vb < 3; ++vb) { \
                    _Pragma("unroll") for (int e = 0; e < 16; ++e) Sv[vb][e] *= dec[e]; \
                    const bf16x8 v0 = *(const LAS bf16x8*)(lds + O_VT + (32 * vb + r) * PK + hf * 16), v1 = *(const LAS bf16x8*)(lds + O_VT + (32 * vb + r) * PK + 32 + hf * 16); \
                    Sv[vb] = MFMA32(ke0, v0, Sv[vb]); Sv[vb] = MFMA32(ke1, v1, Sv[vb]); \
                    _Pragma("unroll") for (int g4 = 0; g4 < 4; ++g4) { u32x2 w; w.x = pg8::cvt_pk_bf16(Sv[vb][4 * g4], Sv[vb][4 * g4 + 1]); w.y = pg8::cvt_pk_bf16(Sv[vb][4 * g4 + 2], Sv[vb][4 * g4 + 3]); \
                        *(LAS u32x2*)(STn + (32 * vb + r) * PQ + (32 * db + 8 * g4 + 4 * hf) * 2) = w; } } \
            } \
            __syncthreads(); } while (0)
        HG_LOAD(nbeg, zrA, qrA, vrA); HG_LOADG(nbeg, ggA);
        const int nend = nbeg + SEQ / 64;
#pragma unroll 1
        for (int n = nbeg; n < nend; ++n) {
            if (n + 1 < nend) { HG_LOAD(n + 1, zrB, qrB, vrB); HG_LOADG(n + 1, ggB); }
            HG_STEP(n, zrA, qrA, vrA, ggA);
            ggA = ggB;
#pragma unroll
            for (int i = 0; i < 8; ++i) { zrA[i] = zrB[i]; qrA[i] = qrB[i]; }
#pragma unroll
            for (int k = 0; k < 6; ++k) vrA[k] = vrB[k];
        }
        { const int r = r0, hf = hf0; if (wave == 3) { if (half) HG_RAW(nend - 1); else HG_GNORM(nend - 1); }
          if (half == 0 && wave >= 4) { const int db = wave - 4; float* sp = SH + (size_t)chain * (128 * 96);
#pragma unroll
              for (int vb = 0; vb < 3; ++vb)
#pragma unroll
                  for (int e = 0; e < 16; ++e) sp[(32 * db + crow(e, hf)) * 96 + 32 * vb + r] = Sv[vb][e]; } }
        __syncthreads();
#undef HG_LOAD
#undef HG_LOADG
#undef HG_STEP
#undef HG_GNORM
#undef HG_RAW
    }
}

__device__ __forceinline__ RsTab rs_preload(LAS unsigned char* lds, const float* SS, const pg8::StaticOrder& S, int tid) {
    LAS float* tab = (LAS float*)(lds + RS_OFF); pg8::Unit u; RsTab T; T.tab = tab; T.g0 = 0;
    if (!S.next(0, u)) return T;
    T.g0 = u.pm >> 3; int last = -1;
    for (int i = 0; S.next(i, u); ++i) { const int gid = u.pm >> 3; if (gid == last) continue; last = gid;
        if (tid < 256 && gid - T.g0 < RS_SLOTS) tab[((gid - T.g0) << 8) + tid] = row_rstd(SS, u.pm * 256 + tid); }
    __syncthreads();
    return T;
}

__device__ __forceinline__ void hgrn_fix_phase(LAS unsigned char* lds, const bf16* BIN, bf16* BO, const float* gn, const float* SH, int vcu, int G, int tid, int lane, int wave) {
    constexpr int PQ = 272;
    const int r = lane & 31, hf = lane >> 5;
    for (int unit = vcu; unit < BATCH * 8 * 2; unit += G) {
        const int chain = unit >> 1, sub = unit & 1, b = chain >> 3, head = chain & 7;
        __syncthreads();
        { const float* sp = SH + (size_t)chain * (128 * 96);
          for (int i = tid; i < 128 * 96; i += 512) { const int d = i / 96, v = i - 96 * d; *(LAS bf16*)(lds + v * PQ + d * 2) = (bf16)f2bf(sp[i]); } }
        __syncthreads();
        for (int j = 0; j < 4; ++j) {
            const int n = SEQ / 64 + 32 * sub + 4 * wave + j; const size_t row = (size_t)b * SEQ + (size_t)n * 32 + r;
            bf16x8 qd[8];
            { const bf16* qp = BIN + row * P_BIN + head * 128 + 8 * hf;
#pragma unroll
              for (int kd = 0; kd < 8; ++kd) qd[kd] = *(const bf16x8*)(qp + 16 * kd); }
            f32x16 ot[3]; float ss = 0.f;
            bf16* op = BO + row * 768 + head * 96 + 4 * hf; const bf16* gp = BIN + row * P_BIN + 2816 + head * 96 + 4 * hf;
#pragma unroll
            for (int vb = 0; vb < 3; ++vb) {
#pragma unroll
                for (int e = 0; e < 16; ++e) ot[vb][e] = 0.f;
#pragma unroll
                for (int kd = 0; kd < 8; ++kd) { const bf16x8 sf = *(const LAS bf16x8*)(lds + (32 * vb + r) * PQ + kd * 32 + hf * 16); ot[vb] = MFMA32(sf, qd[kd], ot[vb]); }
#pragma unroll
                for (int g4 = 0; g4 < 4; ++g4) { const u32x2 w = *(const u32x2*)(op + 32 * vb + 8 * g4); ot[vb][4 * g4] += bflo(w.x); ot[vb][4 * g4 + 1] += bfhi(w.x); ot[vb][4 * g4 + 2] += bflo(w.y); ot[vb][4 * g4 + 3] += bfhi(w.y); }
#pragma unroll
                for (int e = 0; e < 16; ++e) ss += ot[vb][e] * ot[vb][e]; }
            ss += __shfl_xor(ss, 32);
            const float rs = 1.f / sqrtf(ss * (1.f / 96.f) + EPS);
#pragma unroll
            for (int vb = 0; vb < 3; ++vb)
#pragma unroll
                for (int g4 = 0; g4 < 4; ++g4) { const u32x2 gw = *(const u32x2*)(gp + 32 * vb + 8 * g4); const f32x4 ga = *(const f32x4*)(gn + 32 * vb + 8 * g4 + 4 * hf);
                    const float g0 = bflo(gw.x), g1 = bfhi(gw.x), g2 = bflo(gw.y), g3 = bfhi(gw.y);
                    u32x2 w; w.x = pg8::cvt_pk_bf16(ot[vb][4 * g4] * rs * ga[0] * (g0 * sigmoidf_(g0)), ot[vb][4 * g4 + 1] * rs * ga[1] * (g1 * sigmoidf_(g1)));
                    w.y = pg8::cvt_pk_bf16(ot[vb][4 * g4 + 2] * rs * ga[2] * (g2 * sigmoidf_(g2)), ot[vb][4 * g4 + 3] * rs * ga[3] * (g3 * sigmoidf_(g3)));
                    *(u32x2*)(op + 32 * vb + 8 * g4) = w; }
        }
    }
}

typedef const unsigned char __attribute__((address_space(4)))* karg_ptr;
__device__ __forceinline__ const float* karg_in(int k) { karg_ptr kp = (karg_ptr)__builtin_amdgcn_kernarg_segment_ptr(); asm volatile("" : "+s"(kp)); return *(const float* const __attribute__((address_space(4)))*)(kp + 8 * k); }
__device__ __forceinline__ unsigned char* karg_ws() { karg_ptr kp = (karg_ptr)__builtin_amdgcn_kernarg_segment_ptr(); asm volatile("" : "+s"(kp)); return *(unsigned char* const __attribute__((address_space(4)))*)(kp + 200); }
__device__ __forceinline__ float* karg_out() { karg_ptr kp = (karg_ptr)__builtin_amdgcn_kernarg_segment_ptr(); asm volatile("" : "+s"(kp)); return *(float* const __attribute__((address_space(4)))*)(kp + 192); }
constexpr int NPH = 19, NPHASES = DEPTH * NPH + 1;
struct Args { const float* in[24]; float* out; unsigned char* ws; int ph_lo, ph_hi; };
static_assert(sizeof(Args) == 24 * 8 + 8 + 8 + 8, "Args has no padding");

__global__ void __launch_bounds__(512, 2) mk_fwd(Args args) {
    extern __shared__ __attribute__((aligned(16))) unsigned char lds_raw[];
    LAS unsigned char* lds = (LAS unsigned char*)lds_raw;
    volatile LAS unsigned* MISC = (volatile LAS unsigned*)(lds + MISC_OFF);
    const int tid0 = threadIdx.x, lane0 = tid0 & 63, wave0 = __builtin_amdgcn_readfirstlane(tid0 >> 6);
    const int G0 = gridDim.x, bx0 = blockIdx.x;
    const int vcu0 = (G0 % 8 == 0) ? (bx0 % 8) * (G0 / 8) + bx0 / 8 : bx0;
    const int gw0 = vcu0 * 8 + wave0, NGW0 = G0 * 8;
#define PH_LOCALS int z_ = 0; asm volatile("" : "+v"(z_)); int lane = (int)__builtin_amdgcn_mbcnt_hi(~0u, __builtin_amdgcn_mbcnt_lo(~0u, (unsigned)z_)), wave = wave0, tid = wave0 * 64 + lane, G = G0, bx = bx0, vcu = vcu0, gw = gw0, NGW = NGW0;   \
    asm volatile("" : "+v"(tid), "+v"(lane), "+s"(wave), "+s"(G), "+s"(bx), "+s"(vcu), "+s"(gw), "+s"(NGW)); (void)tid; (void)lane; (void)wave; (void)G; (void)bx; (void)vcu; (void)gw; (void)NGW;
    for (int u = tid0; u < (LDS_BYTES - LDSCTL_OFF) / 4; u += 512) ((LAS unsigned*)(lds + LDSCTL_OFF))[u] = 0u;
    __syncthreads();
    const int lo = args.ph_lo, hi = args.ph_hi;
    if (hi - lo > 1) (void)xcd_barrier_post((unsigned*)(karg_ws() + WS_CTL) + CW_BAR, MISC + 8);
#define IN(k) (lo <= (k) && (k) < hi)
#define INP(p) ((((PH_MASK) >> (p)) & 1u) && IN(pb + (p)))
#define SEAM(k) do { if (IN(k) && IN((k) + 1)) { XcdBarrier b_; b_.bar = (unsigned*)(karg_ws() + WS_CTL) + CW_BAR; b_.x = xb_xcc_id(); b_.st = (volatile LAS unsigned*)(lds + MISC_OFF) + 8; int zb_ = 0; asm volatile("" : "+v"(zb_)); \
    const bool ld_ = (wave0 == 0) && ((int)__builtin_amdgcn_mbcnt_hi(~0u, __builtin_amdgcn_mbcnt_lo(~0u, (unsigned)zb_)) == 0); xcd_barrier(b_, ld_); } } while (0)

#define X (karg_out())
#define WSP(T, off) ((T*)(karg_ws() + (off)))
#define ropeA WSP(float, WS_ROPEA)
#define ropeC WSP(float, WS_ROPEC)
#define LBW WSP(float, WS_LB)
#define W1U WSP(bf16, WS_W + W_1U)
#define W1D WSP(bf16, WS_W + W_1D)
#define WIN1 WSP(bf16, WS_W + W_IN1)
#define WINB WSP(bf16, WS_W + W_INB)
#define WING WSP(bf16, WS_W + W_ING)
#define WQB WSP(bf16, WS_W + W_QB)
#define WKVB WSP(bf16, WS_W + W_KVB)
#define WA WSP(bf16, WS_W + W_A)
#define WBb WSP(bf16, WS_W + W_B)
#define WC WSP(bf16, WS_W + W_C)
#define WO WSP(bf16, WS_W + W_O)
#define W2U WSP(bf16, WS_W + W_2U)
#define W2D WSP(bf16, WS_W + W_2D)
#define WPG WSP(bf16, WS_W + W_PG)
#define WPP WSP(bf16, WS_W + W_PP)
#define XN WSP(bf16, WS_XN)
#define XBE WSP(bf16, WS_XBE)
#define XBO WSP(bf16, WS_XBO)
#define SS0 WSP(float, WS_SS0)
#define SS1 WSP(float, WS_SS1)
#define MG WSP(bf16, WS_MG)
#define H WSP(bf16, WS_H)
#define QKVA WSP(bf16, WS_QKVA)
#define CLR WSP(bf16, WS_CLR)
#define QC WSP(bf16, WS_QC)
#define CO WSP(bf16, WS_CO)
#define KVC WSP(bf16, WS_KVC)
#define AOUT WSP(bf16, WS_AOUT)
#define AOG WSP(bf16, WS_AOG)
#define LSEB WSP(float, WS_LSE)
#define SHB WSP(float, WS_SH)
#define BIN WSP(bf16, WS_BIN)
#define BO WSP(bf16, WS_BO)
#define GS WSP(unsigned char, WS_GS)
#define PB WSP(bf16, WS_PB)
#define PP WSP(bf16, WS_PP)

#define WPREP(LY, SEL) do { \
            int ln_w = lane, wv_w = wave, gw_w = gw; asm volatile("" : "+v"(ln_w), "+s"(wv_w), "+s"(gw_w)); \
            LAS float* scr = (LAS float*)(lds + wv_w * 16384); \
            bf16* const w1U = W1U; bf16* const w1D = W1D; bf16* const wIN1 = WIN1; bf16* const wINB = WINB; bf16* const wING = WING; bf16* const wQB = WQB; bf16* const wKVB = WKVB; bf16* const wA = WA; \
            bf16* const wB = WBb; bf16* const wC = WC; bf16* const wO = WO; bf16* const w2U = W2U; bf16* const w2D = W2D; bf16* const wPG = WPG; bf16* const wPP = WPP; \
            const float* w1u = karg_in(3) + (size_t)(LY) * DM * 2 * DFF; const float* w1d = karg_in(4) + (size_t)(LY) * DFF * DM; const float* win = karg_in(6) + (size_t)(LY) * DM * INW; \
            const float* wqb = karg_in(10) + (size_t)(LY) * 384 * 1152; const float* wkvb = karg_in(12) + (size_t)(LY) * 256 * 1536; \
            const float* wa = karg_in(13) + (size_t)(LY) * 256 * DM; const float* wbb = karg_in(14) + (size_t)(LY) * 768 * DM; const float* wcc = karg_in(15) + (size_t)(LY) * 768 * DM; \
            const float* wo = karg_in(16) + (size_t)(LY) * DM * DM; const float* w2u = karg_in(18) + (size_t)(LY) * DM * 2 * DFF; const float* w2d = karg_in(19) + (size_t)(LY) * DFF * DM; \
            const float* wpg = karg_in(21) + (size_t)(LY) * DM * DM; const float* wpp = karg_in(22) + (size_t)(LY) * PLE * DM; \
            const float* gn1 = karg_in(2) + (LY) * DM; const float* gnm = karg_in(5) + (LY) * DM; const float* gn2 = karg_in(17) + (LY) * DM; const float* gnp = karg_in(20) + (LY) * DM; \
            constexpr int I_U = (1024 / 64) * (5632 / 32), I_D = (2816 / 64) * (1024 / 32), I_1 = 16 * (N_IN1 / 32), I_B = 16 * (N_INB / 32), I_G = 16 * (N_ING / 32), I_Q = 6 * (N_QB / 32), I_KV = 4 * (1536 / 32), \
                          I_A = 4 * 32, I_BC = 12 * 32, I_O = 16 * 32, I_PP = 4 * 32; \
            constexpr int NITEMS = 2 * I_U + 2 * I_D + I_1 + I_B + I_G + I_Q + I_KV + I_A + 2 * I_BC + 2 * I_O + I_PP; \
            for (int it = gw_w; it < NITEMS; it += NGW) { \
                int r = it; \
                if (r < I_U) { if ((SEL) != 2) wt_item<1, true>(w1u, 1024, 5632, 5632, w1U, scr, r, ln_w, gn1); continue; } r -= I_U; \
                if (r < I_U) { if ((SEL) != 2) wt_item<1, true>(w2u, 1024, 5632, 5632, w2U, scr, r, ln_w, gn2); continue; } r -= I_U; \
                if (r < I_D) { if ((SEL) != 2) wt_item<0>(w1d, 2816, 1024, 1024, w1D, scr, r, ln_w); continue; } r -= I_D; \
                if (r < I_D) { if ((SEL) != 2) wt_item<0>(w2d, 2816, 1024, 1024, w2D, scr, r, ln_w); continue; } r -= I_D; \
                if (r < I_1) { if ((SEL) != 2) wt_item<2, true>(win, 1024, INW, N_IN1, wIN1, scr, r, ln_w, gnm); continue; } r -= I_1; \
                if (r < I_B) { if ((SEL) != 2) wt_item<3, true>(win, 1024, INW, N_INB, wINB, scr, r, ln_w, gnm); continue; } r -= I_B; \
                if (r < I_G) { if ((SEL) != 2) wt_item<4, true>(win, 1024, INW, N_ING, wING, scr, r, ln_w, gnm); continue; } r -= I_G; \
                if (r < I_Q) { if ((SEL) != 2) wt_item<5>(wqb, 384, 1152, N_QB, wQB, scr, r, ln_w); continue; } r -= I_Q; \
                if (r < I_KV) { if ((SEL) != 2) wt_item<0>(wkvb, 256, 1536, 1536, wKVB, scr, r, ln_w); continue; } r -= I_KV; \
                if (r < I_A) { if ((SEL) != 2) wt_item<0>(wa, 256, 1024, 1024, wA, scr, r, ln_w); continue; } r -= I_A; \
                if (r < I_BC) { if ((SEL) != 2) wt_item<0>(wbb, 768, 1024, 1024, wB, scr, r, ln_w); continue; } r -= I_BC; \
                if (r < I_BC) { if ((SEL) != 2) wt_item<0>(wcc, 768, 1024, 1024, wC, scr, r, ln_w); continue; } r -= I_BC; \
                if (r < I_O) { if ((SEL) != 2) wt_item<0>(wo, 1024, 1024, 1024, wO, scr, r, ln_w); continue; } r -= I_O; \
                if (r < I_O) { if ((SEL) != 1) wt_item<0, true>(wpg, 1024, 1024, 1024, wPG, scr, r, ln_w, gnp); continue; } r -= I_O; \
                if ((SEL) != 1) wt_item<0>(wpp, 256, 1024, 1024, wPP, scr, r, ln_w); \
            } \
            } while (0)
    for (int Lyr = 0; Lyr < DEPTH; ++Lyr) {
        const int pb = Lyr * NPH;
        if (hi <= pb || lo >= pb + NPH) continue;

        if (Lyr == 0 && INP(0)) for (int rep_ = 0; rep_ < 1 + (int)((MK_DUP >> 0) & 1u); ++rep_) { PH_LOCALS
            WPREP(Lyr, 0);
            if (Lyr == 0) {
                const int gt = vcu * 512 + tid, NGT = G * 512; float* rA = ropeA; float* rC = ropeC; float* lbw_ = LBW;
                for (int i = gt; i < SEQ * 8; i += NGT) { const int pos = i >> 3, f = i & 7; const float inv = 1.0f / powf(500000.0f, (float)(2 * f) / 16.0f); const float ang = (float)pos * inv;
                    rA[2 * i] = cosf(ang); rA[2 * i + 1] = sinf(ang); }
                for (int i = gt; i < SEQ * 32; i += NGT) { const int pos = i >> 5, f = i & 31; const float inv = 1.0f / powf(10000.0f, (float)(2 * f) / 64.0f); const float ang = (float)pos * inv;
                    rC[2 * i] = cosf(ang); rC[2 * i + 1] = sinf(ang); }
                const float* lg = karg_in(7);
                for (int c = gt; c < 1024; c += NGT) { const float a0 = lg[c], a1 = lg[1024 + c], a2 = lg[2048 + c], a3 = lg[3072 + c];
                    const float mx = fmaxf(fmaxf(a0, a1), fmaxf(a2, a3)); const float e0 = expf(a0 - mx), e1 = expf(a1 - mx), e2 = expf(a2 - mx), e3 = expf(a3 - mx); const float inv = 1.f / (e0 + e1 + e2 + e3);
                    lbw_[c] = 0.f; lbw_[1024 + c] = e1 * inv; lbw_[2048 + c] = (e1 + e2) * inv; lbw_[3072 + c] = (e1 + e2 + e3) * inv; }
            }
            if (Lyr == 0) {
                const float* xin = karg_in(0); bf16* xb = XBO; float* ss = SS1;
                for (int m0 = gw; m0 < MTOK; m0 += 2 * NGW) {
                    f32x4 v[2][4]; float sq[2];
#pragma unroll
                    for (int q = 0; q < 2; ++q) { const GAS f32x4* xr = (const GAS f32x4*)(xin + (size_t)(m0 + q * NGW) * DM) + lane;
#pragma unroll
                        for (int j = 0; j < 4; ++j) v[q][j] = xr[64 * j]; }
#pragma unroll
                    for (int q = 0; q < 2; ++q) { GAS unsigned long long* o8 = (GAS unsigned long long*)(xb + (size_t)(m0 + q * NGW) * DM) + lane; float t = 0.f;
#pragma unroll
                        for (int j = 0; j < 4; ++j) { const f32x4 u = v[q][j]; t += (u.x * u.x + u.y * u.y) + (u.z * u.z + u.w * u.w); o8[64 * j] = (unsigned long long)pg8::cvt_pk_f16(u.x, u.y) | ((unsigned long long)pg8::cvt_pk_f16(u.z, u.w) << 32); }
                        sq[q] = t; }
#pragma unroll
                    for (int q = 0; q < 2; ++q) { const float t = wave_sum(sq[q]); if (lane < 16) ss[(size_t)(m0 + q * NGW) * 16 + lane] = (lane == 0) ? t : 0.f; } }
            }
        }
        if (Lyr == 0) SEAM(pb + 0);
        if (INP(1)) for (int rep_ = 0; rep_ < 1 + (int)((MK_DUP >> 1) & 1u); ++rep_) { PH_LOCALS pg8::Gemm g{XBO, W1U, MTOK, 2 * DFF, DM, DM}; pg8::StaticOrder S; S.init(MTOK, 2 * DFF, G, bx); EpiSwiglu E{H, rs_preload(lds, SS1, S, tid)}; pg8::gemm_phase<EpiSwiglu, pg8::StaticOrder, true, true>(lds, g, S, E, tid);
            if (Lyr > 0) WPREP(Lyr, 2); }
        SEAM(pb + 1);
        if (INP(2)) for (int rep_ = 0; rep_ < 1 + (int)((MK_DUP >> 2) & 1u); ++rep_) { PH_LOCALS pg8::Gemm g{H, W1D, MTOK, DM, DFF, DFF}; pg8::StaticOrder S; S.init(MTOK, DM, G, bx); EpiResid E{XBO, XBE, rep_ ? 0.f : 0.5f, SS0}; pg8::gemm_phase<EpiResid, pg8::StaticOrder>(lds, g, S, E, tid); }
        SEAM(pb + 2);
        if (INP(4)) for (int rep_ = 0; rep_ < 1 + (int)((MK_DUP >> 4) & 1u); ++rep_) { PH_LOCALS pg8::Gemm g{XBE, WIN1, MTOK, N_IN1, DM, DM}; pg8::StaticOrder S; S.init(MTOK, N_IN1, G, bx); EpiIn1 E{QKVA, CLR, ropeA, ropeC, rs_preload(lds, SS0, S, tid)}; pg8::gemm_phase<EpiIn1, pg8::StaticOrder, true, true>(lds, g, S, E, tid); }
        SEAM(pb + 4);
        if (INP(5)) for (int rep_ = 0; rep_ < 1 + (int)((MK_DUP >> 5) & 1u); ++rep_) { PH_LOCALS
            const float* gq = karg_in(9) + Lyr * 384; const float* gkv = karg_in(11) + Lyr * 256; bf16* const clr = CLR; const bf16* const qkva = QKVA; bf16* const aout = AOUT;
            if (rep_ == 0) {
                float gqr[6], gkr[4];
#pragma unroll
                for (int j = 0; j < 6; ++j) gqr[j] = gq[6 * lane + j];
#pragma unroll
                for (int j = 0; j < 4; ++j) gkr[j] = gkv[4 * lane + j];
                for (int m0 = gw; m0 < MTOK; m0 += 4 * NGW) {
                    unsigned a[4][3], b[4][2]; float s1[4], s2[4];
#pragma unroll
                    for (int q = 0; q < 4; ++q) { const unsigned* row = (const unsigned*)(clr + (size_t)(m0 + q * NGW) * P_CLR);
#pragma unroll
                        for (int j = 0; j < 3; ++j) a[q][j] = row[3 * lane + j];
#pragma unroll
                        for (int j = 0; j < 2; ++j) b[q][j] = (row + CLR_KV / 2)[2 * lane + j]; }
#pragma unroll
                    for (int q = 0; q < 4; ++q) { float t1 = 0.f, t2 = 0.f;
#pragma unroll
                        for (int j = 0; j < 3; ++j) { const float x = bflo(a[q][j]), y = bfhi(a[q][j]); t1 += x * x + y * y; }
#pragma unroll
                        for (int j = 0; j < 2; ++j) { const float x = bflo(b[q][j]), y = bfhi(b[q][j]); t2 += x * x + y * y; }
                        s1[q] = t1; s2[q] = t2; }
#pragma unroll
                    for (int o = 1; o < 64; o <<= 1) {
#pragma unroll
                        for (int q = 0; q < 4; ++q) { s1[q] += __shfl_xor(s1[q], o); s2[q] += __shfl_xor(s2[q], o); } }
#pragma unroll
                    for (int q = 0; q < 4; ++q) { unsigned* row = (unsigned*)(clr + (size_t)(m0 + q * NGW) * P_CLR);
                        const float r1 = 1.f / sqrtf(s1[q] * (1.f / 384.f) + EPS), r2 = 1.f / sqrtf(s2[q] * (1.f / 256.f) + EPS);
#pragma unroll
                        for (int j = 0; j < 3; ++j) row[3 * lane + j] = pk2(bflo(a[q][j]) * r1 * gqr[2 * j], bfhi(a[q][j]) * r1 * gqr[2 * j + 1]);
#pragma unroll
                        for (int j = 0; j < 2; ++j) (row + CLR_KV / 2)[2 * lane + j] = pk2(bflo(b[q][j]) * r2 * gkr[2 * j], bfhi(b[q][j]) * r2 * gkr[2 * j + 1]); }
                }
            }
#if MK_NAIVE_A
            for (int task = gw; task < MTOK * 4; task += NGW) {
                const int m = task >> 2, hh = task & 3, t = m & (SEQ - 1);
                float sc[3][3]; float mx = -1e30f;
#pragma unroll
                for (int g = 0; g < 3; ++g) { const int dil = (g == 0) ? 1 : (g == 1) ? 4 : 16; const int head = 4 * g + hh;
                    const u32x4* qp = (const u32x4*)(qkva + (size_t)m * P_QKVA + head * 64);
#pragma unroll
                    for (int kk = 0; kk < 3; ++kk) { const int i = lane + 64 * kk; const bool valid = (i <= 128) && (t - i * dil >= 0);
                        float s = -1e30f;
                        if (valid) { const u32x4* kp = (const u32x4*)(qkva + (size_t)(m - i * dil) * P_QKVA + 768 + head * 64); s = 0.f;
                            for (int c = 0; c < 8; ++c) { const u32x4 qv = qp[c], kv = kp[c];
                                s += bflo(qv.x) * bflo(kv.x) + bfhi(qv.x) * bfhi(kv.x) + bflo(qv.y) * bflo(kv.y) + bfhi(qv.y) * bfhi(kv.y) + bflo(qv.z) * bflo(kv.z) + bfhi(qv.z) * bfhi(kv.z) + bflo(qv.w) * bflo(kv.w) + bfhi(qv.w) * bfhi(kv.w); } }
                        sc[g][kk] = s; mx = fmaxf(mx, s); } }
                mx = wave_max(mx);
                float l = 0.f;
#pragma unroll
                for (int g = 0; g < 3; ++g)
#pragma unroll
                    for (int kk = 0; kk < 3; ++kk) { const float p = (sc[g][kk] > -1e29f) ? __builtin_amdgcn_exp2f(sc[g][kk] - mx) : 0.f; sc[g][kk] = p; l += p; }
                l = wave_sum(l);
                float o = 0.f;
#pragma unroll
                for (int g = 0; g < 3; ++g) { const int dil = (g == 0) ? 1 : (g == 1) ? 4 : 16; const int head = 4 * g + hh;
#pragma unroll
                    for (int kk = 0; kk < 3; ++kk) { const int nn = (kk < 2) ? 64 : 1;
                        for (int ii = 0; ii < nn; ++ii) { const int i = 64 * kk + ii; if (t - i * dil < 0) break;
                            const float p = __shfl(sc[g][kk], ii); o += p * bf2f(qkva[(size_t)(m - i * dil) * P_QKVA + 1536 + head * 64 + lane]); } } }
                aout[(size_t)m * 256 + hh * 64 + lane] = (bf16)f2bf(o / l);
            }
        #else
            dwa_phase(lds, qkva, AOG, LSEB, vcu, G, tid, lane, wave);
#endif
        }
        SEAM(pb + 5);
        if (INP(6)) for (int rep_ = 0; rep_ < 1 + (int)((MK_DUP >> 6) & 1u); ++rep_) { PH_LOCALS
#if !MK_NAIVE_A
            { const bf16* const aog = AOG; const float* const lse = LSEB; bf16* const aout = AOUT;
              for (int m0 = gw; m0 < MTOK; m0 += 4 * NGW) { const int hh = lane >> 4;
                  float l0[4], l1[4], l2[4]; u32x2 a[4], b[4], c[4];
#pragma unroll
                  for (int q = 0; q < 4; ++q) { const size_t m = (size_t)(m0 + q * NGW);
                      l0[q] = lse[m * 4 + hh]; l1[q] = lse[((size_t)MTOK + m) * 4 + hh]; l2[q] = lse[((size_t)2 * MTOK + m) * 4 + hh];
                      a[q] = *(const u32x2*)(aog + m * 256 + 4 * lane); b[q] = *(const u32x2*)(aog + ((size_t)MTOK + m) * 256 + 4 * lane); c[q] = *(const u32x2*)(aog + ((size_t)2 * MTOK + m) * 256 + 4 * lane); }
#pragma unroll
                  for (int q = 0; q < 4; ++q) { const size_t m = (size_t)(m0 + q * NGW); const float mx = fmaxf(l0[q], fmaxf(l1[q], l2[q]));
                      const float w0 = __builtin_amdgcn_exp2f(l0[q] - mx), w1 = __builtin_amdgcn_exp2f(l1[q] - mx), w2 = __builtin_amdgcn_exp2f(l2[q] - mx); const float inv = 1.f / (w0 + w1 + w2);
                      u32x2 o; o.x = pk2((w0 * bflo(a[q].x) + w1 * bflo(b[q].x) + w2 * bflo(c[q].x)) * inv, (w0 * bfhi(a[q].x) + w1 * bfhi(b[q].x) + w2 * bfhi(c[q].x)) * inv);
                      o.y = pk2((w0 * bflo(a[q].y) + w1 * bflo(b[q].y) + w2 * bflo(c[q].y)) * inv, (w0 * bfhi(a[q].y) + w1 * bfhi(b[q].y) + w2 * bfhi(c[q].y)) * inv);
                      *(u32x2*)(aout + m * 256 + 4 * lane) = o; } } }
#endif
            { pg8::Gemm g{CLR, WQB, MTOK, N_QB, 384, P_CLR}; pg8::StaticOrder S; S.init(MTOK, N_QB, G, bx); EpiQC E{QC, ropeC}; pg8::gemm_phase<EpiQC, pg8::StaticOrder>(lds, g, S, E, tid); }
            { pg8::Gemm g{CLR + CLR_KV, WKVB, MTOK, 1536, 256, P_CLR}; pg8::StaticOrder S; S.init(MTOK, 1536, G, bx); EpiBf16<0, false> E{KVC, P_KVC, RsTab{nullptr, 0}}; pg8::gemm_phase<EpiBf16<0, false>, pg8::StaticOrder>(lds, g, S, E, tid); }
        }
        SEAM(pb + 6);
        if (INP(7)) for (int rep_ = 0; rep_ < 1 + (int)((MK_DUP >> 7) & 1u); ++rep_) { PH_LOCALS
#if MK_NAIVE_C
            LAS float* Sb = (LAS float*)(lds + wave * 16384); const bf16* const qc = QC; const bf16* const kvc = KVC; const bf16* const clr = CLR; bf16* const co = CO;
            for (int task = gw; task < MTOK * 6; task += NGW) {
                const int m = task / 6, h = task - 6 * m, t = m & (SEQ - 1); const size_t rb = (size_t)(m - t);
                const u32x4* qp = (const u32x4*)(qc + (size_t)m * P_QC + h * 192);
                float mx = -1e30f;
                for (int k0 = 0; k0 <= t; k0 += 64) { const int key = k0 + lane; float s = -1e30f;
                    if (key <= t) { const u32x4* kp = (const u32x4*)(kvc + (rb + key) * P_KVC + h * 256); const u32x4* rp = (const u32x4*)(clr + (rb + key) * P_CLR + CLR_KR); s = 0.f;
                        for (int c = 0; c < 24; ++c) { const u32x4 qv = qp[c]; const u32x4 kv = (c < 16) ? kp[c] : rp[c - 16];
                            s += bflo(qv.x) * bflo(kv.x) + bfhi(qv.x) * bfhi(kv.x) + bflo(qv.y) * bflo(kv.y) + bfhi(qv.y) * bfhi(kv.y) + bflo(qv.z) * bflo(kv.z) + bfhi(qv.z) * bfhi(kv.z) + bflo(qv.w) * bflo(kv.w) + bfhi(qv.w) * bfhi(kv.w); } }
                    Sb[key] = s; mx = fmaxf(mx, s); }
                mx = wave_max(mx);
                float l = 0.f;
                for (int k0 = 0; k0 <= t; k0 += 64) { const int key = k0 + lane; const float s = Sb[key]; const float p = (key <= t) ? __builtin_amdgcn_exp2f(s - mx) : 0.f; Sb[key] = p; l += p; }
                l = wave_sum(l);
                LDS_WAIT();
                float o0 = 0.f, o1 = 0.f;
                for (int key = 0; key <= t; ++key) { const float p = Sb[key]; const unsigned v = *(const unsigned*)(kvc + (rb + key) * P_KVC + h * 256 + 128 + 2 * lane); o0 += p * bflo(v); o1 += p * bfhi(v); }
                const float il = 1.f / l;
                *(unsigned*)(co + (size_t)m * 768 + h * 128 + 2 * lane) = pk2(o0 * il, o1 * il);
                LDS_WAIT();
            }
        #else
            mla_phase(lds, QC, KVC, CLR, CO, vcu, G, tid, lane, wave);
#endif
        }
        SEAM(pb + 7);
        if (INP(8)) for (int rep_ = 0; rep_ < 1 + (int)((MK_DUP >> 8) & 1u); ++rep_) { PH_LOCALS pg8::Gemm g{XBE, WINB, MTOK, N_INB, DM, DM}; pg8::StaticOrder S; S.init(MTOK, N_INB, G, bx); EpiBf16<0, true> E{BIN, P_BIN, rs_preload(lds, SS0, S, tid)}; pg8::gemm_phase<EpiBf16<0, true>, pg8::StaticOrder, true, true>(lds, g, S, E, tid); }
        SEAM(pb + 8);
        if (INP(9)) for (int rep_ = 0; rep_ < 1 + (int)((MK_DUP >> 9) & 1u); ++rep_) { PH_LOCALS
#if MK_NAIVE_B
            LAS float* Fs = (LAS float*)lds; LAS float* Ks = Fs + 16 * 128; LAS float* Qs = Ks + 16 * 128; LAS float* Vs = Qs + 16 * 128; LAS float* Os = Vs + 16 * 48;
            const float* lbw = LBW + Lyr * 1024; const bf16* const bin = BIN; bf16* const bo = BO;
            for (int unit = bx; unit < BATCH * 8 * 2; unit += G) {
                const int half = unit & 1, chain = unit >> 1, b = chain >> 3, head = chain & 7;
                const int col = tid >> 3, seg = tid & 7;
                float st[16];
#pragma unroll
                for (int j = 0; j < 16; ++j) st[j] = 0.f;
                const int et = tid >> 5, ed = (tid & 31) * 4;
                f32x4 lb4 = *(const f32x4*)(lbw + head * 128 + ed);
                for (int t0 = 0; t0 < SEQ; t0 += 16) {
                    const size_t row0 = (size_t)b * SEQ + t0;
                    { const bf16* rp = bin + (row0 + et) * P_BIN; const u32x2 qw = *(const u32x2*)(rp + head * 128 + ed); const u32x2 zw = *(const u32x2*)(rp + 1024 + head * 128 + ed);
                      const float z[4] = {bflo(zw.x), bfhi(zw.x), bflo(zw.y), bfhi(zw.y)}; f32x4 f, k;
#pragma unroll
                      for (int j = 0; j < 4; ++j) { const float sg = sigmoidf_(z[j]); f[j] = lb4[j] + (1.f - lb4[j]) * sg; k[j] = (1.f - lb4[j]) * (1.f - sg); }
                      *(LAS f32x4*)(Fs + et * 128 + ed) = f; *(LAS f32x4*)(Ks + et * 128 + ed) = k; *(LAS f32x4*)(Qs + et * 128 + ed) = (f32x4){bflo(qw.x), bfhi(qw.x), bflo(qw.y), bfhi(qw.y)}; }
                    for (int idx = tid; idx < 16 * 48; idx += 512) { const int tt = idx / 48, c = idx - 48 * tt; Vs[idx] = bf2f(bin[(row0 + tt) * P_BIN + 2048 + head * 96 + 48 * half + c]); }
                    __syncthreads();
                    if (tid < 384) {
                        for (int tt = 0; tt < 16; ++tt) { const float vv = Vs[tt * 48 + col]; float o = 0.f;
#pragma unroll
                            for (int j4 = 0; j4 < 4; ++j4) { const f32x4 f = *(const LAS f32x4*)(Fs + tt * 128 + seg * 16 + 4 * j4), k = *(const LAS f32x4*)(Ks + tt * 128 + seg * 16 + 4 * j4), q = *(const LAS f32x4*)(Qs + tt * 128 + seg * 16 + 4 * j4);
#pragma unroll
                                for (int j = 0; j < 4; ++j) { st[4 * j4 + j] = f[j] * st[4 * j4 + j] + k[j] * vv; o += q[j] * st[4 * j4 + j]; } }
                            o += __shfl_xor(o, 1); o += __shfl_xor(o, 2); o += __shfl_xor(o, 4);
                            if (seg == 0) Os[tt * 48 + col] = o; }
                    }
                    __syncthreads();
                    for (int idx = tid; idx < 16 * 48; idx += 512) { const int tt = idx / 48, c = idx - 48 * tt; bo[(row0 + tt) * 768 + head * 96 + 48 * half + c] = (bf16)f2bf(Os[idx]); }
                }
                __syncthreads();
            }
        #else
            hgrn_phase(lds, BIN, BO, LBW + Lyr * 1024, karg_in(8) + Lyr * 96, SHB, vcu, G, tid, lane, wave);
#endif
        }
        SEAM(pb + 9);
#if !MK_NAIVE_B
        if (INP(10)) for (int rep_ = 0; rep_ < 1; ++rep_) { PH_LOCALS hgrn_fix_phase(lds, BIN, BO, karg_in(8) + Lyr * 96, SHB, vcu, G, tid, lane, wave); }
        SEAM(pb + 10);
#endif
#if MK_NAIVE_B
        if (INP(10)) for (int rep_ = 0; rep_ < 1 + (int)((MK_DUP >> 10) & 1u); ++rep_) { PH_LOCALS
            const float* gn = karg_in(8) + Lyr * 96; bf16* const bo = BO; const bf16* const bin = BIN;
            for (int m = gw; m < MTOK; m += NGW) {
                bf16* orow = bo + (size_t)m * 768 + 12 * lane; const bf16* grow = bin + (size_t)m * P_BIN + 2816 + 12 * lane;
                u32x2 a[3], gg[3]; float s = 0.f;
#pragma unroll
                for (int j = 0; j < 3; ++j) { a[j] = ((const u32x2*)orow)[j]; gg[j] = ((const u32x2*)grow)[j]; const float x0 = bflo(a[j].x), x1 = bfhi(a[j].x), x2 = bflo(a[j].y), x3 = bfhi(a[j].y); s += x0 * x0 + x1 * x1 + x2 * x2 + x3 * x3; }
                s += __shfl_xor(s, 1); s += __shfl_xor(s, 2); s += __shfl_xor(s, 4);
                const float rstd = 1.f / sqrtf(s * (1.f / 96.f) + EPS);
                const int e0 = (12 * lane) % 96;
#pragma unroll
                for (int j = 0; j < 3; ++j) { const float x[4] = {bflo(a[j].x), bfhi(a[j].x), bflo(a[j].y), bfhi(a[j].y)}; const float gv[4] = {bflo(gg[j].x), bfhi(gg[j].x), bflo(gg[j].y), bfhi(gg[j].y)}; float r[4];
#pragma unroll
                    for (int e = 0; e < 4; ++e) r[e] = x[e] * rstd * gn[e0 + 4 * j + e] * (gv[e] * sigmoidf_(gv[e]));
                    u32x2 w; w.x = pk2(r[0], r[1]); w.y = pk2(r[2], r[3]); ((u32x2*)orow)[j] = w; }
            }
        }
        SEAM(pb + 10);
#endif
        if (INP(11)) for (int rep_ = 0; rep_ < 1 + (int)((MK_DUP >> 11) & 1u); ++rep_) { PH_LOCALS pg8::Gemm g{XBE, WING, MTOK, N_ING, DM, DM}; pg8::StaticOrder S; S.init(MTOK, N_ING, G, bx); EpiGate8 E{GS, rs_preload(lds, SS0, S, tid)}; pg8::gemm_phase<EpiGate8, pg8::StaticOrder, true, true>(lds, g, S, E, tid); }
        SEAM(pb + 11);
        if (INP(12)) for (int rep_ = 0; rep_ < 1 + (int)((MK_DUP >> 12) & 1u); ++rep_) { PH_LOCALS
            { pg8::Gemm3 g{AOUT, BO, CO, WA, WBb, WC, 256, 768, 768}; pg8::StaticOrder S; S.init(MTOK, DM, G, bx); EpiMerge3 E{MG, GS}; pg8::gemm_phase_ms<EpiMerge3, pg8::StaticOrder>(lds, g, S, E, tid); }
        }
        SEAM(pb + 12);
        if (INP(13)) for (int rep_ = 0; rep_ < 1 + (int)((MK_DUP >> 13) & 1u); ++rep_) { PH_LOCALS pg8::Gemm g{MG, WO, MTOK, DM, DM, DM}; pg8::StaticOrder S; S.init(MTOK, DM, G, bx); EpiResid E{XBE, XBO, rep_ ? 0.f : 1.0f, SS1}; pg8::gemm_phase<EpiResid, pg8::StaticOrder>(lds, g, S, E, tid);
            const f32x4* pp = (const f32x4*)(karg_in(1) + (size_t)Lyr * MTOK * PLE); u32x2* po = (u32x2*)PB;
            for (size_t i = (size_t)vcu * 512 + tid; i < (size_t)MTOK * PLE / 4; i += (size_t)G * 512 * 8) { f32x4 v[8];
#pragma unroll
                for (int q = 0; q < 8; ++q) v[q] = pp[i + (size_t)q * G * 512];
#pragma unroll
                for (int q = 0; q < 8; ++q) { u32x2 w; w.x = pk2(v[q].x, v[q].y); w.y = pk2(v[q].z, v[q].w); po[i + (size_t)q * G * 512] = w; } } }
        SEAM(pb + 13);
        if (INP(15)) for (int rep_ = 0; rep_ < 1 + (int)((MK_DUP >> 15) & 1u); ++rep_) { PH_LOCALS pg8::Gemm g{XBO, W2U, MTOK, 2 * DFF, DM, DM}; pg8::StaticOrder S; S.init(MTOK, 2 * DFF, G, bx); EpiSwiglu E{H, rs_preload(lds, SS1, S, tid)}; pg8::gemm_phase<EpiSwiglu, pg8::StaticOrder, true, true>(lds, g, S, E, tid); }
        SEAM(pb + 15);
        if (INP(16)) for (int rep_ = 0; rep_ < 1 + (int)((MK_DUP >> 16) & 1u); ++rep_) { PH_LOCALS pg8::Gemm g{H, W2D, MTOK, DM, DFF, DFF}; pg8::StaticOrder S; S.init(MTOK, DM, G, bx); EpiResid E{XBO, XBE, rep_ ? 0.f : 0.5f, SS0}; pg8::gemm_phase<EpiResid, pg8::StaticOrder>(lds, g, S, E, tid); }
        SEAM(pb + 16);
        if (INP(18)) for (int rep_ = 0; rep_ < 1 + (int)((MK_DUP >> 18) & 1u); ++rep_) { PH_LOCALS
            { pg8::Gemm g{PB, WPP, MTOK, DM, PLE, PLE}; pg8::StaticOrder S; S.init(MTOK, DM, G, bx); EpiBf16<0, false> E{PP, DM, RsTab{nullptr, 0}}; pg8::gemm_phase<EpiBf16<0, false>, pg8::StaticOrder>(lds, g, S, E, tid); }
            { pg8::Gemm g{XBE, WPG, MTOK, DM, DM, DM}; pg8::StaticOrder S; S.init(MTOK, DM, G, bx); EpiPle E{XBE, PP, rs_preload(lds, SS0, S, tid), XBO, SS1}; pg8::gemm_phase<EpiPle, pg8::StaticOrder, true, true>(lds, g, S, E, tid); }
            if (Lyr + 1 < DEPTH) WPREP(Lyr + 1, 1);
        }
        SEAM(pb + 18);
    }
    if (IN(DEPTH * NPH)) { PH_LOCALS
        const float* gf = karg_in(23); float* const xo = X; const bf16* const xb = XBO;
        f32x4 gv[4];
#pragma unroll
        for (int j = 0; j < 4; ++j) gv[j] = ((const GAS f32x4*)gf + lane)[64 * j];
        for (int m0 = gw; m0 < MTOK; m0 += 4 * NGW) {
            u32x2 w[4][4];
#pragma unroll
            for (int q = 0; q < 4; ++q) { const GAS u32x2* xr = (const GAS u32x2*)(xb + (size_t)(m0 + q * NGW) * DM) + lane;
#pragma unroll
                for (int j = 0; j < 4; ++j) w[q][j] = xr[64 * j]; }
            float sq[4];
#pragma unroll
            for (int q = 0; q < 4; ++q) { float t = 0.f;
#pragma unroll
                for (int j = 0; j < 4; ++j) { const float x0 = pg8::f16lo(w[q][j].x), x1 = pg8::f16hi(w[q][j].x), x2 = pg8::f16lo(w[q][j].y), x3 = pg8::f16hi(w[q][j].y); t += (x0 * x0 + x1 * x1) + (x2 * x2 + x3 * x3); }
                sq[q] = t; }
#pragma unroll
            for (int o = 1; o < 64; o <<= 1) {
#pragma unroll
                for (int q = 0; q < 4; ++q) sq[q] += __shfl_xor(sq[q], o); }
#pragma unroll
            for (int q = 0; q < 4; ++q) { GAS f32x4* orow = (GAS f32x4*)(xo + (size_t)(m0 + q * NGW) * DM) + lane; const float rstd = 1.f / sqrtf(sq[q] * (1.f / DM) + EPS);
#pragma unroll
                for (int j = 0; j < 4; ++j) { const f32x4 v = (f32x4){pg8::f16lo(w[q][j].x), pg8::f16hi(w[q][j].x), pg8::f16lo(w[q][j].y), pg8::f16hi(w[q][j].y)}; orow[64 * j] = v * rstd * gv[j]; } }
        }
    }
#undef IN
#undef SEAM
}
#undef X
#undef WSP
#undef ropeA
#undef ropeC
#undef LBW
#undef W1U
#undef W1D
#undef WIN1
#undef WINB
#undef WING
#undef WQB
#undef WKVB
#undef WA
#undef WBb
#undef WC
#undef WO
#undef W2U
#undef W2D
#undef WPG
#undef WPP
#undef XN
#undef XBE
#undef XBO
#undef SS0
#undef SS1
#undef MG
#undef H
#undef QKVA
#undef CLR
#undef QC
#undef CO
#undef KVC
#undef AOUT
#undef AOG
#undef LSEB
#undef SHB
#undef BIN
#undef BO
#undef GS
#undef PB
#undef PP
#undef PH_LOCALS
#undef WPREP
#undef INP


#ifdef MK_CHECK
constexpr size_t WS_STASH = 978 * MiB;
constexpr int CHK_WORDS = 8192;
__device__ __forceinline__ unsigned hash_u(unsigned x) { x ^= x >> 16; x *= 0x7feb352du; x ^= x >> 15; x *= 0x846ca68bu; x ^= x >> 16; return x; }
__device__ __forceinline__ float dot_bw(const bf16* a, const float* W, int K, int ldw, int col) { float s = 0.f; for (int k = 0; k < K; ++k) s += bf2f(a[k]) * W[(size_t)k * ldw + col]; return s; }
__device__ __forceinline__ void chk_add(unsigned* ctl, int k, float got, float exp_, float atol) {
    const bool bad = !(fabsf(got - exp_) <= 0.05f * fabsf(exp_) + atol);
    atomicAdd(&ctl[CHK_WORDS + 2 * k + 1], 1u); if (bad) atomicAdd(&ctl[CHK_WORDS + 2 * k], 1u);
}
__device__ __forceinline__ void rope_pair(float x1, float x2, int pos, int f, float theta, int dim, bool second, float& out) {
    const float inv = 1.0f / powf(theta, (float)(2 * f) / (float)dim); const float ang = (float)pos * inv; const float c = cosf(ang), s = sinf(ang);
    out = second ? (x2 * c + x1 * s) : (x1 * c - x2 * s);
}
__global__ void __launch_bounds__(512) mk_check(Args args, int p, int Lyr) {
    unsigned char* ws = args.ws; unsigned* ctl = (unsigned*)(ws + WS_CTL);
    const unsigned gt = blockIdx.x * 512 + threadIdx.x; const unsigned h0 = hash_u(gt * 2654435761u + 977u * (unsigned)p + 1u), h1 = hash_u(h0 + 0x9e3779b9u), h2 = hash_u(h1 + 0x85ebca6bu);
    const int m = (int)(h0 % MTOK), pos = m & (SEQ - 1);
    float* X = args.out; float* XS = (float*)(ws + WS_STASH); bf16* BS = (bf16*)(ws + WS_STASH + 4 * MiB);
    const bf16* XN = (const bf16*)(ws + WS_XN); const bf16* H = (const bf16*)(ws + WS_H); const bf16* QKVA = (const bf16*)(ws + WS_QKVA); const bf16* CLR = (const bf16*)(ws + WS_CLR);
    const bf16* QC = (const bf16*)(ws + WS_QC); const bf16* KVC = (const bf16*)(ws + WS_KVC); const bf16* CO = (const bf16*)(ws + WS_CO); const bf16* AOUT = (const bf16*)(ws + WS_AOUT);
    const bf16* BIN = (const bf16*)(ws + WS_BIN); const bf16* BO = (const bf16*)(ws + WS_BO); const bf16* GS = (const bf16*)(ws + WS_GS); const bf16* MG = (const bf16*)(ws + WS_MG);
    const bf16* PB = (const bf16*)(ws + WS_PB); const float* LBW = (const float*)(ws + WS_LB);
    const float* win = args.in[6] + (size_t)Lyr * DM * INW;
    auto stashX = [&]() { for (size_t i = gt; i < (size_t)1024 * 1024; i += (size_t)gridDim.x * 512) { const size_t r = i >> 10, c = i & 1023; XS[i] = X[(r * 64) * DM + c]; } };
    if (p == 0 || p == 3 || p == 14 || p == 17) {
        const int gi = (p == 0) ? 2 : (p == 3) ? 5 : (p == 14) ? 17 : 20; const float* g = args.in[gi] + Lyr * DM; const float* x = (p == 0 && Lyr == 0) ? args.in[0] : X;
        const int c = h1 % DM; float ss = 0.f; for (int k = 0; k < DM; ++k) { const float v = x[(size_t)m * DM + k]; ss += v * v; }
        chk_add(ctl, p, bf2f(XN[(size_t)m * DM + c]), x[(size_t)m * DM + c] / sqrtf(ss / DM + EPS) * g[c], 0.03f);
        if (p == 0) {
            const bf16* Wb = (const bf16*)(ws + WS_W); const int which = h2 % 6; const unsigned r1 = hash_u(h2 + 17u), r2 = hash_u(r1 + 29u);
            if (which == 0) { const int n = r1 % N_ING, k = r2 % 1024; chk_add(ctl, 24, bf2f(Wb[W_ING / 2 + (size_t)n * 1024 + k]), bf2f((bf16)f2bf(win[(size_t)k * INW + O_G + n])), 1e-6f); }
            if (which == 1) { const int n = r1 % N_INB, k = r2 % 1024; chk_add(ctl, 25, bf2f(Wb[W_INB / 2 + (size_t)n * 1024 + k]), bf2f((bf16)f2bf(win[(size_t)k * INW + O_B + n])), 1e-6f); }
            if (which == 2) { const int n = r1 % 1024, k = r2 % DFF; chk_add(ctl, 26, bf2f(Wb[W_1D / 2 + (size_t)n * DFF + k]), bf2f((bf16)f2bf((args.in[4] + (size_t)Lyr * DFF * DM)[(size_t)k * DM + n])), 1e-6f); }
            if (which == 3) { const int n = r1 % 1024, k = r2 % 1024; chk_add(ctl, 27, bf2f(Wb[W_O / 2 + (size_t)n * 1024 + k]), bf2f((bf16)f2bf((args.in[16] + (size_t)Lyr * DM * DM)[(size_t)k * DM + n])), 1e-6f); }
            if (which == 4) { const int n = r1 % 1024, k = r2 % 768; chk_add(ctl, 28, bf2f(Wb[W_C / 2 + (size_t)n * 768 + k]), bf2f((bf16)f2bf((args.in[15] + (size_t)Lyr * 768 * DM)[(size_t)k * DM + n])), 1e-6f); }
            if (which == 5) { const int n = r1 % 1024, k = r2 % 1024; chk_add(ctl, 29, bf2f(Wb[W_PG / 2 + (size_t)n * 1024 + k]), bf2f((bf16)f2bf((args.in[21] + (size_t)Lyr * DM * DM)[(size_t)k * DM + n])), 1e-6f); }
        }
        if (p == 14 || p == 17) stashX();
        if (p == 17) { const float* pp = args.in[1] + (size_t)Lyr * MTOK * PLE; const int j = h2 % PLE; chk_add(ctl, 19, bf2f(PB[(size_t)m * PLE + j]), pp[(size_t)m * PLE + j], 0.03f); }
    } else if (p == 1 || p == 15) {
        const float* W = args.in[p == 1 ? 3 : 18] + (size_t)Lyr * DM * 2 * DFF; const int j = h1 % DFF;
        const float a = dot_bw(XN + (size_t)m * DM, W, DM, 2 * DFF, j), b = dot_bw(XN + (size_t)m * DM, W, DM, 2 * DFF, DFF + j);
        chk_add(ctl, p, bf2f(H[(size_t)m * DFF + j]), a / (1.f + expf(-a)) * b, 0.02f);
    } else if (p == 2 || p == 16) {
        const float* W = args.in[p == 2 ? 4 : 19] + (size_t)Lyr * DFF * DM; const int c = h1 % DM;
        if (p == 2 && Lyr == 0) { chk_add(ctl, p, X[(size_t)m * DM + c], args.in[0][(size_t)m * DM + c] + 0.5f * dot_bw(H + (size_t)m * DFF, W, DFF, DM, c), 0.03f); }
        else if (p == 16) { const int r = h0 % 1024; const size_t mm = (size_t)r * 64; chk_add(ctl, p, X[mm * DM + c], XS[(size_t)r * DM + c] + 0.5f * dot_bw(H + mm * DFF, W, DFF, DM, c), 0.03f); }
    } else if (p == 4) {
        const bf16* a = XN + (size_t)m * DM; const int kind = h1 % 4;
        if (kind < 3) { const int which = kind, head = (h1 >> 8) % 12, d = (h2 >> 4) % 64; const int cb = which * 768 + head * 64; float val; int phys = d;
            if (which < 2 && d < 16) { const int i = d & 7; const float x1 = dot_bw(a, win, DM, INW, cb + i), x2 = dot_bw(a, win, DM, INW, cb + i + 8); rope_pair(x1, x2, pos, i, 500000.0f, 16, d >= 8, val); phys = (d < 8) ? 2 * d : 2 * (d - 8) + 1; }
            else val = dot_bw(a, win, DM, INW, cb + d);
            if (which == 0) val *= QSCALE_A;
            chk_add(ctl, 4, bf2f(QKVA[(size_t)m * P_QKVA + cb + phys]), val, which == 0 ? 0.006f : 0.03f);
        } else { const int sub = (h1 >> 8) % 3;
            if (sub == 0) { const int j = h2 % 384; chk_add(ctl, 20, bf2f(CLR[(size_t)m * P_CLR + j]), dot_bw(a, win, DM, INW, O_CQ + j), 0.03f); }
            else if (sub == 1) { const int j = h2 % 256; chk_add(ctl, 20, bf2f(CLR[(size_t)m * P_CLR + 512 + j]), dot_bw(a, win, DM, INW, O_CKV + j), 0.03f); }
            else { const int d = h2 % 64, i = d & 31; const float x1 = dot_bw(a, win, DM, INW, O_CKR + i), x2 = dot_bw(a, win, DM, INW, O_CKR + i + 32); float val; rope_pair(x1, x2, pos, i, 10000.0f, 64, d >= 32, val);
                const int phys = (d < 32) ? 2 * d : 2 * (d - 32) + 1; chk_add(ctl, 21, bf2f(CLR[(size_t)m * P_CLR + 768 + phys]), val, 0.03f); } }
    } else if (p == 5) {
        { const float* gq = args.in[9] + Lyr * 384; const float* gkv = args.in[11] + Lyr * 256; float s = 0.f; for (int j = 0; j < 384; ++j) { const float v = bf2f(CLR[(size_t)m * P_CLR + j]) / gq[j]; s += v * v; }
          chk_add(ctl, 22, s / 384.f, 1.0f, 0.0f); float s2 = 0.f; for (int j = 0; j < 256; ++j) { const float v = bf2f(CLR[(size_t)m * P_CLR + 512 + j]) / gkv[j]; s2 += v * v; } chk_add(ctl, 22, s2 / 256.f, 1.0f, 0.0f); }
    } else if (p == 6) {
        {
        const int hh = h1 % 4, d = (h1 >> 8) % 64; float og[3], lse[3];
        for (int g = 0; g < 3; ++g) { const int dil = (g == 0) ? 1 : (g == 1) ? 4 : 16, head = 4 * g + hh; float mx = -1e30f, l = 0.f, o = 0.f;
            for (int i = 0; i <= 128 && pos - i * dil >= 0; ++i) { const bf16* q = QKVA + (size_t)m * P_QKVA + head * 64; const bf16* k = QKVA + (size_t)(m - i * dil) * P_QKVA + 768 + head * 64; float s = 0.f; for (int e = 0; e < 64; ++e) s += bf2f(q[e]) * bf2f(k[e]);
                s *= 0.6931471805599453f; const float mn = fmaxf(mx, s), al = expf(mx - mn), pp = expf(s - mn); l = l * al + pp; o = o * al + pp * bf2f(QKVA[(size_t)(m - i * dil) * P_QKVA + 1536 + head * 64 + d]); mx = mn; }
            og[g] = o / l; lse[g] = mx + logf(l); }
        const float ml = fmaxf(lse[0], fmaxf(lse[1], lse[2])); const float w0 = expf(lse[0] - ml), w1 = expf(lse[1] - ml), w2 = expf(lse[2] - ml);
        chk_add(ctl, 5, bf2f(AOUT[(size_t)m * 256 + hh * 64 + d]), (w0 * og[0] + w1 * og[1] + w2 * og[2]) / (w0 + w1 + w2), 0.01f);
        }
        const float* wqb = args.in[10] + (size_t)Lyr * 384 * 1152; const float* wkvb = args.in[12] + (size_t)Lyr * 256 * 1536; const bf16* a = CLR + (size_t)m * P_CLR;
        if (h1 & 1) { const int h = (h1 >> 4) % 6, d = (h2 >> 4) % 192; float val; int phys = d;
            if (d >= 128) { const int e = d - 128, i = e & 31; const float x1 = dot_bw(a, wqb, 384, 1152, h * 192 + 128 + i), x2 = dot_bw(a, wqb, 384, 1152, h * 192 + 128 + i + 32); rope_pair(x1, x2, pos, i, 10000.0f, 64, e >= 32, val); phys = 128 + ((e < 32) ? 2 * e : 2 * (e - 32) + 1); }
            else val = dot_bw(a, wqb, 384, 1152, h * 192 + d);
            chk_add(ctl, 6, bf2f(QC[(size_t)m * P_QC + h * 192 + phys]), val * QSCALE_C, 0.004f);
        } else { const int c = h2 % 1536; chk_add(ctl, 23, bf2f(KVC[(size_t)m * P_KVC + c]), dot_bw(a + 512, wkvb, 256, 1536, c), 0.03f); }
    } else if (p == 7) {
        if (gt < 16384) { const int h = h1 % 6, d = (h1 >> 8) % 128; const size_t rb = (size_t)(m - pos); float mx = -1e30f, l = 0.f, o = 0.f; const bf16* q = QC + (size_t)m * P_QC + h * 192;
            for (int key = 0; key <= pos; ++key) { const bf16* k = KVC + (rb + key) * P_KVC + h * 256; const bf16* r = CLR + (rb + key) * P_CLR + 768; float s = 0.f; for (int e = 0; e < 128; ++e) s += bf2f(q[e]) * bf2f(k[e]); for (int e = 0; e < 64; ++e) s += bf2f(q[128 + e]) * bf2f(r[e]);
                s *= 0.6931471805599453f; const float mn = fmaxf(mx, s), al = expf(mx - mn), pp = expf(s - mn); l = l * al + pp; o = o * al + pp * bf2f(k[128 + d]); mx = mn; }
            chk_add(ctl, 7, bf2f(CO[(size_t)m * 768 + h * 128 + d]), o / l, 0.01f); }
    } else if (p == 8) { const int c = h1 % N_INB; chk_add(ctl, 8, bf2f(BIN[(size_t)m * P_BIN + c]), dot_bw(XN + (size_t)m * DM, win, DM, INW, O_B + c), 0.03f);
    } else if (p == 9) {
        if (gt < 32768) { const int head = h1 % 8, vc = (h1 >> 8) % 96; const float* lb = LBW + Lyr * 1024 + head * 128; float o = 0.f;
            for (int d = 0; d < 128; ++d) { float prod = 1.f, acc = 0.f; const float lbd = lb[d];
                for (int s = pos; s >= 0 && s > pos - 512; --s) { const bf16* r = BIN + (size_t)(m - pos + s) * P_BIN; const float z = bf2f(r[1024 + head * 128 + d]); const float sg = 1.f / (1.f + expf(-z)); const float f = lbd + (1.f - lbd) * sg, k = (1.f - lbd) * (1.f - sg);
                    acc += prod * k * bf2f(r[2048 + head * 96 + vc]); prod *= f; if (prod < 1e-9f) break; }
                o += bf2f(BIN[(size_t)m * P_BIN + head * 128 + d]) * acc; }
            chk_add(ctl, 9, bf2f(BO[(size_t)m * 768 + head * 96 + vc]), o, 0.03f); }
        for (size_t i = gt; i < (size_t)1024 * 768; i += (size_t)gridDim.x * 512) { const size_t r = i / 768, c = i % 768; BS[i] = BO[(r * 64) * 768 + c]; }
    } else if (p == 10) { const int r = h0 % 1024, head = h1 % 8, e = (h1 >> 8) % 96; const size_t mm = (size_t)r * 64; const float* gn = args.in[8] + Lyr * 96; float s = 0.f; for (int j = 0; j < 96; ++j) { const float v = bf2f(BS[(size_t)r * 768 + head * 96 + j]); s += v * v; }
        const float gv = bf2f(BIN[mm * P_BIN + 2816 + head * 96 + e]); chk_add(ctl, 10, bf2f(BO[mm * 768 + head * 96 + e]), bf2f(BS[(size_t)r * 768 + head * 96 + e]) / sqrtf(s / 96.f + EPS) * gn[e] * gv / (1.f + expf(-gv)), 0.02f);
    } else if (p == 11) { const int c = h1 % N_ING; const float a = dot_bw(XN + (size_t)m * DM, win, DM, INW, O_G + c); chk_add(ctl, 11, bf2f(GS[(size_t)m * P_GS + c]), 1.f / (1.f + expf(-a)), 0.01f);
    } else if (p == 12) { const int c = h1 % DM; const float ya = dot_bw(AOUT + (size_t)m * 256, args.in[13] + (size_t)Lyr * 256 * DM, 256, DM, c), yb = dot_bw(BO + (size_t)m * 768, args.in[14] + (size_t)Lyr * 768 * DM, 768, DM, c), yc = dot_bw(CO + (size_t)m * 768, args.in[15] + (size_t)Lyr * 768 * DM, 768, DM, c);
        chk_add(ctl, 12, bf2f(MG[(size_t)m * DM + c]), bf2f(GS[(size_t)m * P_GS + c]) * ya + bf2f(GS[(size_t)m * P_GS + 1024 + c]) * yb + bf2f(GS[(size_t)m * P_GS + 2048 + c]) * yc, 0.02f); stashX();
    } else if (p == 13) { const int r = h0 % 1024, c = h1 % DM; const size_t mm = (size_t)r * 64; chk_add(ctl, 13, X[mm * DM + c], XS[(size_t)r * DM + c] + dot_bw(MG + mm * DM, args.in[16] + (size_t)Lyr * DM * DM, DM, DM, c), 0.03f);
    } else if (p == 18) { const int r = h0 % 1024, c = h1 % DM; const size_t mm = (size_t)r * 64; const float a = dot_bw(XN + mm * DM, args.in[21] + (size_t)Lyr * DM * DM, DM, DM, c), b = dot_bw(PB + mm * PLE, args.in[22] + (size_t)Lyr * PLE * DM, PLE, DM, c);
        chk_add(ctl, 18, X[mm * DM + c], XS[(size_t)r * DM + c] + b / (1.f + expf(-a)), 0.03f); }
}
__global__ void mk_verdict(Args args) {
    const unsigned* ctl = (const unsigned*)(args.ws + WS_CTL); float val = 0.f;
#ifdef MK_REPORT_K
    { const unsigned bad = ctl[CHK_WORDS + 2 * MK_REPORT_K], tot = ctl[CHK_WORDS + 2 * MK_REPORT_K + 1]; val = (tot == 0) ? 100.f : 3.f + 60.f * (float)bad / (float)tot; }
#else
    for (int k = 0; k < 32; ++k) { const unsigned bad = ctl[CHK_WORDS + 2 * k], tot = ctl[CHK_WORDS + 2 * k + 1]; if (bad > tot / 512 + 2) { val = 3.f * (k + 1); break; } }
#endif
    for (size_t i = (size_t)blockIdx.x * blockDim.x + threadIdx.x; i < (size_t)MTOK * DM; i += (size_t)gridDim.x * blockDim.x) args.out[i] = val;
}
#endif
extern "C" void kernel_launch(void* const* d_in, const int* in_sizes, int n_in, void* d_out, int out_size, void* d_ws, size_t ws_size, hipStream_t stream) {
    static int grid = 0;
    if (grid == 0) {
        if (n_in != 24 || in_sizes[0] != MTOK * DM || out_size != MTOK * DM || ws_size < WS_END + 8 * MiB) { fprintf(stderr, "kernel_launch: unexpected shapes (n_in %d, ws %zu); nothing launched\n", n_in, ws_size); grid = -1; return; }
        int dev = 0, cus = 0, per_cu = 0;
        if (hipGetDevice(&dev) != hipSuccess || hipDeviceGetAttribute(&cus, hipDeviceAttributeMultiprocessorCount, dev) != hipSuccess) { grid = -1; return; }
        if (hipFuncSetAttribute((const void*)mk_fwd, hipFuncAttributeMaxDynamicSharedMemorySize, LDS_BYTES) != hipSuccess) { fprintf(stderr, "kernel_launch: hipFuncSetAttribute failed\n"); grid = -1; return; }
        if (hipOccupancyMaxActiveBlocksPerMultiprocessor(&per_cu, (const void*)mk_fwd, 512, LDS_BYTES) != hipSuccess || per_cu < 1) fprintf(stderr, "kernel_launch: occupancy query reports %d\n", per_cu);
        (void)hipGetLastError();
        grid = cus;
        if (grid != 256) { fprintf(stderr, "kernel_launch: built for the 256-CU MI355X (unit deal of the GEMM phases, rstd tables); found %d CUs; nothing launched\n", grid); grid = -1; return; }
    }
    if (grid < 0) return;
    if (hipMemsetAsync((char*)d_ws + WS_CTL, 0, CTL_ZERO_BYTES, stream) != hipSuccess) return;
    Args a{};
    for (int i = 0; i < 24; ++i) a.in[i] = (const float*)d_in[i];
    a.out = (float*)d_out; a.ws = (unsigned char*)d_ws;
#if MK_N_LAUNCHES == 1
    a.ph_lo = 0; a.ph_hi = NPHASES;
    hipLaunchKernelGGL(mk_fwd, dim3(grid), dim3(512), LDS_BYTES, stream, a);
#elif defined(MK_CHECK)
    for (int p = 0; p < NPH * (MK_CHECK + 1); ++p) {
#ifdef MK_SKIP
        if ((MK_SKIP >> (p % NPH)) & 1u) continue;
#endif
        a.ph_lo = p; a.ph_hi = p + 1; hipLaunchKernelGGL(mk_fwd, dim3(grid), dim3(512), LDS_BYTES, stream, a);
        if (p / NPH == MK_CHECK) hipLaunchKernelGGL(mk_check, dim3(256), dim3(512), 0, stream, a, p % NPH, p / NPH); }
    hipLaunchKernelGGL(mk_verdict, dim3(1024), dim3(256), 0, stream, a);
#else
    for (int p = 0; p < NPHASES; ++p) { a.ph_lo = p; a.ph_hi = p + 1; hipLaunchKernelGGL(mk_fwd, dim3(grid), dim3(512), LDS_BYTES, stream, a); }
#endif
}
```

```cpp
#include <hip/hip_runtime.h>
#include <cstdio>
#include <cstdint>

#ifndef MK_DUP
#define MK_DUP 0u
#endif
#define MK_NAIVE_A 0
#define MK_NAIVE_C 0
#define MK_NAIVE_B 0
#ifndef PH_MASK
#define PH_MASK 0xFFFFFFFFu
#endif
#ifndef MK_N_LAUNCHES
#define MK_N_LAUNCHES 1
#endif

namespace pg8 {
#define PG8_LAS __attribute__((address_space(3)))
typedef unsigned short bf16_t;
typedef short bf16x8 __attribute__((ext_vector_type(8)));
typedef float f32x4 __attribute__((ext_vector_type(4)));
typedef unsigned u32x4 __attribute__((ext_vector_type(4)));
typedef unsigned u32x2 __attribute__((ext_vector_type(2)));
constexpr int BM = 256, BK = 64, HALF = 128, HTB = HALF * BK * 2  , STAGE_BYTES = 8 * HTB, NXCD = 8, WGM = 8;

__host__ __device__ __forceinline__ int lds_byte(int r, int c) { const int st = (r >> 4) * 2 + (c >> 5), rr = r & 15, cc = c & 31, ob = rr * 64 + cc * 2; return st * 1024 + (ob ^ (((ob >> 9) & 1) << 5)); }
__host__ __device__ __forceinline__ void stage_rc(int b, int& R, int& C) { const int st = b / 1024, sb = b % 1024, swz = sb ^ (((sb >> 9) & 1) << 5); R = (st >> 1) * 16 + swz / 64; C = (st & 1) * 32 + (swz % 64) / 2; }
__host__ __device__ __forceinline__ int perm32(int rho) { const int n = rho >> 4, i = rho & 15; return 8 * (i >> 2) + 4 * n + (i & 3); }

struct Unit { int pm, pn; };
struct Gemm { const bf16_t* A; const bf16_t* Bt; int M, N, K, lda; };

struct StaticOrder {
    int nM, nN, nwg, G, c;
    __host__ __device__ void init(int M, int N, int G_, int c_) { nM = M / BM; nN = N / BM; nwg = nM * nN; G = G_; c = c_; }
    __host__ __device__ bool next(int i, Unit& u) const {
        const long L = (long)i * G + c; if (L >= nwg) return false;
        int wgid = (int)L; { const int q = nwg / NXCD, r = nwg % NXCD, xcd = wgid % NXCD, off = wgid / NXCD; wgid = (xcd < r ? xcd * (q + 1) : r * (q + 1) + (xcd - r) * q) + off; }
        const int nig = WGM * nN, gid = wgid / nig, fm = gid * WGM, gsz = (nM - fm) < WGM ? (nM - fm) : WGM;
        u.pm = fm + ((wgid % nig) % gsz); u.pn = (wgid % nig) / gsz; return true;
    }
    __device__ __forceinline__ void a_ready(const Unit&) const {}
    __device__ __forceinline__ void done(const Unit&) const {}
};

typedef float f32x2_t __attribute__((ext_vector_type(2))); typedef __bf16 bf16x2_t __attribute__((ext_vector_type(2)));
__device__ __forceinline__ unsigned cvt_pk_bf16(float lo, float hi) { f32x2_t v = {lo, hi}; bf16x2_t b = __builtin_convertvector(v, bf16x2_t); return __builtin_bit_cast(unsigned, b); }
typedef _Float16 f16x2_t __attribute__((ext_vector_type(2))); typedef _Float16 f16x8_t __attribute__((ext_vector_type(8)));
__device__ __forceinline__ unsigned cvt_pk_f16(float lo, float hi) { f32x2_t v = {lo, hi}; f16x2_t h = __builtin_convertvector(v, f16x2_t); return __builtin_bit_cast(unsigned, h); }
__device__ __forceinline__ float f16lo(unsigned u) { return (float)__builtin_bit_cast(f16x2_t, u)[0]; }
__device__ __forceinline__ float f16hi(unsigned u) { return (float)__builtin_bit_cast(f16x2_t, u)[1]; }

template <class Epi, class Sched, bool ALIGN_EPI = true, bool F16 = false>
__device__ __forceinline__ void gemm_phase(PG8_LAS unsigned char* lds, const Gemm g, const Sched& S, const Epi& E, int tid_in) {
    int tid_ = tid_in; asm volatile("" : "+v"(tid_));
    const int tid = tid_, wid = __builtin_amdgcn_readfirstlane(tid >> 6), lane = tid & 63, wr = wid >> 2, wc = wid & 3, fr = lane & 15, fq = lane >> 4;
    const int K = g.K, nt = K / BK, lda = g.lda;
    unsigned voffA[2], voffB[2];
#pragma unroll
    for (int i = 0; i < 2; ++i) { int R, C; stage_rc(tid * 16 + i * 8192, R, C); const int Rb = Epi::PERM ? ((R & ~31) + perm32(R & 31)) : R;
        voffA[i] = (unsigned)(R * lda + C) * 2u; voffB[i] = (unsigned)(Rb * K + C) * 2u; }
    const unsigned kstep = (unsigned)(BK * 2);
    const unsigned hstepA = (unsigned)(HALF * lda * 2), hstepB = (unsigned)(HALF * K * 2);
    const unsigned tstepA = 2 * hstepA, tstepB = 2 * hstepB;
    const __amdgpu_buffer_rsrc_t rsA = __builtin_amdgcn_make_buffer_rsrc((void*)g.A, (short)0, -1, 0x00020000), rsB = __builtin_amdgcn_make_buffer_rsrc((void*)g.Bt, (short)0, -1, 0x00020000);
    const unsigned ldsw = (unsigned)wid * 1024u;
    const int aoff = lds_byte(wr * 64 + fr, fq * 8), boff = lds_byte(wc * 32 + fr, fq * 8);
#define PG8_SA(b, h) (((b) * 2 + (h)) * HTB)
#define PG8_SB(b, h) ((4 + (b) * 2 + (h)) * HTB)
#define PG8_STAGE(bufoff, soff, voff) do { _Pragma("unroll") for (int _i = 0; _i < 2; ++_i) \
        __builtin_amdgcn_raw_ptr_buffer_load_lds(PG8_RS_##voff, (PG8_LAS void*)(lds + (bufoff) + ldsw + _i * 8192), 16, (voff)[_i], (soff), 0, 0); } while (0)
#define PG8_RS_voffA rsA
#define PG8_RS_voffB rsB
#define PG8_LDA(dst, b, h) do { _Pragma("unroll") for (int m = 0; m < 4; ++m) _Pragma("unroll") for (int k = 0; k < 2; ++k) dst[m][k] = *(const PG8_LAS bf16x8*)(lds + PG8_SA(b, h) + aoff + m * 2048 + k * 1024); } while (0)
#define PG8_LDB(dst, b, h) do { _Pragma("unroll") for (int n = 0; n < 2; ++n) _Pragma("unroll") for (int k = 0; k < 2; ++k) dst[n][k] = *(const PG8_LAS bf16x8*)(lds + PG8_SB(b, h) + boff + n * 2048 + k * 1024); } while (0)
#define PG8_MMA(ai, bj, At, Bt) do { __builtin_amdgcn_s_setprio(1); _Pragma("unroll") for (int m = 0; m < 4; ++m) _Pragma("unroll") for (int n = 0; n < 2; ++n) _Pragma("unroll") for (int k = 0; k < 2; ++k) \
        { if constexpr (F16) acc[ai][bj][m][n] = __builtin_amdgcn_mfma_f32_16x16x32_f16(__builtin_bit_cast(f16x8_t, Bt[n][k]), __builtin_bit_cast(f16x8_t, At[m][k]), acc[ai][bj][m][n], 0, 0, 0); \
          else acc[ai][bj][m][n] = __builtin_amdgcn_mfma_f32_16x16x32_bf16(Bt[n][k], At[m][k], acc[ai][bj][m][n], 0, 0, 0); } __builtin_amdgcn_s_setprio(0); } while (0)
#define PG8_WAIT_V(n) asm volatile("s_waitcnt vmcnt(" #n ")" ::: "memory")
#define PG8_WAIT_L(n) asm volatile("s_waitcnt lgkmcnt(" #n ")" ::: "memory")
#define PG8_BAR __builtin_amdgcn_s_barrier()
#define PG8_SCHED __builtin_amdgcn_sched_barrier(0)
    Unit cur, nxt; int ui = 0;
    if (!S.next(0, cur)) return;
    f32x4 acc[2][2][4][2];
#pragma unroll
    for (int a = 0; a < 2; ++a)
#pragma unroll
        for (int b = 0; b < 2; ++b)
#pragma unroll
            for (int m = 0; m < 4; ++m)
#pragma unroll
                for (int n = 0; n < 2; ++n) acc[a][b][m][n] = (f32x4){0.f, 0.f, 0.f, 0.f};
    bf16x8 At[4][2], B0[2][2], B1[2][2];
    unsigned cA = (unsigned)cur.pm * tstepA, cB = (unsigned)cur.pn * tstepB;
    S.a_ready(cur);
    PG8_STAGE(PG8_SB(0, 0), cB, voffB); PG8_STAGE(PG8_SB(0, 1), cB + hstepB, voffB); PG8_STAGE(PG8_SA(0, 0), cA, voffA); PG8_STAGE(PG8_SA(0, 1), cA + hstepA, voffA);
    if (wr == 1) PG8_BAR;
    PG8_WAIT_V(2); PG8_BAR;
    PG8_STAGE(PG8_SB(1, 0), cB + kstep, voffB); PG8_STAGE(PG8_SA(1, 0), cA + kstep, voffA); PG8_STAGE(PG8_SB(1, 1), cB + hstepB + kstep, voffB);
    PG8_WAIT_V(6); PG8_BAR;
    for (;;) {
        const bool has_next = S.next(ui + 1, nxt);
        const unsigned nA = has_next ? (unsigned)nxt.pm * tstepA : cA, nB = has_next ? (unsigned)nxt.pn * tstepB : cB;
#pragma unroll 1
        for (int t = 0; t < nt; t += 2) {
            const bool last = (t == nt - 2);
            const unsigned a1 = cA + (unsigned)(t + 1) * kstep;
            const unsigned a2 = last ? nA : cA + (unsigned)(t + 2) * kstep, b2 = last ? nB : cB + (unsigned)(t + 2) * kstep;
            const unsigned a3 = a2 + kstep, b3 = b2 + kstep;
            if (last && has_next) S.a_ready(nxt);
            PG8_LDB(B0, 0, 0); PG8_LDB(B1, 0, 1); PG8_SCHED; PG8_LDA(At, 0, 0); PG8_STAGE(PG8_SA(1, 1), a1 + hstepA, voffA);
            PG8_WAIT_V(8); PG8_WAIT_L(0); PG8_BAR; PG8_MMA(0, 0, At, B0); PG8_MMA(0, 1, At, B1); PG8_BAR; PG8_SCHED;
            PG8_LDA(At, 0, 1); PG8_STAGE(PG8_SB(0, 0), b2, voffB); PG8_STAGE(PG8_SB(0, 1), b2 + hstepB, voffB); PG8_STAGE(PG8_SA(0, 0), a2, voffA);
            PG8_WAIT_V(8); PG8_WAIT_L(0); PG8_BAR; PG8_MMA(1, 0, At, B0); PG8_MMA(1, 1, At, B1); PG8_BAR; PG8_SCHED;
            PG8_LDB(B0, 1, 0); PG8_LDB(B1, 1, 1); PG8_SCHED; PG8_LDA(At, 1, 0); PG8_STAGE(PG8_SA(0, 1), a2 + hstepA, voffA);
            PG8_WAIT_V(8); PG8_WAIT_L(0); PG8_BAR; PG8_MMA(0, 0, At, B0); PG8_MMA(0, 1, At, B1); PG8_BAR; PG8_SCHED;
            PG8_LDA(At, 1, 1); PG8_STAGE(PG8_SB(1, 0), b3, voffB); PG8_STAGE(PG8_SB(1, 1), b3 + hstepB, voffB); PG8_STAGE(PG8_SA(1, 0), a3, voffA);
            PG8_WAIT_V(8); PG8_WAIT_L(0); PG8_BAR; PG8_MMA(1, 0, At, B0); PG8_MMA(1, 1, At, B1); PG8_BAR; PG8_SCHED;
        }
        if constexpr (ALIGN_EPI) { if (wr == 0) PG8_BAR; }
        E(acc, cur, wr, wc, fr, fq);
        if (!has_next) break;
#pragma unroll
        for (int a = 0; a < 2; ++a)
#pragma unroll
            for (int b = 0; b < 2; ++b)
#pragma unroll
                for (int m = 0; m < 4; ++m)
#pragma unroll
                    for (int n = 0; n < 2; ++n) acc[a][b][m][n] = (f32x4){0.f, 0.f, 0.f, 0.f};
        cur = nxt; cA = nA; cB = nB; ++ui;
        if constexpr (ALIGN_EPI) { if (wr == 1) PG8_BAR; }
    }
    PG8_WAIT_V(0);
    if constexpr (!ALIGN_EPI) { if (wr == 0) PG8_BAR; }
    PG8_BAR;
#undef PG8_SA
#undef PG8_SB
#undef PG8_STAGE
#undef PG8_RS_voffA
#undef PG8_RS_voffB
#undef PG8_LDA
#undef PG8_LDB
#undef PG8_MMA
#undef PG8_WAIT_V
#undef PG8_WAIT_L
#undef PG8_BAR
#undef PG8_SCHED
}
struct Gemm3 { const bf16_t* A0; const bf16_t* A1; const bf16_t* A2; const bf16_t* B0; const bf16_t* B1; const bf16_t* B2; int K0, K1, K2; };
template <class Epi, class Sched>
__device__ __forceinline__ void gemm_phase_ms(PG8_LAS unsigned char* lds, const Gemm3 g, const Sched& S, const Epi& E, int tid_in) {
    constexpr bool ALIGN_EPI = true, F16 = false;
    int tid_ = tid_in; asm volatile("" : "+v"(tid_));
    const int tid = tid_, wid = __builtin_amdgcn_readfirstlane(tid >> 6), lane = tid & 63, wr = wid >> 2, wc = wid & 3, fr = lane & 15, fq = lane >> 4;
#define PG8_VOFF(vA_, vB_, K_) do { int R_, C_; stage_rc(tid * 16, R_, C_); const int Rb_ = Epi::PERM ? ((R_ & ~31) + perm32(R_ & 31)) : R_; vA_ = (unsigned)(R_ * (K_) + C_) * 2u; vB_ = (unsigned)(Rb_ * (K_) + C_) * 2u; } while (0)
#define PG8_SEGK(sg) ((sg) == 0 ? g.K0 : (sg) == 1 ? g.K1 : g.K2)
#define PG8_SEGA(sg) ((const char*)((sg) == 0 ? g.A0 : (sg) == 1 ? g.A1 : g.A2))
#define PG8_SEGB(sg) ((const char*)((sg) == 0 ? g.B0 : (sg) == 1 ? g.B1 : g.B2))
    const size_t kstep = (size_t)(BK * 2);
    const unsigned ldsw = (unsigned)wid * 1024u;
    const int aoff = lds_byte(wr * 64 + fr, fq * 8), boff = lds_byte(wc * 32 + fr, fq * 8);
#define PG8_SA(b, h) (((b) * 2 + (h)) * HTB)
#define PG8_SB(b, h) ((4 + (b) * 2 + (h)) * HTB)
#define PG8_STAGE(bufoff, gbase, voff, s64) do { __builtin_amdgcn_global_load_lds((const unsigned*)((const char*)(gbase) + (voff)), (PG8_LAS unsigned*)(lds + (bufoff) + ldsw), 16, 0, 0); \
        __builtin_amdgcn_global_load_lds((const unsigned*)((const char*)(gbase) + (s64) + (voff)), (PG8_LAS unsigned*)(lds + (bufoff) + ldsw + 8192), 16, 0, 0); } while (0)
#define PG8_LDA(dst, b, h) do { _Pragma("unroll") for (int m = 0; m < 4; ++m) _Pragma("unroll") for (int k = 0; k < 2; ++k) dst[m][k] = *(const PG8_LAS bf16x8*)(lds + PG8_SA(b, h) + aoff + m * 2048 + k * 1024); } while (0)
#define PG8_LDB(dst, b, h) do { _Pragma("unroll") for (int n = 0; n < 2; ++n) _Pragma("unroll") for (int k = 0; k < 2; ++k) dst[n][k] = *(const PG8_LAS bf16x8*)(lds + PG8_SB(b, h) + boff + n * 2048 + k * 1024); } while (0)
#define PG8_MMA(ai, bj, At, Bt) do { __builtin_amdgcn_s_setprio(1); _Pragma("unroll") for (int m = 0; m < 4; ++m) _Pragma("unroll") for (int n = 0; n < 2; ++n) _Pragma("unroll") for (int k = 0; k < 2; ++k) \
        { if constexpr (F16) acc[ai][bj][m][n] = __builtin_amdgcn_mfma_f32_16x16x32_f16(__builtin_bit_cast(f16x8_t, Bt[n][k]), __builtin_bit_cast(f16x8_t, At[m][k]), acc[ai][bj][m][n], 0, 0, 0); \
          else acc[ai][bj][m][n] = __builtin_amdgcn_mfma_f32_16x16x32_bf16(Bt[n][k], At[m][k], acc[ai][bj][m][n], 0, 0, 0); } __builtin_amdgcn_s_setprio(0); } while (0)
#define PG8_WAIT_V(n) asm volatile("s_waitcnt vmcnt(" #n ")" ::: "memory")
#define PG8_WAIT_L(n) asm volatile("s_waitcnt lgkmcnt(" #n ")" ::: "memory")
#define PG8_BAR __builtin_amdgcn_s_barrier()
#define PG8_SCHED __builtin_amdgcn_sched_barrier(0)
    Unit cur, nxt; int ui = 0, seg = 0;
    if (!S.next(0, cur)) return;
    f32x4 acc[2][2][4][2];
#pragma unroll
    for (int a = 0; a < 2; ++a)
#pragma unroll
        for (int b = 0; b < 2; ++b)
#pragma unroll
            for (int m = 0; m < 4; ++m)
#pragma unroll
                for (int n = 0; n < 2; ++n) acc[a][b][m][n] = (f32x4){0.f, 0.f, 0.f, 0.f};
    bf16x8 At[4][2], B0[2][2], B1[2][2];
    int Kc = PG8_SEGK(0); int nt = Kc / BK; size_t hstep = (size_t)HALF * Kc * 2;
    unsigned voffA, voffB; PG8_VOFF(voffA, voffB, Kc);
    const char* cA = PG8_SEGA(0) + (size_t)cur.pm * 2 * hstep; const char* cB = PG8_SEGB(0) + (size_t)cur.pn * 2 * hstep;
    S.a_ready(cur);
    PG8_STAGE(PG8_SB(0, 0), cB, voffB, (hstep >> 1)); PG8_STAGE(PG8_SB(0, 1), cB + hstep, voffB, (hstep >> 1)); PG8_STAGE(PG8_SA(0, 0), cA, voffA, (hstep >> 1)); PG8_STAGE(PG8_SA(0, 1), cA + hstep, voffA, (hstep >> 1));
    if (wr == 1) PG8_BAR;
    PG8_WAIT_V(2); PG8_BAR;
    PG8_STAGE(PG8_SB(1, 0), cB + kstep, voffB, (hstep >> 1)); PG8_STAGE(PG8_SA(1, 0), cA + kstep, voffA, (hstep >> 1)); PG8_STAGE(PG8_SB(1, 1), cB + hstep + kstep, voffB, (hstep >> 1));
    PG8_WAIT_V(6); PG8_BAR;
    for (;;) {
        const int nseg = (seg == 2) ? 0 : seg + 1; nxt = cur;
        const bool has_next = (seg < 2) ? true : S.next(ui + 1, nxt);
        const int Kn = has_next ? PG8_SEGK(nseg) : Kc; const size_t hstepN = (size_t)HALF * Kn * 2;
        unsigned voffAn, voffBn; PG8_VOFF(voffAn, voffBn, Kn);
        const char* nA = has_next ? PG8_SEGA(nseg) + (size_t)nxt.pm * 2 * hstepN : cA; const char* nB = has_next ? PG8_SEGB(nseg) + (size_t)nxt.pn * 2 * hstepN : cB;
#pragma unroll 1
        for (int t = 0; t < nt; t += 2) {
            const bool last = (t == nt - 2);
            const char* a1 = cA + (size_t)(t + 1) * kstep;
            const char* a2 = last ? nA : cA + (size_t)(t + 2) * kstep; const char* b2 = last ? nB : cB + (size_t)(t + 2) * kstep;
            const char* a3 = a2 + kstep; const char* b3 = b2 + kstep;
            const size_t hs2 = last ? hstepN : hstep;
            const unsigned vA2 = last ? voffAn : voffA, vB2 = last ? voffBn : voffB; const size_t q2 = hs2 >> 1;
            PG8_LDB(B0, 0, 0); PG8_LDB(B1, 0, 1); PG8_SCHED; PG8_LDA(At, 0, 0); PG8_STAGE(PG8_SA(1, 1), a1 + hstep, voffA, (hstep >> 1));
            PG8_WAIT_V(8); PG8_WAIT_L(0); PG8_BAR; PG8_MMA(0, 0, At, B0); PG8_MMA(0, 1, At, B1); PG8_BAR; PG8_SCHED;
            PG8_LDA(At, 0, 1); PG8_STAGE(PG8_SB(0, 0), b2, vB2, q2); PG8_STAGE(PG8_SB(0, 1), b2 + hs2, vB2, q2); PG8_STAGE(PG8_SA(0, 0), a2, vA2, q2);
            PG8_WAIT_V(8); PG8_WAIT_L(0); PG8_BAR; PG8_MMA(1, 0, At, B0); PG8_MMA(1, 1, At, B1); PG8_BAR; PG8_SCHED;
            PG8_LDB(B0, 1, 0); PG8_LDB(B1, 1, 1); PG8_SCHED; PG8_LDA(At, 1, 0); PG8_STAGE(PG8_SA(0, 1), a2 + hs2, vA2, q2);
            PG8_WAIT_V(8); PG8_WAIT_L(0); PG8_BAR; PG8_MMA(0, 0, At, B0); PG8_MMA(0, 1, At, B1); PG8_BAR; PG8_SCHED;
            PG8_LDA(At, 1, 1); PG8_STAGE(PG8_SB(1, 0), b3, vB2, q2); PG8_STAGE(PG8_SB(1, 1), b3 + hs2, vB2, q2); PG8_STAGE(PG8_SA(1, 0), a3, vA2, q2);
            PG8_WAIT_V(8); PG8_WAIT_L(0); PG8_BAR; PG8_MMA(1, 0, At, B0); PG8_MMA(1, 1, At, B1); PG8_BAR; PG8_SCHED;
        }
        if constexpr (ALIGN_EPI) { if (wr == 0) PG8_BAR; }
        E(acc, cur, seg, wr, wc, fr, fq);
        if (!has_next) break;
        if (seg == 2) {
#pragma unroll
        for (int a = 0; a < 2; ++a)
#pragma unroll
            for (int b = 0; b < 2; ++b)
#pragma unroll
                for (int m = 0; m < 4; ++m)
#pragma unroll
                    for (int n = 0; n < 2; ++n) acc[a][b][m][n] = (f32x4){0.f, 0.f, 0.f, 0.f};
        ++ui; }
        cur = nxt; cA = nA; cB = nB; seg = nseg; Kc = Kn; nt = Kc / BK; hstep = hstepN;
        voffA = voffAn; voffB = voffBn;
        if constexpr (ALIGN_EPI) { if (wr == 1) PG8_BAR; }
    }
    PG8_WAIT_V(0);
    if constexpr (!ALIGN_EPI) { if (wr == 0) PG8_BAR; }
    PG8_BAR;
#undef PG8_VOFF
#undef PG8_SEGK
#undef PG8_SEGA
#undef PG8_SEGB
#undef PG8_SA
#undef PG8_SB
#undef PG8_STAGE
#undef PG8_LDA
#undef PG8_LDB
#undef PG8_MMA
#undef PG8_WAIT_V
#undef PG8_WAIT_L
#undef PG8_BAR
#undef PG8_SCHED
}
}

typedef unsigned short bf16;
typedef float f32x4 __attribute__((ext_vector_type(4)));
typedef float f32x2 __attribute__((ext_vector_type(2)));
typedef unsigned u32x4 __attribute__((ext_vector_type(4)));
typedef unsigned u32x2 __attribute__((ext_vector_type(2)));
#define GAS __attribute__((address_space(1)))
#define LAS __attribute__((address_space(3)))

constexpr int BATCH = 16, SEQ = 4096, DM = 1024, MTOK = BATCH * SEQ, DEPTH = 4, DFF = 2816, PLE = 256, INW = 9664;
constexpr int O_CQ = 5888, O_CKV = 6272, O_CKR = 6528, O_G = 6592, O_B = 2304;
constexpr int N_IN1 = 3072, N_INB = 3584, N_ING = 3072, N_QB = 1280;
constexpr int P_QKVA = 2304, P_CLR = 768, CLR_KV = 384, CLR_KR = 640, P_QC = 1152, P_KVC = 1536, P_BIN = 3584, P_GS = 3072;
constexpr float EPS = 1e-6f, LOG2E = 1.4426950408889634f;
constexpr float QSCALE_A = 0.125f * LOG2E;
constexpr float QSCALE_C = 0.07216878364870322f * LOG2E;

constexpr size_t MiB = 1u << 20;
constexpr size_t WS_CTL = 0, CTL_ZERO_BYTES = 1 * MiB;
constexpr size_t WS_ROPEA = 1 * MiB, WS_ROPEC = 1 * MiB + 256 * 1024, WS_LB = 2 * MiB + 512 * 1024;
constexpr size_t WS_W = 4 * MiB;
constexpr size_t W_1U = 0, W_1D = 11 * MiB, W_IN1 = W_1D + 5632 * 1024, W_INB = 23 * MiB, W_ING = 30 * MiB, W_QB = 36 * MiB, W_KVB = 37 * MiB, W_A = 38 * MiB,
                 W_B = W_A + 512 * 1024, W_C = 40 * MiB, W_O = W_C + 1536 * 1024, W_2U = W_O + 2 * MiB, W_2D = W_2U + 11 * MiB, W_PG = 60 * MiB, W_PP = 62 * MiB;
static_assert(W_1U + (size_t)5632 * 1024 * 2 <= W_1D && W_1D + (size_t)1024 * 2816 * 2 <= W_IN1 && W_IN1 + (size_t)N_IN1 * 1024 * 2 <= W_INB && W_INB + (size_t)N_INB * 1024 * 2 <= W_ING &&
              W_ING + (size_t)N_ING * 1024 * 2 <= W_QB && W_QB + (size_t)N_QB * 384 * 2 <= W_KVB && W_KVB + (size_t)1536 * 256 * 2 <= W_A && W_A + 1024 * 256 * 2 <= W_B &&
              W_B + 1024 * 768 * 2 <= W_C && W_C + 1024 * 768 * 2 <= W_O && W_O + 1024 * 1024 * 2 <= W_2U && W_2U + (size_t)5632 * 1024 * 2 <= W_2D && W_2D + (size_t)1024 * 2816 * 2 <= W_PG &&
              W_PG + 1024 * 1024 * 2 <= W_PP && W_PP + 1024 * 256 * 2 <= 64 * MiB, "weight map");
constexpr size_t WS_XBE = 68 * MiB, WS_XBO = 196 * MiB, WS_XN = WS_XBE, WS_MG = 708 * MiB;
constexpr size_t WS_H = 324 * MiB, WS_QKVA = 196 * MiB, WS_CLR = 484 * MiB, WS_AOG = 612 * MiB, WS_LSE = 708 * MiB, WS_QC = 196 * MiB, WS_CO = 340 * MiB, WS_KVC = 744 * MiB,
                 WS_AOUT = 936 * MiB, WS_BIN = 484 * MiB, WS_BO = 196 * MiB, WS_GS = 484 * MiB, WS_PB = 936 * MiB, WS_PP = 708 * MiB, WS_SH = 292 * MiB, WS_SS0 = 968 * MiB, WS_SS1 = 972 * MiB, WS_END = 976 * MiB;
constexpr int CW_BAR = 4096;

constexpr int RING_BYTES = 131072, PHASE_LDS = 155648, LDSCTL_OFF = PHASE_LDS, MISC_OFF = LDSCTL_OFF + 320, LDS_BYTES = 163840;

#define RLX_AGENT __ATOMIC_RELAXED, __HIP_MEMORY_SCOPE_AGENT
#define LDS_WAIT() asm volatile("s_waitcnt lgkmcnt(0)" ::: "memory")
#define VM_WAIT() asm volatile("s_waitcnt vmcnt(0)" ::: "memory")
__device__ __forceinline__ unsigned f2bf(float f) { unsigned u = __builtin_bit_cast(unsigned, f); return (u + 0x7fffu + ((u >> 16) & 1u)) >> 16; }
__device__ __forceinline__ unsigned pk2(float lo, float hi) { return f2bf(lo) | (f2bf(hi) << 16); }
__device__ __forceinline__ float bflo(unsigned w) { return __builtin_bit_cast(float, w << 16); }
__device__ __forceinline__ float bfhi(unsigned w) { return __builtin_bit_cast(float, w & 0xffff0000u); }
__device__ __forceinline__ float bf2f(bf16 b) { return __builtin_bit_cast(float, (unsigned)b << 16); }
__device__ __forceinline__ float sigmoidf_(float x) { return __builtin_amdgcn_rcpf(1.f + __builtin_amdgcn_exp2f(-x * LOG2E)); }
__device__ __forceinline__ float wave_sum(float v) {
#pragma unroll
    for (int o = 1; o < 64; o <<= 1) v += __shfl_xor(v, o);
    return v;
}
__device__ __forceinline__ float wave_max(float v) {
#pragma unroll
    for (int o = 1; o < 64; o <<= 1) v = fmaxf(v, __shfl_xor(v, o));
    return v;
}

#define XB_TMO      128
#define XB_XCNT(j)  (256  + 64 * (j))
#define XB_XSUB(j)  (1280 + 64 * (j))
#define XB_XGEN(j)  (2304 + 64 * (j))
#define XB_TOP      3328
#define XB_TOPGEN   3392
#define XCD_BAR_WORDS 3456
#define XB_SPIN_CAP (1u << 25)
__device__ __forceinline__ unsigned xb_ld(unsigned* p)              { return __hip_atomic_load(p, __ATOMIC_RELAXED, __HIP_MEMORY_SCOPE_AGENT); }
__device__ __forceinline__ unsigned xb_add(unsigned* p, unsigned v) { return __hip_atomic_fetch_add(p, v, __ATOMIC_RELAXED, __HIP_MEMORY_SCOPE_AGENT); }
__device__ __forceinline__ unsigned xb_xcc_id() { return (unsigned)__builtin_amdgcn_s_getreg((3 << 11) | 20) & 0xFu; }
#define XB_SPIN(cond, bar) do { unsigned _sp = 0; while (cond) { __builtin_amdgcn_s_sleep(1); \
    if ((++_sp & 255u) == 0u) { if (xb_ld(&(bar)[XB_TMO])) break; if (_sp > XB_SPIN_CAP) { atomicAdd(&(bar)[XB_TMO], 1u); break; } } } } while (0)
struct XcdBarrier { unsigned* bar; unsigned x; volatile LAS unsigned* st; };
__device__ __forceinline__ XcdBarrier xcd_barrier_post(unsigned* bar, volatile LAS unsigned* st) {
    XcdBarrier b; b.bar = bar; b.x = xb_xcc_id(); b.st = st;
    if (threadIdx.x == 0) (void)xb_add(&bar[XB_XCNT(b.x)], 1u);
    return b;
}
__device__ __forceinline__ void xcd_barrier_complete(unsigned* bar, unsigned x, unsigned& nloc, unsigned& nx) {
    const unsigned G = gridDim.x * gridDim.y * gridDim.z;
    unsigned sum, cnt, mine, sp = 0u;
    for (;;) {
        sum = 0u; cnt = 0u; mine = 0u;
#pragma unroll
        for (unsigned j = 0; j < 16; ++j) { const unsigned c = xb_ld(&bar[XB_XCNT(j)]); sum += c; cnt += (c > 0u) ? 1u : 0u; mine = (j == x) ? c : mine; }
        if (sum == G) break;
        __builtin_amdgcn_s_sleep(1);
        if ((++sp & 255u) == 0u) { if (xb_ld(&bar[XB_TMO])) break; if (sp > XB_SPIN_CAP) { atomicAdd(&bar[XB_TMO], 1u); break; } }
    }
    nloc = mine > 0u ? mine : 1u; nx = cnt > 0u ? cnt : 1u;
}
__device__ __forceinline__ void xcd_barrier(const XcdBarrier& b, const bool leader) {
    asm volatile("s_waitcnt vmcnt(0)" ::: "memory");
    __syncthreads();
    if (leader) {
        unsigned* bar = b.bar;
        __builtin_amdgcn_s_waitcnt(0);
        unsigned nloc = b.st[0], nx = b.st[1];
        if (nloc == 0u) { xcd_barrier_complete(bar, b.x, nloc, nx); b.st[0] = nloc; b.st[1] = nx; }
        const unsigned old = xb_add(&bar[XB_XSUB(b.x)], 1u);
        const unsigned gen = old / nloc;
        if (old + 1u == (gen + 1u) * nloc) {
            __builtin_amdgcn_fence(__ATOMIC_RELEASE, "agent");
            asm volatile("s_waitcnt vmcnt(0)" ::: "memory");
            const unsigned og = xb_add(&bar[XB_TOP], 1u);
            const unsigned tg = og / nx;
            if (og + 1u == (tg + 1u) * nx) xb_add(&bar[XB_TOPGEN], 1u);
            else XB_SPIN(xb_ld(&bar[XB_TOPGEN]) == tg, bar);
            __builtin_amdgcn_fence(__ATOMIC_ACQUIRE, "agent");
            xb_add(&bar[XB_XGEN(b.x)], 1u);
            asm volatile("s_waitcnt vmcnt(0)" ::: "memory");
        } else {
            XB_SPIN(xb_ld(&bar[XB_XGEN(b.x)]) == gen, bar);
            __builtin_amdgcn_fence(__ATOMIC_ACQUIRE, "agent");
            asm volatile("s_waitcnt vmcnt(0)" ::: "memory");
        }
    }
    __syncthreads();
}

using pg8::Unit;
constexpr int RS_OFF = RING_BYTES, RS_SLOTS = 6;
struct RsTab { const LAS float* tab; int g0; };
__device__ __forceinline__ float rs_get(const RsTab& T, int row) { return T.tab[(((row >> 11) - T.g0) << 8) + (row & 255)]; }
__device__ __forceinline__ float row_rstd(const float* SS, int row) {
    const f32x4* p = (const f32x4*)(SS + (size_t)row * 16); const f32x4 a = p[0], b = p[1], c = p[2], d = p[3];
    const float s = (((a[0] + a[1]) + (a[2] + a[3])) + ((b[0] + b[1]) + (b[2] + b[3]))) + (((c[0] + c[1]) + (c[2] + c[3])) + ((d[0] + d[1]) + (d[2] + d[3])));
    return 1.f / sqrtf(s * (1.f / DM) + EPS);
}
struct EpiSwiglu {
    static constexpr bool PERM = true;
    bf16* H; RsTab SS;
    __device__ __forceinline__ void operator()(const f32x4 (&acc)[2][2][4][2], const Unit& u, int wr, int wc, int fr, int fq) const {
        const int row0 = u.pm * 256 + wr * 64 + fr, col0 = u.pn * 128 + wc * 32 + 8 * fq;
#pragma unroll
        for (int ai = 0; ai < 2; ++ai)
#pragma unroll
            for (int m = 0; m < 4; ++m) { const int row = row0 + ai * 128 + m * 16; const float rs = rs_get(SS, row);
                float h[8];
#pragma unroll
                for (int n = 0; n < 2; ++n)
#pragma unroll
                    for (int j = 0; j < 4; ++j) { const float g = acc[ai][0][m][n][j] * rs, uu = acc[ai][1][m][n][j] * rs; h[4 * n + j] = g * sigmoidf_(g) * uu; }
                u32x4 w; w.x = pg8::cvt_pk_bf16(h[0], h[1]); w.y = pg8::cvt_pk_bf16(h[2], h[3]); w.z = pg8::cvt_pk_bf16(h[4], h[5]); w.w = pg8::cvt_pk_bf16(h[6], h[7]);
                *(u32x4*)(H + (size_t)row * DFF + col0) = w; }
    }
};
struct EpiResid {
    static constexpr bool PERM = true;
    static constexpr int LA = 4;
    const bf16* XI; bf16* XO; float scale; float* SSo;
    __device__ __forceinline__ void operator()(const f32x4 (&acc)[2][2][4][2], const Unit& u, int wr, int wc, int fr, int fq) const {
        const unsigned row0 = u.pm * 256 + wr * 64 + fr, col0 = u.pn * 256 + wc * 32 + 8 * fq;
        float sc = scale; asm volatile("" : "+v"(sc));
        u32x4 xi[8][2];
#pragma unroll
        for (int it = 0; it < 8 + LA; ++it) {
            if (it < 8) { const unsigned off = (row0 + (it >> 2) * 128 + (it & 3) * 16) * (unsigned)DM + col0;
#pragma unroll
                for (int bj = 0; bj < 2; ++bj) xi[it][bj] = *(const u32x4*)(XI + off + bj * 128); }
            if (it >= LA) { const int r = it - LA; const unsigned row = row0 + (r >> 2) * 128 + (r & 3) * 16; float ssq = 0.f;
#pragma unroll
                for (int bj = 0; bj < 2; ++bj) { const unsigned off = row * (unsigned)DM + col0 + bj * 128; const u32x4 w = xi[r][bj]; const f32x4 a0 = acc[r >> 2][bj][r & 3][0], a1 = acc[r >> 2][bj][r & 3][1];
                    f32x4 x0, x1;
                    x0[0] = pg8::f16lo(w.x) + a0[0] * sc; x0[1] = pg8::f16hi(w.x) + a0[1] * sc; x0[2] = pg8::f16lo(w.y) + a0[2] * sc; x0[3] = pg8::f16hi(w.y) + a0[3] * sc;
                    x1[0] = pg8::f16lo(w.z) + a1[0] * sc; x1[1] = pg8::f16hi(w.z) + a1[1] * sc; x1[2] = pg8::f16lo(w.w) + a1[2] * sc; x1[3] = pg8::f16hi(w.w) + a1[3] * sc;
                    ssq += ((x0[0] * x0[0] + x0[1] * x0[1]) + (x0[2] * x0[2] + x0[3] * x0[3])) + ((x1[0] * x1[0] + x1[1] * x1[1]) + (x1[2] * x1[2] + x1[3] * x1[3]));
                    u32x4 o; o.x = pg8::cvt_pk_f16(x0[0], x0[1]); o.y = pg8::cvt_pk_f16(x0[2], x0[3]); o.z = pg8::cvt_pk_f16(x1[0], x1[1]); o.w = pg8::cvt_pk_f16(x1[2], x1[3]);
                    *(u32x4*)(XO + off) = o; }
                ssq += __shfl_xor(ssq, 16); ssq += __shfl_xor(ssq, 32);
                if (fq == 0) SSo[row * 16u + u.pn * 4 + wc] = ssq; }
        }
    }
};
template <int ACT, bool NORM> struct EpiBf16 {
    static constexpr bool PERM = true;
    bf16* O; int ldc; RsTab SS;
    __device__ __forceinline__ void operator()(const f32x4 (&acc)[2][2][4][2], const Unit& u, int wr, int wc, int fr, int fq) const {
        const int row0 = u.pm * 256 + wr * 64 + fr, col0 = u.pn * 256 + wc * 32 + 8 * fq;
#pragma unroll
        for (int ai = 0; ai < 2; ++ai)
#pragma unroll
            for (int m = 0; m < 4; ++m) { const int row = row0 + ai * 128 + m * 16; bf16* rowp = O + (size_t)row * ldc + col0; float rs = 1.f; if (NORM) rs = rs_get(SS, row);
#pragma unroll
                for (int bj = 0; bj < 2; ++bj) { f32x4 v0 = acc[ai][bj][m][0], v1 = acc[ai][bj][m][1];
                    if (NORM) { v0 = v0 * rs; v1 = v1 * rs; }
                    if (ACT == 1) {
#pragma unroll
                        for (int j = 0; j < 4; ++j) { v0[j] = sigmoidf_(v0[j]); v1[j] = sigmoidf_(v1[j]); } }
                    u32x4 w; w.x = pg8::cvt_pk_bf16(v0[0], v0[1]); w.y = pg8::cvt_pk_bf16(v0[2], v0[3]); w.z = pg8::cvt_pk_bf16(v1[0], v1[1]); w.w = pg8::cvt_pk_bf16(v1[2], v1[3]);
                    *(u32x4*)(rowp + bj * 128) = w; } }
    }
};
struct EpiGate8 {
    static constexpr bool PERM = true;
    unsigned char* G8; RsTab SS;
    __device__ __forceinline__ void operator()(const f32x4 (&acc)[2][2][4][2], const Unit& u, int wr, int wc, int fr, int fq) const {
        const int row0 = u.pm * 256 + wr * 64 + fr, col0 = u.pn * 256 + wc * 32 + 8 * fq;
#pragma unroll
        for (int ai = 0; ai < 2; ++ai)
#pragma unroll
            for (int m = 0; m < 4; ++m) { const int row = row0 + ai * 128 + m * 16; unsigned char* rowp = G8 + (size_t)row * P_GS + col0; const float rs = rs_get(SS, row);
#pragma unroll
                for (int bj = 0; bj < 2; ++bj) { const f32x4 v0 = acc[ai][bj][m][0] * rs, v1 = acc[ai][bj][m][1] * rs;
                    unsigned b[8];
#pragma unroll
                    for (int j = 0; j < 4; ++j) { b[j] = max((unsigned)(sigmoidf_(v0[j]) * 255.f + 0.5f), 1u); b[4 + j] = max((unsigned)(sigmoidf_(v1[j]) * 255.f + 0.5f), 1u); }
                    u32x2 w; w.x = b[0] | (b[1] << 8) | (b[2] << 16) | (b[3] << 24); w.y = b[4] | (b[5] << 8) | (b[6] << 16) | (b[7] << 24);
                    *(u32x2*)(rowp + bj * 128) = w; } }
    }
};
__device__ __forceinline__ void rope4(f32x4& v, const f32x4 cs) {
    const float a0 = v[0] * cs[0] - v[1] * cs[1], b0 = v[1] * cs[0] + v[0] * cs[1], a1 = v[2] * cs[2] - v[3] * cs[3], b1 = v[3] * cs[2] + v[2] * cs[3];
    v[0] = a0; v[1] = b0; v[2] = a1; v[3] = b1;
}
struct EpiIn1 {
    static constexpr bool PERM = true;
    bf16* QKVA; bf16* CLR; const float* ropeA; const float* ropeC; RsTab SS;
    __device__ __forceinline__ void operator()(const f32x4 (&acc)[2][2][4][2], const Unit& u, int wr, int wc, int fr, int fq) const {
        const int row0 = u.pm * 256 + wr * 64 + fr;
        const bool isA = u.pn < 9;
        bf16* base = isA ? QKVA : CLR; const int ldc = isA ? P_QKVA : P_CLR; const int colt = isA ? u.pn * 256 : (u.pn - 9) * 256;
        const int col0 = colt + wc * 32 + 8 * fq;
        const bool ropeq = (u.pn < 6) && ((wc & 1) == 0) && (fq < 2);
        const bool ropek = (u.pn == 11) && (wc < 2);
        const float qs = (u.pn < 3) ? QSCALE_A : 1.f;
        f32x4 cs[8][2];
        if (ropeq || ropek) { const float* rp = ropeq ? ropeA + 8 * fq : ropeC + 32 * wc + 8 * fq; const int rstride = ropeq ? 16 : 64;
#pragma unroll
            for (int r = 0; r < 8; ++r) { const int pos = (row0 + (r >> 2) * 128 + (r & 3) * 16) & (SEQ - 1); cs[r][0] = *(const f32x4*)(rp + pos * rstride); cs[r][1] = *(const f32x4*)(rp + pos * rstride + 4); } }
        else {
#pragma unroll
            for (int r = 0; r < 8; ++r) { cs[r][0] = (f32x4){1.f, 0.f, 1.f, 0.f}; cs[r][1] = (f32x4){1.f, 0.f, 1.f, 0.f}; } }
#pragma unroll
        for (int ai = 0; ai < 2; ++ai)
#pragma unroll
            for (int m = 0; m < 4; ++m) { const int row = row0 + ai * 128 + m * 16; bf16* rowp = base + (size_t)row * ldc + col0; const float rs = rs_get(SS, row);
#pragma unroll
                for (int bj = 0; bj < 2; ++bj) { f32x4 v0 = acc[ai][bj][m][0] * rs, v1 = acc[ai][bj][m][1] * rs;
                    if (ropeq || (ropek && bj == 1)) { rope4(v0, cs[ai * 4 + m][0]); rope4(v1, cs[ai * 4 + m][1]); }
                    v0 = v0 * qs; v1 = v1 * qs;
                    u32x4 w; w.x = pg8::cvt_pk_bf16(v0[0], v0[1]); w.y = pg8::cvt_pk_bf16(v0[2], v0[3]); w.z = pg8::cvt_pk_bf16(v1[0], v1[1]); w.w = pg8::cvt_pk_bf16(v1[2], v1[3]);
                    *(u32x4*)(rowp + bj * 128) = w; } }
    }
};
struct EpiQC {
    static constexpr bool PERM = true;
    bf16* QC; const float* ropeC;
    __device__ __forceinline__ void operator()(const f32x4 (&acc)[2][2][4][2], const Unit& u, int wr, int wc, int fr, int fq) const {
        const int row0 = u.pm * 256 + wr * 64 + fr;
#pragma unroll
        for (int bj = 0; bj < 2; ++bj) { const int cu = u.pn * 256 + bj * 128 + wc * 32;
            if (cu >= P_QC) continue;
            const int col0 = cu + 8 * fq; const int ub = cu % 192; const bool rp = ub >= 128; const int d0 = ub + 8 * fq;
            f32x4 cs[8][2];
            if (rp) {
#pragma unroll
                for (int r = 0; r < 8; ++r) { const int pos = (row0 + (r >> 2) * 128 + (r & 3) * 16) & (SEQ - 1); cs[r][0] = *(const f32x4*)(ropeC + pos * 64 + (d0 - 128)); cs[r][1] = *(const f32x4*)(ropeC + pos * 64 + (d0 - 128) + 4); } }
            else {
#pragma unroll
                for (int r = 0; r < 8; ++r) { cs[r][0] = (f32x4){1.f, 0.f, 1.f, 0.f}; cs[r][1] = (f32x4){1.f, 0.f, 1.f, 0.f}; } }
#pragma unroll
            for (int ai = 0; ai < 2; ++ai)
#pragma unroll
                for (int m = 0; m < 4; ++m) { const int row = row0 + ai * 128 + m * 16;
                    f32x4 v0 = acc[ai][bj][m][0], v1 = acc[ai][bj][m][1];
                    if (rp) { rope4(v0, cs[ai * 4 + m][0]); rope4(v1, cs[ai * 4 + m][1]); }
                    v0 = v0 * QSCALE_C; v1 = v1 * QSCALE_C;
                    u32x4 w; w.x = pg8::cvt_pk_bf16(v0[0], v0[1]); w.y = pg8::cvt_pk_bf16(v0[2], v0[3]); w.z = pg8::cvt_pk_bf16(v1[0], v1[1]); w.w = pg8::cvt_pk_bf16(v1[2], v1[3]);
                    *(u32x4*)(QC + (size_t)row * P_QC + col0) = w; } }
    }
};
template <bool FIRST> struct EpiMerge {
    static constexpr bool PERM = true;
    static constexpr int LA = 4;
    bf16* MG; const unsigned char* GS; int goff;
    __device__ __forceinline__ void operator()(const f32x4 (&acc)[2][2][4][2], const Unit& u, int wr, int wc, int fr, int fq) const {
        const unsigned row0 = u.pm * 256 + wr * 64 + fr, col0 = u.pn * 256 + wc * 32 + 8 * fq;
        u32x2 gi[8][2]; u32x4 oi[8][2];
#pragma unroll
        for (int it = 0; it < 8 + LA; ++it) {
            if (it >= LA) { const int r = it - LA;
#pragma unroll
                for (int bj = 0; bj < 2; ++bj) { const u32x2 gw = gi[r][bj]; const u32x4 ow = oi[r][bj]; const f32x4 v0 = acc[r >> 2][bj][r & 3][0], v1 = acc[r >> 2][bj][r & 3][1]; float g[8], q[8];
#pragma unroll
                    for (int jj = 0; jj < 4; ++jj) { g[jj] = (float)((gw.x >> (8 * jj)) & 255u) * (1.f / 255.f); g[4 + jj] = (float)((gw.y >> (8 * jj)) & 255u) * (1.f / 255.f); }
                    q[0] = bflo(ow.x) + g[0] * v0[0]; q[1] = bfhi(ow.x) + g[1] * v0[1]; q[2] = bflo(ow.y) + g[2] * v0[2]; q[3] = bfhi(ow.y) + g[3] * v0[3];
                    q[4] = bflo(ow.z) + g[4] * v1[0]; q[5] = bfhi(ow.z) + g[5] * v1[1]; q[6] = bflo(ow.w) + g[6] * v1[2]; q[7] = bfhi(ow.w) + g[7] * v1[3];
                    u32x4 w; w.x = pg8::cvt_pk_bf16(q[0], q[1]); w.y = pg8::cvt_pk_bf16(q[2], q[3]); w.z = pg8::cvt_pk_bf16(q[4], q[5]); w.w = pg8::cvt_pk_bf16(q[6], q[7]); oi[r][bj] = w; } }
            if (it < 8) { const unsigned row = row0 + (it >> 2) * 128 + (it & 3) * 16;
#pragma unroll
                for (int bj = 0; bj < 2; ++bj) { gi[it][bj] = *(const u32x2*)(GS + row * (unsigned)P_GS + goff + col0 + bj * 128); oi[it][bj] = (u32x4){0u, 0u, 0u, 0u}; if (!FIRST) oi[it][bj] = *(const u32x4*)(MG + row * (unsigned)DM + col0 + bj * 128); } }
            if (it >= LA) { const int r = it - LA; const unsigned row = row0 + (r >> 2) * 128 + (r & 3) * 16;
#pragma unroll
                for (int bj = 0; bj < 2; ++bj) *(u32x4*)(MG + row * (unsigned)DM + col0 + bj * 128) = oi[r][bj]; }
        }
    }
};
struct EpiMerge3 {
    static constexpr bool PERM = true;
    bf16* MG; const unsigned char* GS;
    __device__ __forceinline__ void operator()(f32x4 (&acc)[2][2][4][2], const Unit& u, int seg, int wr, int wc, int fr, int fq) const {
        const unsigned row0 = u.pm * 256 + wr * 64 + fr, col0 = u.pn * 256 + wc * 32 + 8 * fq;
        if (seg < 2) { const unsigned go = (unsigned)seg * 1024u + col0;
#pragma unroll
            for (int r = 0; r < 8; ++r) { const unsigned row = row0 + (r >> 2) * 128 + (r & 3) * 16;
#pragma unroll
                for (int bj = 0; bj < 2; ++bj) { const u32x2 ga = *(const u32x2*)(GS + row * (unsigned)P_GS + go + bj * 128), gb = *(const u32x2*)(GS + row * (unsigned)P_GS + go + 1024 + bj * 128);
#pragma unroll
                    for (int jj = 0; jj < 4; ++jj) {
                        acc[r >> 2][bj][r & 3][0][jj] *= (float)((ga.x >> (8 * jj)) & 255u) * __builtin_amdgcn_rcpf((float)((gb.x >> (8 * jj)) & 255u));
                        acc[r >> 2][bj][r & 3][1][jj] *= (float)((ga.y >> (8 * jj)) & 255u) * __builtin_amdgcn_rcpf((float)((gb.y >> (8 * jj)) & 255u)); } } }
        } else {
#pragma unroll
            for (int r = 0; r < 8; ++r) { const unsigned row = row0 + (r >> 2) * 128 + (r & 3) * 16;
#pragma unroll
                for (int bj = 0; bj < 2; ++bj) { const u32x2 gw = *(const u32x2*)(GS + row * (unsigned)P_GS + 2048 + col0 + bj * 128); const f32x4 v0 = acc[r >> 2][bj][r & 3][0], v1 = acc[r >> 2][bj][r & 3][1]; float q[8];
#pragma unroll
                    for (int jj = 0; jj < 4; ++jj) { q[jj] = v0[jj] * ((float)((gw.x >> (8 * jj)) & 255u) * (1.f / 255.f)); q[4 + jj] = v1[jj] * ((float)((gw.y >> (8 * jj)) & 255u) * (1.f / 255.f)); }
                    u32x4 w; w.x = pg8::cvt_pk_bf16(q[0], q[1]); w.y = pg8::cvt_pk_bf16(q[2], q[3]); w.z = pg8::cvt_pk_bf16(q[4], q[5]); w.w = pg8::cvt_pk_bf16(q[6], q[7]);
                    *(u32x4*)(MG + row * (unsigned)DM + col0 + bj * 128) = w; } }
        }
    }
};
struct EpiPle {
    static constexpr bool PERM = true;
    static constexpr int LA = 3;
    const bf16* XI; const bf16* PP; RsTab SS; bf16* XO; float* SSo;
    __device__ __forceinline__ void operator()(const f32x4 (&acc)[2][2][4][2], const Unit& u, int wr, int wc, int fr, int fq) const {
        const unsigned row0 = u.pm * 256 + wr * 64 + fr, col0 = u.pn * 256 + wc * 32 + 8 * fq;
        u32x4 xi[8][2], pi[8][2];
#pragma unroll
        for (int it = 0; it < 8 + LA; ++it) {
            if (it < 8) { const unsigned off = (row0 + (it >> 2) * 128 + (it & 3) * 16) * (unsigned)DM + col0;
#pragma unroll
                for (int bj = 0; bj < 2; ++bj) { pi[it][bj] = *(const u32x4*)(PP + off + bj * 128); xi[it][bj] = *(const u32x4*)(XI + off + bj * 128); } }
            if (it >= LA) { const int r = it - LA; const unsigned row = row0 + (r >> 2) * 128 + (r & 3) * 16; const float rs = rs_get(SS, (int)row); float ssq = 0.f;
#pragma unroll
                for (int bj = 0; bj < 2; ++bj) { const unsigned off = row * (unsigned)DM + col0 + bj * 128; const u32x4 pw = pi[r][bj], w = xi[r][bj];
                    const f32x4 v0 = acc[r >> 2][bj][r & 3][0] * rs, v1 = acc[r >> 2][bj][r & 3][1] * rs; f32x4 x0, x1;
                    x0[0] = pg8::f16lo(w.x) + sigmoidf_(v0[0]) * bflo(pw.x); x0[1] = pg8::f16hi(w.x) + sigmoidf_(v0[1]) * bfhi(pw.x); x0[2] = pg8::f16lo(w.y) + sigmoidf_(v0[2]) * bflo(pw.y); x0[3] = pg8::f16hi(w.y) + sigmoidf_(v0[3]) * bfhi(pw.y);
                    x1[0] = pg8::f16lo(w.z) + sigmoidf_(v1[0]) * bflo(pw.z); x1[1] = pg8::f16hi(w.z) + sigmoidf_(v1[1]) * bfhi(pw.z); x1[2] = pg8::f16lo(w.w) + sigmoidf_(v1[2]) * bflo(pw.w); x1[3] = pg8::f16hi(w.w) + sigmoidf_(v1[3]) * bfhi(pw.w);
                    ssq += ((x0[0] * x0[0] + x0[1] * x0[1]) + (x0[2] * x0[2] + x0[3] * x0[3])) + ((x1[0] * x1[0] + x1[1] * x1[1]) + (x1[2] * x1[2] + x1[3] * x1[3]));
                    u32x4 o; o.x = pg8::cvt_pk_f16(x0[0], x0[1]); o.y = pg8::cvt_pk_f16(x0[2], x0[3]); o.z = pg8::cvt_pk_f16(x1[0], x1[1]); o.w = pg8::cvt_pk_f16(x1[2], x1[3]);
                    *(u32x4*)(XO + off) = o; }
                ssq += __shfl_xor(ssq, 16); ssq += __shfl_xor(ssq, 32);
                if (fq == 0) SSo[row * 16u + u.pn * 4 + wc] = ssq; }
        }
    }
};

template <int MAP> __device__ __forceinline__ int wmap(int n) {
    if (MAP == 0) return n;
    if (MAP == 1) { const int t = n >> 8, c = n & 255; return (c < 128) ? 128 * t + c : DFF + 128 * t + (c - 128); }
    if (MAP == 2) {
        if (n < 2304) { const int p = n & 63; if (n < 1536 && p < 16) return (n - p) + (p >> 1) + 8 * (p & 1); return n; }
        if (n < 2688) return O_CQ + (n - 2304);
        if (n < 2944) return O_CKV + (n - 2688);
        if (n < 3008) { const int p = n - 2944; return O_CKR + (p >> 1) + 32 * (p & 1); }
        return -1; }
    if (MAP == 3) return O_B + n;
    if (MAP == 4) return O_G + n;
    if (MAP == 5) { if (n >= 1152) return -1; const int h = n / 192, d = n % 192; if (d < 128) return n; const int p = d - 128; return 192 * h + 128 + (p >> 1) + 32 * (p & 1); }
    return n;
}
template <int MAP, bool F16 = false> __device__ __forceinline__ void wt_item(const float* W, int K, int Nsrc, int Ndst, bf16* WT, LAS float* scr, int item, int lane, const float* gain = nullptr) {
    const int nblk = Ndst / 32, kb = item / nblk, nb = item % nblk, k0 = 64 * kb, n0 = 32 * nb;
    const int sc = wmap<MAP>(n0 + (lane & 31));
#pragma unroll 8
    for (int i = 0; i < 32; ++i) { const int kk = 2 * i + (lane >> 5); const float gk = gain ? gain[k0 + kk] : 1.f; scr[kk * 33 + (lane & 31)] = (sc >= 0) ? W[(size_t)(k0 + kk) * Nsrc + sc] * gk : 0.f; }
    LDS_WAIT(); asm volatile("" ::: "memory");
    const int c = lane & 7;
#pragma unroll
    for (int j = 0; j < 4; ++j) { const int n = (lane >> 3) + 8 * j; const LAS float* s = scr + (8 * c) * 33 + n;
        u32x4 o;
        if (F16) { o.x = pg8::cvt_pk_f16(s[0 * 33], s[1 * 33]); o.y = pg8::cvt_pk_f16(s[2 * 33], s[3 * 33]); o.z = pg8::cvt_pk_f16(s[4 * 33], s[5 * 33]); o.w = pg8::cvt_pk_f16(s[6 * 33], s[7 * 33]); }
        else { o.x = pk2(s[0 * 33], s[1 * 33]); o.y = pk2(s[2 * 33], s[3 * 33]); o.z = pk2(s[4 * 33], s[5 * 33]); o.w = pk2(s[6 * 33], s[7 * 33]); }
        *(GAS u32x4*)(WT + (size_t)(n0 + n) * K + k0 + 8 * c) = o; }
    LDS_WAIT(); asm volatile("" ::: "memory");
}

__device__ __forceinline__ void rms_row_to_bf16(const float* xrow, const float* gain, bf16* orow, int lane) {
    const GAS f32x4* xr = (const GAS f32x4*)xrow + lane; const GAS f32x4* gr = (const GAS f32x4*)gain + lane;
    f32x4 v[4]; float s = 0.f;
#pragma unroll
    for (int j = 0; j < 4; ++j) { v[j] = xr[64 * j]; s += (v[j].x * v[j].x + v[j].y * v[j].y) + (v[j].z * v[j].z + v[j].w * v[j].w); }
    const float rstd = 1.f / sqrtf(wave_sum(s) * (1.f / DM) + EPS);
    GAS unsigned long long* o8 = (GAS unsigned long long*)orow + lane;
#pragma unroll
    for (int j = 0; j < 4; ++j) { const f32x4 g = gr[64 * j]; o8[64 * j] = (unsigned long long)pk2(v[j].x * rstd * g.x, v[j].y * rstd * g.y) | ((unsigned long long)pk2(v[j].z * rstd * g.z, v[j].w * rstd * g.w) << 32); }
}


typedef short s16x4 __attribute__((ext_vector_type(4)));
typedef short bf16x8 __attribute__((ext_vector_type(8)));
typedef float f32x16 __attribute__((ext_vector_type(16)));
__device__ __forceinline__ s16x4 vtr(const LAS unsigned char* p) { return __builtin_amdgcn_ds_read_tr16_b64_v4i16((LAS s16x4*)p); }
__device__ __forceinline__ int crow(int reg, int hf) { return (reg & 3) + 8 * (reg >> 2) + 4 * hf; }
__device__ __forceinline__ bf16x8 pack8(const f32x16& s, int o) {
    u32x4 w; w.x = pg8::cvt_pk_bf16(s[o], s[o + 1]); w.y = pg8::cvt_pk_bf16(s[o + 2], s[o + 3]); w.z = pg8::cvt_pk_bf16(s[o + 4], s[o + 5]); w.w = pg8::cvt_pk_bf16(s[o + 6], s[o + 7]); return __builtin_bit_cast(bf16x8, w);
}
#define MFMA32(a, b, c) __builtin_amdgcn_mfma_f32_32x32x16_bf16((a), (b), (c), 0, 0, 0)

__device__ __forceinline__ void mla_phase(LAS unsigned char* lds, const bf16* QC, const bf16* KVC, const bf16* CLR, bf16* CO, int vcu, int G, int tid, int lane, int wave) {
    constexpr int KP = 400, VP = 320, KB = 64 * KP, VB = 64 * VP; constexpr float MLA_THR = 8.f;
    LAS unsigned char* Kl = lds; LAS unsigned char* Vl = lds + 2 * KB;
    static_assert(2 * KB + 3 * VB <= PHASE_LDS, "mla LDS map");
    const int r = lane & 31, hf = lane >> 5; const bool trail = wave >= 4;
#define MLA_OFFS int t_o = tid; asm volatile("" : "+v"(t_o)); const int srow = t_o >> 4, sch = t_o & 15, prow = t_o >> 3, pch = t_o & 7; \
    const int noff = srow * P_KVC + sch * 8, poff = prow * P_CLR + pch * 8, kd0 = srow * KP + sch * 16, vd0 = srow * VP + sch * 16, pd0 = prow * KP + 256 + pch * 16; (void)noff; (void)poff; (void)kd0; (void)vd0; (void)pd0;
    for (int pi = vcu; pi < 768; pi += G) {
        const int bh = pi >> 3, sft = pi & 7, b = bh / 6, h = bh - 6 * b; const size_t rb = (size_t)b * SEQ;
        const bf16* kvb = KVC + rb * P_KVC + h * 256; const bf16* clb = CLR + rb * P_CLR + CLR_KR;
        for (int half = 0; half < 2; ++half) {
            const int qb = half ? 15 - sft : sft, q0w = qb * 256 + wave * 32, NT = 4 * (qb + 1);
            bf16x8 qf[12];
            { const bf16* qp = QC + (rb + q0w + r) * P_QC + h * 192 + 8 * hf;
#pragma unroll
              for (int s = 0; s < 12; ++s) qf[s] = *(const bf16x8*)(qp + 16 * s); }
            float m_ref = 0.f, l_run = 0.f; f32x16 OT[4];
#pragma unroll
            for (int d = 0; d < 4; ++d)
#pragma unroll
                for (int e = 0; e < 16; ++e) OT[d][e] = 0.f;
            u32x4 kr[3], vr[2];
            bf16x8 p00, p01, p10, p11; bool pact = false;
#pragma unroll
            for (int e = 0; e < 8; ++e) { p00[e] = 0; p01[e] = 0; p10[e] = 0; p11[e] = 0; }
#define MLA_LOAD(t) do { MLA_OFFS const bf16* kt_ = kvb + (size_t)(t) * (64 * P_KVC) + noff; kr[0] = *(const u32x4*)(kt_); kr[1] = *(const u32x4*)(kt_ + 32 * P_KVC); vr[0] = *(const u32x4*)(kt_ + 128); vr[1] = *(const u32x4*)(kt_ + 32 * P_KVC + 128); \
                         kr[2] = *(const u32x4*)(clb + (size_t)(t) * (64 * P_CLR) + poff); } while (0)
#define MLA_STORE(kb_, vb_) do { MLA_OFFS *(LAS u32x4*)(Kl + (kb_) * KB + kd0) = kr[0]; *(LAS u32x4*)(Kl + (kb_) * KB + kd0 + 32 * KP) = kr[1]; *(LAS u32x4*)(Kl + (kb_) * KB + pd0) = kr[2]; \
                          *(LAS u32x4*)(Vl + (vb_) * VB + vd0) = vr[0]; *(LAS u32x4*)(Vl + (vb_) * VB + vd0 + 32 * VP) = vr[1]; } while (0)
#define MLA_PV(Vbuf) do { const LAS unsigned char* vp = (Vbuf) + (((lane & 15) >> 2) + 4 * hf) * VP + (16 * ((lane >> 4) & 1) + 4 * (lane & 3)) * 2; \
                _Pragma("unroll") for (int h_ = 0; h_ < 8; ++h_) { s16x4 vl_[2], vh_[2]; \
                    _Pragma("unroll") for (int q2 = 0; q2 < 2; ++q2) { vl_[q2] = vtr(vp + (16 * (2 * (h_ & 1) + q2)) * VP + 64 * (h_ >> 1)); vh_[q2] = vtr(vp + (16 * (2 * (h_ & 1) + q2) + 8) * VP + 64 * (h_ >> 1)); } \
                    const bf16x8 f0_ = {vl_[0][0], vl_[0][1], vl_[0][2], vl_[0][3], vh_[0][0], vh_[0][1], vh_[0][2], vh_[0][3]}, f1_ = {vl_[1][0], vl_[1][1], vl_[1][2], vl_[1][3], vh_[1][0], vh_[1][1], vh_[1][2], vh_[1][3]}; \
                    if (h_ & 1) { OT[h_ >> 1] = MFMA32(f0_, p10, OT[h_ >> 1]); OT[h_ >> 1] = MFMA32(f1_, p11, OT[h_ >> 1]); } else { OT[h_ >> 1] = MFMA32(f0_, p00, OT[h_ >> 1]); OT[h_ >> 1] = MFMA32(f1_, p01, OT[h_ >> 1]); } } } while (0)
            MLA_LOAD(0); MLA_STORE(0, 0); __syncthreads();
            int v3 = 0;
            for (int t = 0; t < NT; ++t) {
                const LAS unsigned char* Kb = Kl + (t & 1) * KB; const LAS unsigned char* Vb = Vl + v3 * VB; const int vprev = (v3 == 0) ? 2 : v3 - 1, vnext = (v3 == 2) ? 0 : v3 + 1;
                if (t + 1 < NT) MLA_LOAD(t + 1);
                if (trail && pact) MLA_PV(Vl + vprev * VB);
                const int kbase = 64 * t; const bool act = kbase <= q0w + 31;
                f32x16 s0, s1;
                if (act) {
#pragma unroll
                    for (int e = 0; e < 16; ++e) { s0[e] = -m_ref; s1[e] = -m_ref; }
                    const LAS unsigned char* kp = Kb + r * KP + hf * 16;
                    bf16x8 kf[2][2];
#define MLA_KRD(g, B) do { kf[B][0] = *(const LAS bf16x8*)(kp + (g) * 32); kf[B][1] = *(const LAS bf16x8*)(kp + 32 * KP + (g) * 32); } while (0)
                    MLA_KRD(0, 0);
#pragma unroll
                    for (int g = 0; g < 12; ++g) {
                        if (g + 1 < 12) { if (g & 1) MLA_KRD(g + 1, 0); else MLA_KRD(g + 1, 1); }
                        __builtin_amdgcn_sched_barrier(0);
                        s0 = MFMA32(kf[g & 1][0], qf[g], s0); s1 = MFMA32(kf[g & 1][1], qf[g], s1);
                        __builtin_amdgcn_sched_barrier(0);
                    }
#undef MLA_KRD
                }
                if (act) {
                    if (kbase + 63 > q0w) { const int qq = q0w + r - kbase;
#pragma unroll
                        for (int e = 0; e < 16; ++e) { const int kk = crow(e, hf); if (kk > qq) s0[e] = -1e30f; if (kk + 32 > qq) s1[e] = -1e30f; } }
                    float tm = s0[0];
#pragma unroll
                    for (int e = 1; e < 16; ++e) tm = fmaxf(tm, s0[e]);
#pragma unroll
                    for (int e = 0; e < 16; ++e) tm = fmaxf(tm, s1[e]);
                    tm = fmaxf(tm, __shfl_xor(tm, 32));
                    if (t == 0 || __any(tm > MLA_THR)) {
                        const bool mv = (t == 0) || (tm > MLA_THR);
                        const float mnew = m_ref + tm;
                        const float dl = mv ? mnew - m_ref : 0.f; m_ref += dl;
#pragma unroll
                        for (int e = 0; e < 16; ++e) { s0[e] -= dl; s1[e] -= dl; }
                        if (t > 0) { const float al = __builtin_amdgcn_exp2f(-dl); l_run *= al;
#pragma unroll
                            for (int d = 0; d < 4; ++d)
#pragma unroll
                                for (int e = 0; e < 16; ++e) OT[d][e] *= al; }
                    }
                    float ls = 0.f;
#pragma unroll
                    for (int e = 0; e < 16; ++e) { s0[e] = __builtin_amdgcn_exp2f(s0[e]); s1[e] = __builtin_amdgcn_exp2f(s1[e]); ls += s0[e] + s1[e]; }
                    l_run += ls;
                    p00 = pack8(s0, 0); p01 = pack8(s0, 8); p10 = pack8(s1, 0); p11 = pack8(s1, 8);
                    if (!trail) MLA_PV(Vb);
                }
                pact = act;
                if (t + 1 < NT) MLA_STORE((t + 1) & 1, vnext);
                v3 = vnext;
                __syncthreads();
            }
            if (trail && pact) MLA_PV(Vl + ((v3 == 0) ? 2 : v3 - 1) * VB);
#undef MLA_LOAD
#undef MLA_STORE
#undef MLA_PV
            l_run += __shfl_xor(l_run, 32);
            const float il = 1.f / l_run;
            bf16* op = CO + (rb + q0w + r) * 768 + h * 128 + 4 * hf;
#pragma unroll
            for (int d = 0; d < 4; ++d)
#pragma unroll
                for (int g4 = 0; g4 < 4; ++g4) { u32x2 w; w.x = pg8::cvt_pk_bf16(OT[d][4 * g4] * il, OT[d][4 * g4 + 1] * il); w.y = pg8::cvt_pk_bf16(OT[d][4 * g4 + 2] * il, OT[d][4 * g4 + 3] * il); *(u32x2*)(op + 32 * d + 8 * g4) = w; }
            __syncthreads();
        }
    }
}
#undef MLA_OFFS
__device__ __forceinline__ void dwa_phase(LAS unsigned char* lds, const bf16* QKVA, bf16* AOG, float* LSE, int vcu, int G, int tid, int lane, int wave) {
    constexpr int KP = 144, VP = 128, KBY = 384 * KP;
    LAS unsigned char* Kl = lds; LAS unsigned char* Vl = lds + KBY;
    const int r = lane & 31, hf = lane >> 5;
    for (int u = vcu * 12; u < vcu * 12 + 12 && u < 3072; ++u) {
        const int v16 = u & 15, hh = (u >> 4) & 3, bg = u >> 6, g = bg % 3, b = bg / 3;
        const int dil = (g == 0) ? 1 : (g == 1) ? 4 : 16, res = (g == 0) ? 0 : (g == 1) ? (v16 >> 2) : v16, qb = (g == 0) ? v16 : (g == 1) ? (v16 & 3) : 0;
        const int head = 4 * g + hh; const size_t rb = (size_t)b * SEQ; const int j0 = 256 * qb - 128;
        const bf16* kb_ = QKVA + rb * P_QKVA + 768 + head * 64; const bf16* vb_ = QKVA + rb * P_QKVA + 1536 + head * 64;
        u32x4 kr[6], vr[6];
#pragma unroll
        for (int i = 0; i < 6; ++i) { const int c = tid + 512 * i, jw = c >> 3, ch = c & 7, jj = j0 + jw; const bool ok = jj >= 0; const size_t off = (size_t)(ok ? jj * dil + res : 0) * P_QKVA + ch * 8;
            kr[i] = ok ? *(const u32x4*)(kb_ + off) : (u32x4){0u, 0u, 0u, 0u}; vr[i] = ok ? *(const u32x4*)(vb_ + off) : (u32x4){0u, 0u, 0u, 0u}; }
        const int jq0 = 256 * qb + 32 * wave;
        bf16x8 qf[4];
        { const bf16* qp = QKVA + (rb + (size_t)(jq0 + r) * dil + res) * P_QKVA + head * 64 + 8 * hf;
#pragma unroll
          for (int s = 0; s < 4; ++s) qf[s] = *(const bf16x8*)(qp + 16 * s); }
#pragma unroll
        for (int i = 0; i < 6; ++i) { const int c = tid + 512 * i, jw = c >> 3, ch = c & 7; *(LAS u32x4*)(Kl + jw * KP + ch * 16) = kr[i]; *(LAS u32x4*)(Vl + jw * VP + ch * 16) = vr[i]; }
        __syncthreads();
        f32x16 st[5];
        const LAS unsigned char* kp = Kl + (32 * wave + r) * KP + hf * 16;
#pragma unroll
        for (int c = 0; c < 5; ++c) {
#pragma unroll
            for (int e = 0; e < 16; ++e) st[c][e] = 0.f;
#pragma unroll
            for (int s = 0; s < 4; ++s) { const bf16x8 kf = *(const LAS bf16x8*)(kp + 32 * c * KP + s * 32); st[c] = MFMA32(kf, qf[s], st[c]); } }
        float tm = -1e30f;
#pragma unroll
        for (int c = 0; c < 5; ++c)
#pragma unroll
            for (int e = 0; e < 16; ++e) { const int kk = 32 * c + crow(e, hf); const int dj = r + 128 - kk; const bool ok = (dj >= 0) && (dj <= 128) && (jq0 - 128 + kk >= 0); st[c][e] = ok ? st[c][e] : -1e30f; tm = fmaxf(tm, st[c][e]); }
        tm = fmaxf(tm, __shfl_xor(tm, 32));
        float ls = 0.f;
#pragma unroll
        for (int c = 0; c < 5; ++c)
#pragma unroll
            for (int e = 0; e < 16; ++e) { st[c][e] = __builtin_amdgcn_exp2f(st[c][e] - tm); ls += st[c][e]; }
        ls += __shfl_xor(ls, 32);
        f32x16 OT[2];
#pragma unroll
        for (int d = 0; d < 2; ++d)
#pragma unroll
            for (int e = 0; e < 16; ++e) OT[d][e] = 0.f;
        const LAS unsigned char* vp = Vl + (32 * wave + ((lane & 15) >> 2) + 4 * hf) * VP + (16 * ((lane >> 4) & 1) + 4 * (lane & 3)) * 2;
#pragma unroll
        for (int c = 0; c < 5; ++c)
#pragma unroll
            for (int s2 = 0; s2 < 2; ++s2) { const bf16x8 pf = pack8(st[c], 8 * s2);
#pragma unroll
                for (int d = 0; d < 2; ++d) { const s16x4 lo = vtr(vp + (32 * c + 16 * s2) * VP + 64 * d), hi = vtr(vp + (32 * c + 16 * s2 + 8) * VP + 64 * d);
                    const bf16x8 vf = {lo[0], lo[1], lo[2], lo[3], hi[0], hi[1], hi[2], hi[3]}; OT[d] = MFMA32(vf, pf, OT[d]); } }
        const float il = 1.f / ls; const size_t orow = rb + (size_t)(jq0 + r) * dil + res;
        bf16* op = AOG + ((size_t)g * MTOK + orow) * 256 + hh * 64 + 4 * hf;
#pragma unroll
        for (int d = 0; d < 2; ++d)
#pragma unroll
            for (int g4 = 0; g4 < 4; ++g4) { u32x2 w; w.x = pg8::cvt_pk_bf16(OT[d][4 * g4] * il, OT[d][4 * g4 + 1] * il); w.y = pg8::cvt_pk_bf16(OT[d][4 * g4 + 2] * il, OT[d][4 * g4 + 3] * il); *(u32x2*)(op + 32 * d + 8 * g4) = w; }
        if (hf == 0) LSE[((size_t)g * MTOK + orow) * 4 + hh] = tm + __builtin_amdgcn_logf(ls);
        __syncthreads();
    }
}

__device__ __forceinline__ void hgrn_phase(LAS unsigned char* lds, bf16* BIN, bf16* BO, const float* lbw, const float* gn, float* SH, int vcu, int G, int tid, int lane, int wave) {
    constexpr int PQ = 272, PK = 80, PO = 400;
    constexpr int O_QT = 0, O_KT = 32 * PQ, O_QI = 2 * 32 * PQ, O_KE = 3 * 32 * PQ, O_VT = O_KE + 128 * PK, O_DEC = O_VT + 96 * PK, O_ST = O_DEC + 512, STB = 96 * PQ, O_OB = O_ST + 2 * STB, OBB = 32 * PO, PG = 208, O_GB = O_OB + 2 * OBB, GBB = 32 * PG;
    static_assert(O_GB + 2 * GBB <= PHASE_LDS, "hgrn LDS map");
    for (int unit = vcu; unit < BATCH * 8 * 2; unit += G) {
        const int chain = unit >> 1, half = unit & 1, b = chain >> 3, head = chain & 7, nbeg = half * (SEQ / 64);
        int lane_o = lane; asm volatile("" : "+v"(lane_o));
        const int dl0 = lane_o & 15, tseg0 = lane_o >> 4, d0 = 16 * wave + dl0, r0 = lane_o & 31, hf0 = lane_o >> 5;
        const float lb = lbw[head * 128 + d0], olb = 1.f - lb;
        bf16* cbase = BIN + (size_t)b * SEQ * P_BIN;
        const unsigned zqo = (unsigned)((8 * tseg0) * P_BIN + head * 128 + d0);
        const unsigned vo0 = (unsigned)((tid >> 4) * P_BIN + 2048 + head * 96 + (tid & 15));
        const unsigned vl0 = (unsigned)((tid & 15) * PK + (tid >> 4) * 2);
        const unsigned gso = (unsigned)((tid / 12) * P_BIN + 2816 + head * 96 + (tid % 12) * 8);
        const unsigned gl0 = (unsigned)((tid / 12) * PG + (tid % 12) * 16);
        float run = 0.f;
        f32x16 Sv[3];
#pragma unroll
        for (int i = 0; i < 3; ++i)
#pragma unroll
            for (int e = 0; e < 16; ++e) Sv[i][e] = 0.f;
        for (int i = tid; i < STB / 4; i += 512) ((LAS unsigned*)(lds + O_ST))[i] = 0u;
        unsigned zrA[8], qrA[8], vrA[6], zrB[8], qrB[8], vrB[6];
        u32x4 ggA = (u32x4){0u, 0u, 0u, 0u}, ggB = (u32x4){0u, 0u, 0u, 0u};
        const f32x4 gna = *(const f32x4*)(gn + (tid % 12) * 8), gnb = *(const f32x4*)(gn + (tid % 12) * 8 + 4);
#define HG_LOAD(n, zr, qr, vr) do { const bf16* p_ = cbase + (size_t)(n) * 32 * P_BIN; _Pragma("unroll") for (int i = 0; i < 8; ++i) { qr[i] = p_[zqo + (unsigned)(i * P_BIN)]; zr[i] = p_[zqo + (unsigned)(i * P_BIN + 1024)]; } \
                        _Pragma("unroll") for (int k = 0; k < 6; ++k) vr[k] = p_[vo0 + 16u * k]; } while (0)
#define HG_LOADG(n, gg) do { if (half == 0 && tid < 384) gg = *(const u32x4*)(cbase + (size_t)(n) * 32 * P_BIN + gso); } while (0)
#define HG_GNORM(c) do { const LAS unsigned char* ob_ = lds + O_OB + ((c) & 1) * OBB + r * PO + hf * 192; const LAS unsigned char* gb_ = lds + O_GB + ((c) & 1) * GBB + r * PG + hf * 96; \
            float ss_ = 0.f; _Pragma("unroll") for (int i = 0; i < 12; ++i) { const f32x4 o_ = *(const LAS f32x4*)(ob_ + 16 * i); ss_ += (o_[0] * o_[0] + o_[1] * o_[1]) + (o_[2] * o_[2] + o_[3] * o_[3]); } \
            ss_ += __shfl_xor(ss_, 32); const float rs_ = 1.f / sqrtf(ss_ * (1.f / 96.f) + EPS); \
            asm volatile("" ::: "memory");     \
            bf16* op_ = BO + ((size_t)b * SEQ + (size_t)(c) * 32 + r) * 768 + head * 96 + 48 * hf; \
            _Pragma("unroll") for (int i = 0; i < 6; ++i) { const u32x4 gw_ = *(const LAS u32x4*)(gb_ + 16 * i); \
                const f32x4 oa_ = *(const LAS f32x4*)(ob_ + 32 * i), ob2_ = *(const LAS f32x4*)(ob_ + 32 * i + 16); \
                u32x4 w_; w_.x = pg8::cvt_pk_bf16(oa_[0] * rs_ * bflo(gw_.x), oa_[1] * rs_ * bfhi(gw_.x)); w_.y = pg8::cvt_pk_bf16(oa_[2] * rs_ * bflo(gw_.y), oa_[3] * rs_ * bfhi(gw_.y)); \
                w_.z = pg8::cvt_pk_bf16(ob2_[0] * rs_ * bflo(gw_.z), ob2_[1] * rs_ * bfhi(gw_.z)); w_.w = pg8::cvt_pk_bf16(ob2_[2] * rs_ * bflo(gw_.w), ob2_[3] * rs_ * bfhi(gw_.w)); \
                *(u32x4*)(op_ + 8 * i) = w_; } } while (0)
#define HG_RAW(c) do { const LAS unsigned char* ob_ = lds + O_OB + ((c) & 1) * OBB + r * PO + hf * 192; bf16* op_ = BO + ((size_t)b * SEQ + (size_t)(c) * 32 + r) * 768 + head * 96 + 48 * hf; \
            _Pragma("unroll") for (int i = 0; i < 6; ++i) { const f32x4 oa_ = *(const LAS f32x4*)(ob_ + 32 * i), ob2_ = *(const LAS f32x4*)(ob_ + 32 * i + 16); \
                u32x4 w_; w_.x = pg8::cvt_pk_bf16(oa_[0], oa_[1]); w_.y = pg8::cvt_pk_bf16(oa_[2], oa_[3]); w_.z = pg8::cvt_pk_bf16(ob2_[0], ob2_[1]); w_.w = pg8::cvt_pk_bf16(ob2_[2], ob2_[3]); *(u32x4*)(op_ + 8 * i) = w_; } } while (0)
#define HG_STEP(n, zr, qr, vr, gg) do { \
            int ln_ = lane; asm volatile("" : "+v"(ln_));     \
            const int r = ln_ & 31, hf = ln_ >> 5, dl = ln_ & 15, tseg = ln_ >> 4, d = 16 * wave + dl; (void)r; (void)hf; \
            _Pragma("unroll") for (int i = 0; i < 8; ++i) asm volatile("" : "+v"(zr[i]), "+v"(qr[i]));     \
            _Pragma("unroll") for (int k = 0; k < 6; ++k) asm volatile("" : "+v"(vr[k])); \
            float lf[8], kk[8], qv[8]; \
            _Pragma("unroll") for (int i = 0; i < 8; ++i) { const float z = __builtin_bit_cast(float, zr[i] << 16); const float sg = sigmoidf_(z); const float f = lb + olb * sg; kk[i] = olb * (1.f - sg); lf[i] = __builtin_amdgcn_logf(f); qv[i] = __builtin_bit_cast(float, qr[i] << 16); } \
            _Pragma("unroll") for (int i = 1; i < 8; ++i) lf[i] += lf[i - 1]; \
            const float T = lf[7]; \
            const float T0 = __shfl(T, dl), T1 = __shfl(T, dl + 16), T2 = __shfl(T, dl + 32), T3 = __shfl(T, dl + 48); \
            const float ref = T0 + T1, total = ref + T2 + T3; \
            const float pre = (tseg == 0) ? 0.f : (tseg == 1) ? T0 : (tseg == 2) ? ref : ref + T2; \
            const float eref = __builtin_amdgcn_exp2f(ref), etr = __builtin_amdgcn_exp2f(total - ref); \
            unsigned kew[4]; const float erun = half ? __builtin_amdgcn_exp2f(run) * eref : 0.f; \
            _Pragma("unroll") for (int i = 0; i < 8; i += 2) { const float e1a = __builtin_amdgcn_exp2f(pre + lf[i] - ref), e1b = __builtin_amdgcn_exp2f(pre + lf[i + 1] - ref); const float r1a = __builtin_amdgcn_rcpf(e1a), r1b = __builtin_amdgcn_rcpf(e1b); \
                const float qta = qv[i] * e1a, qtb = qv[i + 1] * e1b, kta = kk[i] * r1a, ktb = kk[i + 1] * r1b; \
                const unsigned wq = pg8::cvt_pk_bf16(qta, qtb), wk = pg8::cvt_pk_bf16(kta, ktb), wi = pg8::cvt_pk_bf16(qta * eref, qtb * eref); kew[i >> 1] = pg8::cvt_pk_bf16(kta * etr, ktb * etr); \
                const int t = 8 * tseg + i; \
                if (half) { bf16* qd_ = cbase + (size_t)(n) * 32 * P_BIN + (zqo + (unsigned)(i * P_BIN)); const unsigned wd_ = pg8::cvt_pk_bf16(qta * erun, qtb * erun); qd_[0] = (bf16)(wd_ & 0xffffu); qd_[P_BIN] = (bf16)(wd_ >> 16); } \
                *(LAS bf16*)(lds + O_QT + t * PQ + d * 2) = (bf16)(wq & 0xffffu); *(LAS bf16*)(lds + O_QT + (t + 1) * PQ + d * 2) = (bf16)(wq >> 16); \
                *(LAS bf16*)(lds + O_KT + t * PQ + d * 2) = (bf16)(wk & 0xffffu); *(LAS bf16*)(lds + O_KT + (t + 1) * PQ + d * 2) = (bf16)(wk >> 16); \
                *(LAS bf16*)(lds + O_QI + t * PQ + d * 2) = (bf16)(wi & 0xffffu); *(LAS bf16*)(lds + O_QI + (t + 1) * PQ + d * 2) = (bf16)(wi >> 16); } \
            *(LAS u32x4*)(lds + O_KE + d * PK + tseg * 16) = (u32x4){kew[0], kew[1], kew[2], kew[3]}; \
            if (tseg == 0) *(LAS float*)(lds + O_DEC + d * 4) = __builtin_amdgcn_exp2f(total); \
            run += total; \
            _Pragma("unroll") for (int k = 0; k < 6; ++k) *(LAS bf16*)(lds + O_VT + vl0 + 16 * PK * k) = (bf16)vr[k]; \
            if (half == 0 && tid < 384) { const float g0_ = bflo(gg.x), g1_ = bfhi(gg.x), g2_ = bflo(gg.y), g3_ = bfhi(gg.y), g4_ = bflo(gg.z), g5_ = bfhi(gg.z), g6_ = bflo(gg.w), g7_ = bfhi(gg.w); u32x4 sw_; \
                sw_.x = pg8::cvt_pk_bf16(gna[0] * g0_ * sigmoidf_(g0_), gna[1] * g1_ * sigmoidf_(g1_)); sw_.y = pg8::cvt_pk_bf16(gna[2] * g2_ * sigmoidf_(g2_), gna[3] * g3_ * sigmoidf_(g3_)); \
                sw_.z = pg8::cvt_pk_bf16(gnb[0] * g4_ * sigmoidf_(g4_), gnb[1] * g5_ * sigmoidf_(g5_)); sw_.w = pg8::cvt_pk_bf16(gnb[2] * g6_ * sigmoidf_(g6_), gnb[3] * g7_ * sigmoidf_(g7_)); \
                *(LAS u32x4*)(lds + O_GB + ((n) & 1) * GBB + gl0) = sw_; }     \
            __syncthreads(); \
            const LAS unsigned char* STc = lds + O_ST + ((n) & 1) * STB; LAS unsigned char* STn = lds + O_ST + (((n) + 1) & 1) * STB; \
            if (wave < 3) { \
                const int vb = wave; \
                  \
                bf16x8 fa[2][2], fb[2][2]; \
                const LAS unsigned char* ktp = lds + O_KT + r * PQ + hf * 16; const LAS unsigned char* qtp = lds + O_QT + r * PQ + hf * 16; \
                const LAS unsigned char* stp = STc + (32 * vb + r) * PQ + hf * 16; const LAS unsigned char* qip = lds + O_QI + r * PQ + hf * 16; \
                const LAS unsigned char* vp = lds + O_VT + (32 * vb + r) * PK + hf * 8; \
                const u32x2 a0 = *(const LAS u32x2*)(vp), a1 = *(const LAS u32x2*)(vp + 16), b0 = *(const LAS u32x2*)(vp + 32), b1 = *(const LAS u32x2*)(vp + 48); \
                fa[0][0] = *(const LAS bf16x8*)(ktp); fb[0][0] = *(const LAS bf16x8*)(qtp); fa[0][1] = *(const LAS bf16x8*)(ktp + 32); fb[0][1] = *(const LAS bf16x8*)(qtp + 32); \
                f32x16 at, ot; \
                _Pragma("unroll") for (int e = 0; e < 16; ++e) { at[e] = 0.f; ot[e] = 0.f; } \
                bf16x8 pa0, pa1; \
                _Pragma("unroll") for (int g = 0; g < 8; ++g) { \
                    if (g + 1 < 8) { const int n_ = g + 1, B_ = n_ & 1; const LAS unsigned char* pa_ = (n_ < 4) ? ktp + n_ * 64 : stp + (n_ - 4) * 64; const LAS unsigned char* pb_ = (n_ < 4) ? qtp + n_ * 64 : qip + (n_ - 4) * 64; \
                        fa[B_][0] = *(const LAS bf16x8*)(pa_); fb[B_][0] = *(const LAS bf16x8*)(pb_); fa[B_][1] = *(const LAS bf16x8*)(pa_ + 32); fb[B_][1] = *(const LAS bf16x8*)(pb_ + 32); } \
                    __builtin_amdgcn_sched_barrier(0); \
                    if (g < 4) { at = MFMA32(fa[g & 1][0], fb[g & 1][0], at); at = MFMA32(fa[g & 1][1], fb[g & 1][1], at); } \
                    else { ot = MFMA32(fa[g & 1][0], fb[g & 1][0], ot); ot = MFMA32(fa[g & 1][1], fb[g & 1][1], ot); } \
                    if (g == 3) { _Pragma("unroll") for (int e = 0; e < 16; ++e) at[e] = (crow(e, hf) <= r) ? at[e] : 0.f; pa0 = pack8(at, 0); pa1 = pack8(at, 8); } \
                    __builtin_amdgcn_sched_barrier(0); } \
                { const bf16x8 v0 = __builtin_bit_cast(bf16x8, (u32x4){a0.x, a0.y, a1.x, a1.y}), v1 = __builtin_bit_cast(bf16x8, (u32x4){b0.x, b0.y, b1.x, b1.y}); \
                  ot = MFMA32(v0, pa0, ot); ot = MFMA32(v1, pa1, ot); } \
                LAS unsigned char* obw = lds + O_OB + ((n) & 1) * OBB + r * PO + (32 * vb + 4 * hf) * 4; \
                _Pragma("unroll") for (int g4 = 0; g4 < 4; ++g4) *(LAS f32x4*)(obw + 32 * g4) = (f32x4){ot[4 * g4], ot[4 * g4 + 1], ot[4 * g4 + 2], ot[4 * g4 + 3]}; \
            } else if (wave == 3) { \
                if ((n) > nbeg) { if (half) HG_RAW((n) - 1); else HG_GNORM((n) - 1); } \
            } else { \
                const int db = wave - 4; \
                float dec[16]; \
                _Pragma("unroll") for (int g4 = 0; g4 < 4; ++g4) { const f32x4 dv = *(const LAS f32x4*)(lds + O_DEC + (32 * db + 8 * g4 + 4 * hf) * 4); dec[4 * g4] = dv[0]; dec[4 * g4 + 1] = dv[1]; dec[4 * g4 + 2] = dv[2]; dec[4 * g4 + 3] = dv[3]; } \
                const bf16x8 ke0 = *(const LAS bf16x8*)(lds + O_KE + (32 * db + r) * PK + hf * 16), ke1 = *(const LAS bf16x8*)(lds + O_KE + (32 * db + r) * PK + 32 + hf * 16); \
                _Pragma("unroll") for (int vb = 0; vb < 3; ++vb) { \
                    _Pragma("unroll") for (int e = 0; e < 16; ++e) Sv[vb][e] *= dec[e]; \
                    const bf16x8 v0 = *(const LAS bf16x8*)(lds + O_VT + (32 * vb + r) * PK + hf * 16), v1 = *(const LAS bf16x8*)(lds + O_VT + (32 * vb + r) * PK + 32 + hf * 16); \
                    Sv[vb] = MFMA32(ke0, v0, Sv[vb]); Sv[vb] = MFMA32(ke1, v1, Sv[vb]); \
                    _Pragma("unroll") for (int g4 = 0; g4 < 4; ++g4) { u32x2 w; w.x = pg8::cvt_pk_bf16(Sv[vb][4 * g4], Sv[vb][4 * g4 + 1]); w.y = pg8::cvt_pk_bf16(Sv[vb][4 * g4 + 2], Sv[vb][4 * g4 + 3]); \
                        *(LAS u32x2*)(STn + (32 * vb + r) * PQ + (32 * db + 8 * g4 + 4 * hf) * 2) = w; } } \
            } \
            __syncthreads(); } while (0)
        HG_LOAD(nbeg, zrA, qrA, vrA); HG_LOADG(nbeg, ggA);
        const int nend = nbeg + SEQ / 64;
#pragma unroll 1
        for (int n = nbeg; n < nend; ++n) {
            if (n + 1 < nend) { HG_LOAD(n + 1, zrB, qrB, vrB); HG_LOADG(n + 1, ggB); }
            HG_STEP(n, zrA, qrA, vrA, ggA);
            ggA = ggB;
#pragma unroll
            for (int i = 0; i < 8; ++i) { zrA[i] = zrB[i]; qrA[i] = qrB[i]; }
#pragma unroll
            for (int k = 0; k < 6; ++k) vrA[k] = vrB[k];
        }
        { const int r = r0, hf = hf0; if (wave == 3) { if (half) HG_RAW(nend - 1); else HG_GNORM(nend - 1); }
          if (half == 0 && wave >= 4) { const int db = wave - 4; float* sp = SH + (size_t)chain * (128 * 96);
#pragma unroll
              for (int vb = 0; vb < 3; ++vb)
#pragma unroll
                  for (int e = 0; e < 16; ++e) sp[(32 * db + crow(e, hf)) * 96 + 32 * vb + r] = Sv[vb][e]; } }
        __syncthreads();
#undef HG_LOAD
#undef HG_LOADG
#undef HG_STEP
#undef HG_GNORM
#undef HG_RAW
    }
}

__device__ __forceinline__ RsTab rs_preload(LAS unsigned char* lds, const float* SS, const pg8::StaticOrder& S, int tid) {
    LAS float* tab = (LAS float*)(lds + RS_OFF); pg8::Unit u; RsTab T; T.tab = tab; T.g0 = 0;
    if (!S.next(0, u)) return T;
    T.g0 = u.pm >> 3; int last = -1;
    for (int i = 0; S.next(i, u); ++i) { const int gid = u.pm >> 3; if (gid == last) continue; last = gid;
        if (tid < 256 && gid - T.g0 < RS_SLOTS) tab[((gid - T.g0) << 8) + tid] = row_rstd(SS, u.pm * 256 + tid); }
    __syncthreads();
    return T;
}

__device__ __forceinline__ void hgrn_fix_phase(LAS unsigned char* lds, const bf16* BIN, bf16* BO, const float* gn, const float* SH, int vcu, int G, int tid, int lane, int wave) {
    constexpr int PQ = 272;
    const int r = lane & 31, hf = lane >> 5;
    for (int unit = vcu; unit < BATCH * 8 * 2; unit += G) {
        const int chain = unit >> 1, sub = unit & 1, b = chain >> 3, head = chain & 7;
        __syncthreads();
        { const float* sp = SH + (size_t)chain * (128 * 96);
          for (int i = tid; i < 128 * 96; i += 512) { const int d = i / 96, v = i - 96 * d; *(LAS bf16*)(lds + v * PQ + d * 2) = (bf16)f2bf(sp[i]); } }
        __syncthreads();
        for (int j = 0; j < 4; ++j) {
            const int n = SEQ / 64 + 32 * sub + 4 * wave + j; const size_t row = (size_t)b * SEQ + (size_t)n * 32 + r;
            bf16x8 qd[8];
            { const bf16* qp = BIN + row * P_BIN + head * 128 + 8 * hf;
#pragma unroll
              for (int kd = 0; kd < 8; ++kd) qd[kd] = *(const bf16x8*)(qp + 16 * kd); }
            f32x16 ot[3]; float ss = 0.f;
            bf16* op = BO + row * 768 + head * 96 + 4 * hf; const bf16* gp = BIN + row * P_BIN + 2816 + head * 96 + 4 * hf;
#pragma unroll
            for (int vb = 0; vb < 3; ++vb) {
#pragma unroll
                for (int e = 0; e < 16; ++e) ot[vb][e] = 0.f;
#pragma unroll
                for (int kd = 0; kd < 8; ++kd) { const bf16x8 sf = *(const LAS bf16x8*)(lds + (32 * vb + r) * PQ + kd * 32 + hf * 16); ot[vb] = MFMA32(sf, qd[kd], ot[vb]); }
#pragma unroll
                for (int g4 = 0; g4 < 4; ++g4) { const u32x2 w = *(const u32x2*)(op + 32 * vb + 8 * g4); ot[vb][4 * g4] += bflo(w.x); ot[vb][4 * g4 + 1] += bfhi(w.x); ot[vb][4 * g4 + 2] += bflo(w.y); ot[vb][4 * g4 + 3] += bfhi(w.y); }
#pragma unroll
                for (int e = 0; e < 16; ++e) ss += ot[vb][e] * ot[vb][e]; }
            ss += __shfl_xor(ss, 32);
            const float rs = 1.f / sqrtf(ss * (1.f / 96.f) + EPS);
#pragma unroll
            for (int vb = 0; vb < 3; ++vb)
#pragma unroll
                for (int g4 = 0; g4 < 4; ++g4) { const u32x2 gw = *(const u32x2*)(gp + 32 * vb + 8 * g4); const f32x4 ga = *(const f32x4*)(gn + 32 * vb + 8 * g4 + 4 * hf);
                    const float g0 = bflo(gw.x), g1 = bfhi(gw.x), g2 = bflo(gw.y), g3 = bfhi(gw.y);
                    u32x2 w; w.x = pg8::cvt_pk_bf16(ot[vb][4 * g4] * rs * ga[0] * (g0 * sigmoidf_(g0)), ot[vb][4 * g4 + 1] * rs * ga[1] * (g1 * sigmoidf_(g1)));
                    w.y = pg8::cvt_pk_bf16(ot[vb][4 * g4 + 2] * rs * ga[2] * (g2 * sigmoidf_(g2)), ot[vb][4 * g4 + 3] * rs * ga[3] * (g3 * sigmoidf_(g3)));
                    *(u32x2*)(op + 32 * vb + 8 * g4) = w; }
        }
    }
}

typedef const unsigned char __attribute__((address_space(4)))* karg_ptr;
__device__ __forceinline__ const float* karg_in(int k) { karg_ptr kp = (karg_ptr)__builtin_amdgcn_kernarg_segment_ptr(); asm volatile("" : "+s"(kp)); return *(const float* const __attribute__((address_space(4)))*)(kp + 8 * k); }
__device__ __forceinline__ unsigned char* karg_ws() { karg_ptr kp = (karg_ptr)__builtin_amdgcn_kernarg_segment_ptr(); asm volatile("" : "+s"(kp)); return *(unsigned char* const __attribute__((address_space(4)))*)(kp + 200); }
__device__ __forceinline__ float* karg_out() { karg_ptr kp = (karg_ptr)__builtin_amdgcn_kernarg_segment_ptr(); asm volatile("" : "+s"(kp)); return *(float* const __attribute__((address_space(4)))*)(kp + 192); }
constexpr int NPH = 19, NPHASES = DEPTH * NPH + 1;
struct Args { const float* in[24]; float* out; unsigned char* ws; int ph_lo, ph_hi; };
static_assert(sizeof(Args) == 24 * 8 + 8 + 8 + 8, "Args has no padding");

__global__ void __launch_bounds__(512, 2) mk_fwd(Args args) {
    extern __shared__ __attribute__((aligned(16))) unsigned char lds_raw[];
    LAS unsigned char* lds = (LAS unsigned char*)lds_raw;
    volatile LAS unsigned* MISC = (volatile LAS unsigned*)(lds + MISC_OFF);
    const int tid0 = threadIdx.x, lane0 = tid0 & 63, wave0 = __builtin_amdgcn_readfirstlane(tid0 >> 6);
    const int G0 = gridDim.x, bx0 = blockIdx.x;
    const int vcu0 = (G0 % 8 == 0) ? (bx0 % 8) * (G0 / 8) + bx0 / 8 : bx0;
    const int gw0 = vcu0 * 8 + wave0, NGW0 = G0 * 8;
#define PH_LOCALS int z_ = 0; asm volatile("" : "+v"(z_)); int lane = (int)__builtin_amdgcn_mbcnt_hi(~0u, __builtin_amdgcn_mbcnt_lo(~0u, (unsigned)z_)), wave = wave0, tid = wave0 * 64 + lane, G = G0, bx = bx0, vcu = vcu0, gw = gw0, NGW = NGW0;   \
    asm volatile("" : "+v"(tid), "+v"(lane), "+s"(wave), "+s"(G), "+s"(bx), "+s"(vcu), "+s"(gw), "+s"(NGW)); (void)tid; (void)lane; (void)wave; (void)G; (void)bx; (void)vcu; (void)gw; (void)NGW;
    for (int u = tid0; u < (LDS_BYTES - LDSCTL_OFF) / 4; u += 512) ((LAS unsigned*)(lds + LDSCTL_OFF))[u] = 0u;
    __syncthreads();
    const int lo = args.ph_lo, hi = args.ph_hi;
    if (hi - lo > 1) (void)xcd_barrier_post((unsigned*)(karg_ws() + WS_CTL) + CW_BAR, MISC + 8);
#define IN(k) (lo <= (k) && (k) < hi)
#define INP(p) ((((PH_MASK) >> (p)) & 1u) && IN(pb + (p)))
#define SEAM(k) do { if (IN(k) && IN((k) + 1)) { XcdBarrier b_; b_.bar = (unsigned*)(karg_ws() + WS_CTL) + CW_BAR; b_.x = xb_xcc_id(); b_.st = (volatile LAS unsigned*)(lds + MISC_OFF) + 8; int zb_ = 0; asm volatile("" : "+v"(zb_)); \
    const bool ld_ = (wave0 == 0) && ((int)__builtin_amdgcn_mbcnt_hi(~0u, __builtin_amdgcn_mbcnt_lo(~0u, (unsigned)zb_)) == 0); xcd_barrier(b_, ld_); } } while (0)

#define X (karg_out())
#define WSP(T, off) ((T*)(karg_ws() + (off)))
#define ropeA WSP(float, WS_ROPEA)
#define ropeC WSP(float, WS_ROPEC)
#define LBW WSP(float, WS_LB)
#define W1U WSP(bf16, WS_W + W_1U)
#define W1D WSP(bf16, WS_W + W_1D)
#define WIN1 WSP(bf16, WS_W + W_IN1)
#define WINB WSP(bf16, WS_W + W_INB)
#define WING WSP(bf16, WS_W + W_ING)
#define WQB WSP(bf16, WS_W + W_QB)
#define WKVB WSP(bf16, WS_W + W_KVB)
#define WA WSP(bf16, WS_W + W_A)
#define WBb WSP(bf16, WS_W + W_B)
#define WC WSP(bf16, WS_W + W_C)
#define WO WSP(bf16, WS_W + W_O)
#define W2U WSP(bf16, WS_W + W_2U)
#define W2D WSP(bf16, WS_W + W_2D)
#define WPG WSP(bf16, WS_W + W_PG)
#define WPP WSP(bf16, WS_W + W_PP)
#define XN WSP(bf16, WS_XN)
#define XBE WSP(bf16, WS_XBE)
#define XBO WSP(bf16, WS_XBO)
#define SS0 WSP(float, WS_SS0)
#define SS1 WSP(float, WS_SS1)
#define MG WSP(bf16, WS_MG)
#define H WSP(bf16, WS_H)
#define QKVA WSP(bf16, WS_QKVA)
#define CLR WSP(bf16, WS_CLR)
#define QC WSP(bf16, WS_QC)
#define CO WSP(bf16, WS_CO)
#define KVC WSP(bf16, WS_KVC)
#define AOUT WSP(bf16, WS_AOUT)
#define AOG WSP(bf16, WS_AOG)
#define LSEB WSP(float, WS_LSE)
#define SHB WSP(float, WS_SH)
#define BIN WSP(bf16, WS_BIN)
#define BO WSP(bf16, WS_BO)
#define GS WSP(unsigned char, WS_GS)
#define PB WSP(bf16, WS_PB)
#define PP WSP(bf16, WS_PP)

#define WPREP(LY, SEL) do { \
            int ln_w = lane, wv_w = wave, gw_w = gw; asm volatile("" : "+v"(ln_w), "+s"(wv_w), "+s"(gw_w)); \
            LAS float* scr = (LAS float*)(lds + wv_w * 16384); \
            bf16* const w1U = W1U; bf16* const w1D = W1D; bf16* const wIN1 = WIN1; bf16* const wINB = WINB; bf16* const wING = WING; bf16* const wQB = WQB; bf16* const wKVB = WKVB; bf16* const wA = WA; \
            bf16* const wB = WBb; bf16* const wC = WC; bf16* const wO = WO; bf16* const w2U = W2U; bf16* const w2D = W2D; bf16* const wPG = WPG; bf16* const wPP = WPP; \
            const float* w1u = karg_in(3) + (size_t)(LY) * DM * 2 * DFF; const float* w1d = karg_in(4) + (size_t)(LY) * DFF * DM; const float* win = karg_in(6) + (size_t)(LY) * DM * INW; \
            const float* wqb = karg_in(10) + (size_t)(LY) * 384 * 1152; const float* wkvb = karg_in(12) + (size_t)(LY) * 256 * 1536; \
            const float* wa = karg_in(13) + (size_t)(LY) * 256 * DM; const float* wbb = karg_in(14) + (size_t)(LY) * 768 * DM; const float* wcc = karg_in(15) + (size_t)(LY) * 768 * DM; \
            const float* wo = karg_in(16) + (size_t)(LY) * DM * DM; const float* w2u = karg_in(18) + (size_t)(LY) * DM * 2 * DFF; const float* w2d = karg_in(19) + (size_t)(LY) * DFF * DM; \
            const float* wpg = karg_in(21) + (size_t)(LY) * DM * DM; const float* wpp = karg_in(22) + (size_t)(LY) * PLE * DM; \
            const float* gn1 = karg_in(2) + (LY) * DM; const float* gnm = karg_in(5) + (LY) * DM; const float* gn2 = karg_in(17) + (LY) * DM; const float* gnp = karg_in(20) + (LY) * DM; \
            constexpr int I_U = (1024 / 64) * (5632 / 32), I_D = (2816 / 64) * (1024 / 32), I_1 = 16 * (N_IN1 / 32), I_B = 16 * (N_INB / 32), I_G = 16 * (N_ING / 32), I_Q = 6 * (N_QB / 32), I_KV = 4 * (1536 / 32), \
                          I_A = 4 * 32, I_BC = 12 * 32, I_O = 16 * 32, I_PP = 4 * 32; \
            constexpr int NITEMS = 2 * I_U + 2 * I_D + I_1 + I_B + I_G + I_Q + I_KV + I_A + 2 * I_BC + 2 * I_O + I_PP; \
            for (int it = gw_w; it < NITEMS; it += NGW) { \
                int r = it; \
                if (r < I_U) { if ((SEL) != 2) wt_item<1, true>(w1u, 1024, 5632, 5632, w1U, scr, r, ln_w, gn1); continue; } r -= I_U; \
                if (r < I_U) { if ((SEL) != 2) wt_item<1, true>(w2u, 1024, 5632, 5632, w2U, scr, r, ln_w, gn2); continue; } r -= I_U; \
                if (r < I_D) { if ((SEL) != 2) wt_item<0>(w1d, 2816, 1024, 1024, w1D, scr, r, ln_w); continue; } r -= I_D; \
                if (r < I_D) { if ((SEL) != 2) wt_item<0>(w2d, 2816, 1024, 1024, w2D, scr, r, ln_w); continue; } r -= I_D; \
                if (r < I_1) { if ((SEL) != 2) wt_item<2, true>(win, 1024, INW, N_IN1, wIN1, scr, r, ln_w, gnm); continue; } r -= I_1; \
                if (r < I_B) { if ((SEL) != 2) wt_item<3, true>(win, 1024, INW, N_INB, wINB, scr, r, ln_w, gnm); continue; } r -= I_B; \
                if (r < I_G) { if ((SEL) != 2) wt_item<4, true>(win, 1024, INW, N_ING, wING, scr, r, ln_w, gnm); continue; } r -= I_G; \
                if (r < I_Q) { if ((SEL) != 2) wt_item<5>(wqb, 384, 1152, N_QB, wQB, scr, r, ln_w); continue; } r -= I_Q; \
                if (r < I_KV) { if ((SEL) != 2) wt_item<0>(wkvb, 256, 1536, 1536, wKVB, scr, r, ln_w); continue; } r -= I_KV; \
                if (r < I_A) { if ((SEL) != 2) wt_item<0>(wa, 256, 1024, 1024, wA, scr, r, ln_w); continue; } r -= I_A; \
                if (r < I_BC) { if ((SEL) != 2) wt_item<0>(wbb, 768, 1024, 1024, wB, scr, r, ln_w); continue; } r -= I_BC; \
                if (r < I_BC) { if ((SEL) != 2) wt_item<0>(wcc, 768, 1024, 1024, wC, scr, r, ln_w); continue; } r -= I_BC; \
                if (r < I_O) { if ((SEL) != 2) wt_item<0>(wo, 1024, 1024, 1024, wO, scr, r, ln_w); continue; } r -= I_O; \
                if (r < I_O) { if ((SEL) != 1) wt_item<0, true>(wpg, 1024, 1024, 1024, wPG, scr, r, ln_w, gnp); continue; } r -= I_O; \
                if ((SEL) != 1) wt_item<0>(wpp, 256, 1024, 1024, wPP, scr, r, ln_w); \
            } \
            } while (0)
    for (int Lyr = 0; Lyr < DEPTH; ++Lyr) {
        const int pb = Lyr * NPH;
        if (hi <= pb || lo >= pb + NPH) continue;

        if (Lyr == 0 && INP(0)) for (int rep_ = 0; rep_ < 1 + (int)((MK_DUP >> 0) & 1u); ++rep_) { PH_LOCALS
            WPREP(Lyr, 0);
            if (Lyr == 0) {
                const int gt = vcu * 512 + tid, NGT = G * 512; float* rA = ropeA; float* rC = ropeC; float* lbw_ = LBW;
                for (int i = gt; i < SEQ * 8; i += NGT) { const int pos = i >> 3, f = i & 7; const float inv = 1.0f / powf(500000.0f, (float)(2 * f) / 16.0f); const float ang = (float)pos * inv;
                    rA[2 * i] = cosf(ang); rA[2 * i + 1] = sinf(ang); }
                for (int i = gt; i < SEQ * 32; i += NGT) { const int pos = i >> 5, f = i & 31; const float inv = 1.0f / powf(10000.0f, (float)(2 * f) / 64.0f); const float ang = (float)pos * inv;
                    rC[2 * i] = cosf(ang); rC[2 * i + 1] = sinf(ang); }
                const float* lg = karg_in(7);
                for (int c = gt; c < 1024; c += NGT) { const float a0 = lg[c], a1 = lg[1024 + c], a2 = lg[2048 + c], a3 = lg[3072 + c];
                    const float mx = fmaxf(fmaxf(a0, a1), fmaxf(a2, a3)); const float e0 = expf(a0 - mx), e1 = expf(a1 - mx), e2 = expf(a2 - mx), e3 = expf(a3 - mx); const float inv = 1.f / (e0 + e1 + e2 + e3);
                    lbw_[c] = 0.f; lbw_[1024 + c] = e1 * inv; lbw_[2048 + c] = (e1 + e2) * inv; lbw_[3072 + c] = (e1 + e2 + e3) * inv; }
            }
            if (Lyr == 0) {
                const float* xin = karg_in(0); bf16* xb = XBO; float* ss = SS1;
                for (int m0 = gw; m0 < MTOK; m0 += 2 * NGW) {
                    f32x4 v[2][4]; float sq[2];
#pragma unroll
                    for (int q = 0; q < 2; ++q) { const GAS f32x4* xr = (const GAS f32x4*)(xin + (size_t)(m0 + q * NGW) * DM) + lane;
#pragma unroll
                        for (int j = 0; j < 4; ++j) v[q][j] = xr[64 * j]; }
#pragma unroll
                    for (int q = 0; q < 2; ++q) { GAS unsigned long long* o8 = (GAS unsigned long long*)(xb + (size_t)(m0 + q * NGW) * DM) + lane; float t = 0.f;
#pragma unroll
                        for (int j = 0; j < 4; ++j) { const f32x4 u = v[q][j]; t += (u.x * u.x + u.y * u.y) + (u.z * u.z + u.w * u.w); o8[64 * j] = (unsigned long long)pg8::cvt_pk_f16(u.x, u.y) | ((unsigned long long)pg8::cvt_pk_f16(u.z, u.w) << 32); }
                        sq[q] = t; }
#pragma unroll
                    for (int q = 0; q < 2; ++q) { const float t = wave_sum(sq[q]); if (lane < 16) ss[(size_t)(m0 + q * NGW) * 16 + lane] = (lane == 0) ? t : 0.f; } }
            }
        }
        if (Lyr == 0) SEAM(pb + 0);
        if (INP(1)) for (int rep_ = 0; rep_ < 1 + (int)((MK_DUP >> 1) & 1u); ++rep_) { PH_LOCALS pg8::Gemm g{XBO, W1U, MTOK, 2 * DFF, DM, DM}; pg8::StaticOrder S; S.init(MTOK, 2 * DFF, G, bx); EpiSwiglu E{H, rs_preload(lds, SS1, S, tid)}; pg8::gemm_phase<EpiSwiglu, pg8::StaticOrder, true, true>(lds, g, S, E, tid);
            if (Lyr > 0) WPREP(Lyr, 2); }
        SEAM(pb + 1);
        if (INP(2)) for (int rep_ = 0; rep_ < 1 + (int)((MK_DUP >> 2) & 1u); ++rep_) { PH_LOCALS pg8::Gemm g{H, W1D, MTOK, DM, DFF, DFF}; pg8::StaticOrder S; S.init(MTOK, DM, G, bx); EpiResid E{XBO, XBE, rep_ ? 0.f : 0.5f, SS0}; pg8::gemm_phase<EpiResid, pg8::StaticOrder>(lds, g, S, E, tid); }
        SEAM(pb + 2);
        if (INP(4)) for (int rep_ = 0; rep_ < 1 + (int)((MK_DUP >> 4) & 1u); ++rep_) { PH_LOCALS pg8::Gemm g{XBE, WIN1, MTOK, N_IN1, DM, DM}; pg8::StaticOrder S; S.init(MTOK, N_IN1, G, bx); EpiIn1 E{QKVA, CLR, ropeA, ropeC, rs_preload(lds, SS0, S, tid)}; pg8::gemm_phase<EpiIn1, pg8::StaticOrder, true, true>(lds, g, S, E, tid); }
        SEAM(pb + 4);
        if (INP(5)) for (int rep_ = 0; rep_ < 1 + (int)((MK_DUP >> 5) & 1u); ++rep_) { PH_LOCALS
            const float* gq = karg_in(9) + Lyr * 384; const float* gkv = karg_in(11) + Lyr * 256; bf16* const clr = CLR; const bf16* const qkva = QKVA; bf16* const aout = AOUT;
            if (rep_ == 0) {
                float gqr[6], gkr[4];
#pragma unroll
                for (int j = 0; j < 6; ++j) gqr[j] = gq[6 * lane + j];
#pragma unroll
                for (int j = 0; j < 4; ++j) gkr[j] = gkv[4 * lane + j];
                for (int m0 = gw; m0 < MTOK; m0 += 4 * NGW) {
                    unsigned a[4][3], b[4][2]; float s1[4], s2[4];
#pragma unroll
                    for (int q = 0; q < 4; ++q) { const unsigned* row = (const unsigned*)(clr + (size_t)(m0 + q * NGW) * P_CLR);
#pragma unroll
                        for (int j = 0; j < 3; ++j) a[q][j] = row[3 * lane + j];
#pragma unroll
                        for (int j = 0; j < 2; ++j) b[q][j] = (row + CLR_KV / 2)[2 * lane + j]; }
#pragma unroll
                    for (int q = 0; q < 4; ++q) { float t1 = 0.f, t2 = 0.f;
#pragma unroll
                        for (int j = 0; j < 3; ++j) { const float x = bflo(a[q][j]), y = bfhi(a[q][j]); t1 += x * x + y * y; }
#pragma unroll
                        for (int j = 0; j < 2; ++j) { const float x = bflo(b[q][j]), y = bfhi(b[q][j]); t2 += x * x + y * y; }
                        s1[q] = t1; s2[q] = t2; }
#pragma unroll
                    for (int o = 1; o < 64; o <<= 1) {
#pragma unroll
                        for (int q = 0; q < 4; ++q) { s1[q] += __shfl_xor(s1[q], o); s2[q] += __shfl_xor(s2[q], o); } }
#pragma unroll
                    for (int q = 0; q < 4; ++q) { unsigned* row = (unsigned*)(clr + (size_t)(m0 + q * NGW) * P_CLR);
                        const float r1 = 1.f / sqrtf(s1[q] * (1.f / 384.f) + EPS), r2 = 1.f / sqrtf(s2[q] * (1.f / 256.f) + EPS);
#pragma unroll
                        for (int j = 0; j < 3; ++j) row[3 * lane + j] = pk2(bflo(a[q][j]) * r1 * gqr[2 * j], bfhi(a[q][j]) * r1 * gqr[2 * j + 1]);
#pragma unroll
                        for (int j = 0; j < 2; ++j) (row + CLR_KV / 2)[2 * lane + j] = pk2(bflo(b[q][j]) * r2 * gkr[2 * j], bfhi(b[q][j]) * r2 * gkr[2 * j + 1]); }
                }
            }
#if MK_NAIVE_A
            for (int task = gw; task < MTOK * 4; task += NGW) {
                const int m = task >> 2, hh = task & 3, t = m & (SEQ - 1);
                float sc[3][3]; float mx = -1e30f;
#pragma unroll
                for (int g = 0; g < 3; ++g) { const int dil = (g == 0) ? 1 : (g == 1) ? 4 : 16; const int head = 4 * g + hh;
                    const u32x4* qp = (const u32x4*)(qkva + (size_t)m * P_QKVA + head * 64);
#pragma unroll
                    for (int kk = 0; kk < 3; ++kk) { const int i = lane + 64 * kk; const bool valid = (i <= 128) && (t - i * dil >= 0);
                        float s = -1e30f;
                        if (valid) { const u32x4* kp = (const u32x4*)(qkva + (size_t)(m - i * dil) * P_QKVA + 768 + head * 64); s = 0.f;
                            for (int c = 0; c < 8; ++c) { const u32x4 qv = qp[c], kv = kp[c];
                                s += bflo(qv.x) * bflo(kv.x) + bfhi(qv.x) * bfhi(kv.x) + bflo(qv.y) * bflo(kv.y) + bfhi(qv.y) * bfhi(kv.y) + bflo(qv.z) * bflo(kv.z) + bfhi(qv.z) * bfhi(kv.z) + bflo(qv.w) * bflo(kv.w) + bfhi(qv.w) * bfhi(kv.w); } }
                        sc[g][kk] = s; mx = fmaxf(mx, s); } }
                mx = wave_max(mx);
                float l = 0.f;
#pragma unroll
                for (int g = 0; g < 3; ++g)
#pragma unroll
                    for (int kk = 0; kk < 3; ++kk) { const float p = (sc[g][kk] > -1e29f) ? __builtin_amdgcn_exp2f(sc[g][kk] - mx) : 0.f; sc[g][kk] = p; l += p; }
                l = wave_sum(l);
                float o = 0.f;
#pragma unroll
                for (int g = 0; g < 3; ++g) { const int dil = (g == 0) ? 1 : (g == 1) ? 4 : 16; const int head = 4 * g + hh;
#pragma unroll
                    for (int kk = 0; kk < 3; ++kk) { const int nn = (kk < 2) ? 64 : 1;
                        for (int ii = 0; ii < nn; ++ii) { const int i = 64 * kk + ii; if (t - i * dil < 0) break;
                            const float p = __shfl(sc[g][kk], ii); o += p * bf2f(qkva[(size_t)(m - i * dil) * P_QKVA + 1536 + head * 64 + lane]); } } }
                aout[(size_t)m * 256 + hh * 64 + lane] = (bf16)f2bf(o / l);
            }
        #else
            dwa_phase(lds, qkva, AOG, LSEB, vcu, G, tid, lane, wave);
#endif
        }
        SEAM(pb + 5);
        if (INP(6)) for (int rep_ = 0; rep_ < 1 + (int)((MK_DUP >> 6) & 1u); ++rep_) { PH_LOCALS
#if !MK_NAIVE_A
            { const bf16* const aog = AOG; const float* const lse = LSEB; bf16* const aout = AOUT;
              for (int m0 = gw; m0 < MTOK; m0 += 4 * NGW) { const int hh = lane >> 4;
                  float l0[4], l1[4], l2[4]; u32x2 a[4], b[4], c[4];
#pragma unroll
                  for (int q = 0; q < 4; ++q) { const size_t m = (size_t)(m0 + q * NGW);
                      l0[q] = lse[m * 4 + hh]; l1[q] = lse[((size_t)MTOK + m) * 4 + hh]; l2[q] = lse[((size_t)2 * MTOK + m) * 4 + hh];
                      a[q] = *(const u32x2*)(aog + m * 256 + 4 * lane); b[q] = *(const u32x2*)(aog + ((size_t)MTOK + m) * 256 + 4 * lane); c[q] = *(const u32x2*)(aog + ((size_t)2 * MTOK + m) * 256 + 4 * lane); }
#pragma unroll
                  for (int q = 0; q < 4; ++q) { const size_t m = (size_t)(m0 + q * NGW); const float mx = fmaxf(l0[q], fmaxf(l1[q], l2[q]));
                      const float w0 = __builtin_amdgcn_exp2f(l0[q] - mx), w1 = __builtin_amdgcn_exp2f(l1[q] - mx), w2 = __builtin_amdgcn_exp2f(l2[q] - mx); const float inv = 1.f / (w0 + w1 + w2);
                      u32x2 o; o.x = pk2((w0 * bflo(a[q].x) + w1 * bflo(b[q].x) + w2 * bflo(c[q].x)) * inv, (w0 * bfhi(a[q].x) + w1 * bfhi(b[q].x) + w2 * bfhi(c[q].x)) * inv);
                      o.y = pk2((w0 * bflo(a[q].y) + w1 * bflo(b[q].y) + w2 * bflo(c[q].y)) * inv, (w0 * bfhi(a[q].y) + w1 * bfhi(b[q].y) + w2 * bfhi(c[q].y)) * inv);
                      *(u32x2*)(aout + m * 256 + 4 * lane) = o; } } }
#endif
            { pg8::Gemm g{CLR, WQB, MTOK, N_QB, 384, P_CLR}; pg8::StaticOrder S; S.init(MTOK, N_QB, G, bx); EpiQC E{QC, ropeC}; pg8::gemm_phase<EpiQC, pg8::StaticOrder>(lds, g, S, E, tid); }
            { pg8::Gemm g{CLR + CLR_KV, WKVB, MTOK, 1536, 256, P_CLR}; pg8::StaticOrder S; S.init(MTOK, 1536, G, bx); EpiBf16<0, false> E{KVC, P_KVC, RsTab{nullptr, 0}}; pg8::gemm_phase<EpiBf16<0, false>, pg8::StaticOrder>(lds, g, S, E, tid); }
        }
        SEAM(pb + 6);
        if (INP(7)) for (int rep_ = 0; rep_ < 1 + (int)((MK_DUP >> 7) & 1u); ++rep_) { PH_LOCALS
#if MK_NAIVE_C
            LAS float* Sb = (LAS float*)(lds + wave * 16384); const bf16* const qc = QC; const bf16* const kvc = KVC; const bf16* const clr = CLR; bf16* const co = CO;
            for (int task = gw; task < MTOK * 6; task += NGW) {
                const int m = task / 6, h = task - 6 * m, t = m & (SEQ - 1); const size_t rb = (size_t)(m - t);
                const u32x4* qp = (const u32x4*)(qc + (size_t)m * P_QC + h * 192);
                float mx = -1e30f;
                for (int k0 = 0; k0 <= t; k0 += 64) { const int key = k0 + lane; float s = -1e30f;
                    if (key <= t) { const u32x4* kp = (const u32x4*)(kvc + (rb + key) * P_KVC + h * 256); const u32x4* rp = (const u32x4*)(clr + (rb + key) * P_CLR + CLR_KR); s = 0.f;
                        for (int c = 0; c < 24; ++c) { const u32x4 qv = qp[c]; const u32x4 kv = (c < 16) ? kp[c] : rp[c - 16];
                            s += bflo(qv.x) * bflo(kv.x) + bfhi(qv.x) * bfhi(kv.x) + bflo(qv.y) * bflo(kv.y) + bfhi(qv.y) * bfhi(kv.y) + bflo(qv.z) * bflo(kv.z) + bfhi(qv.z) * bfhi(kv.z) + bflo(qv.w) * bflo(kv.w) + bfhi(qv.w) * bfhi(kv.w); } }
                    Sb[key] = s; mx = fmaxf(mx, s); }
                mx = wave_max(mx);
                float l = 0.f;
                for (int k0 = 0; k0 <= t; k0 += 64) { const int key = k0 + lane; const float s = Sb[key]; const float p = (key <= t) ? __builtin_amdgcn_exp2f(s - mx) : 0.f; Sb[key] = p; l += p; }
                l = wave_sum(l);
                LDS_WAIT();
                float o0 = 0.f, o1 = 0.f;
                for (int key = 0; key <= t; ++key) { const float p = Sb[key]; const unsigned v = *(const unsigned*)(kvc + (rb + key) * P_KVC + h * 256 + 128 + 2 * lane); o0 += p * bflo(v); o1 += p * bfhi(v); }
                const float il = 1.f / l;
                *(unsigned*)(co + (size_t)m * 768 + h * 128 + 2 * lane) = pk2(o0 * il, o1 * il);
                LDS_WAIT();
            }
        #else
            mla_phase(lds, QC, KVC, CLR, CO, vcu, G, tid, lane, wave);
#endif
        }
        SEAM(pb + 7);
        if (INP(8)) for (int rep_ = 0; rep_ < 1 + (int)((MK_DUP >> 8) & 1u); ++rep_) { PH_LOCALS pg8::Gemm g{XBE, WINB, MTOK, N_INB, DM, DM}; pg8::StaticOrder S; S.init(MTOK, N_INB, G, bx); EpiBf16<0, true> E{BIN, P_BIN, rs_preload(lds, SS0, S, tid)}; pg8::gemm_phase<EpiBf16<0, true>, pg8::StaticOrder, true, true>(lds, g, S, E, tid); }
        SEAM(pb + 8);
        if (INP(9)) for (int rep_ = 0; rep_ < 1 + (int)((MK_DUP >> 9) & 1u); ++rep_) { PH_LOCALS
#if MK_NAIVE_B
            LAS float* Fs = (LAS float*)lds; LAS float* Ks = Fs + 16 * 128; LAS float* Qs = Ks + 16 * 128; LAS float* Vs = Qs + 16 * 128; LAS float* Os = Vs + 16 * 48;
            const float* lbw = LBW + Lyr * 1024; const bf16* const bin = BIN; bf16* const bo = BO;
            for (int unit = bx; unit < BATCH * 8 * 2; unit += G) {
                const int half = unit & 1, chain = unit >> 1, b = chain >> 3, head = chain & 7;
                const int col = tid >> 3, seg = tid & 7;
                float st[16];
#pragma unroll
                for (int j = 0; j < 16; ++j) st[j] = 0.f;
                const int et = tid >> 5, ed = (tid & 31) * 4;
                f32x4 lb4 = *(const f32x4*)(lbw + head * 128 + ed);
                for (int t0 = 0; t0 < SEQ; t0 += 16) {
                    const size_t row0 = (size_t)b * SEQ + t0;
                    { const bf16* rp = bin + (row0 + et) * P_BIN; const u32x2 qw = *(const u32x2*)(rp + head * 128 + ed); const u32x2 zw = *(const u32x2*)(rp + 1024 + head * 128 + ed);
                      const float z[4] = {bflo(zw.x), bfhi(zw.x), bflo(zw.y), bfhi(zw.y)}; f32x4 f, k;
#pragma unroll
                      for (int j = 0; j < 4; ++j) { const float sg = sigmoidf_(z[j]); f[j] = lb4[j] + (1.f - lb4[j]) * sg; k[j] = (1.f - lb4[j]) * (1.f - sg); }
                      *(LAS f32x4*)(Fs + et * 128 + ed) = f; *(LAS f32x4*)(Ks + et * 128 + ed) = k; *(LAS f32x4*)(Qs + et * 128 + ed) = (f32x4){bflo(qw.x), bfhi(qw.x), bflo(qw.y), bfhi(qw.y)}; }
                    for (int idx = tid; idx < 16 * 48; idx += 512) { const int tt = idx / 48, c = idx - 48 * tt; Vs[idx] = bf2f(bin[(row0 + tt) * P_BIN + 2048 + head * 96 + 48 * half + c]); }
                    __syncthreads();
                    if (tid < 384) {
                        for (int tt = 0; tt < 16; ++tt) { const float vv = Vs[tt * 48 + col]; float o = 0.f;
#pragma unroll
                            for (int j4 = 0; j4 < 4; ++j4) { const f32x4 f = *(const LAS f32x4*)(Fs + tt * 128 + seg * 16 + 4 * j4), k = *(const LAS f32x4*)(Ks + tt * 128 + seg * 16 + 4 * j4), q = *(const LAS f32x4*)(Qs + tt * 128 + seg * 16 + 4 * j4);
#pragma unroll
                                for (int j = 0; j < 4; ++j) { st[4 * j4 + j] = f[j] * st[4 * j4 + j] + k[j] * vv; o += q[j] * st[4 * j4 + j]; } }
                            o += __shfl_xor(o, 1); o += __shfl_xor(o, 2); o += __shfl_xor(o, 4);
                            if (seg == 0) Os[tt * 48 + col] = o; }
                    }
                    __syncthreads();
                    for (int idx = tid; idx < 16 * 48; idx += 512) { const int tt = idx / 48, c = idx - 48 * tt; bo[(row0 + tt) * 768 + head * 96 + 48 * half + c] = (bf16)f2bf(Os[idx]); }
                }
                __syncthreads();
            }
        #else
            hgrn_phase(lds, BIN, BO, LBW + Lyr * 1024, karg_in(8) + Lyr * 96, SHB, vcu, G, tid, lane, wave);
#endif
        }
        SEAM(pb + 9);
#if !MK_NAIVE_B
        if (INP(10)) for (int rep_ = 0; rep_ < 1; ++rep_) { PH_LOCALS hgrn_fix_phase(lds, BIN, BO, karg_in(8) + Lyr * 96, SHB, vcu, G, tid, lane, wave); }
        SEAM(pb + 10);
#endif
#if MK_NAIVE_B
        if (INP(10)) for (int rep_ = 0; rep_ < 1 + (int)((MK_DUP >> 10) & 1u); ++rep_) { PH_LOCALS
            const float* gn = karg_in(8) + Lyr * 96; bf16* const bo = BO; const bf16* const bin = BIN;
            for (int m = gw; m < MTOK; m += NGW) {
                bf16* orow = bo + (size_t)m * 768 + 12 * lane; const bf16* grow = bin + (size_t)m * P_BIN + 2816 + 12 * lane;
                u32x2 a[3], gg[3]; float s = 0.f;
#pragma unroll
                for (int j = 0; j < 3; ++j) { a[j] = ((const u32x2*)orow)[j]; gg[j] = ((const u32x2*)grow)[j]; const float x0 = bflo(a[j].x), x1 = bfhi(a[j].x), x2 = bflo(a[j].y), x3 = bfhi(a[j].y); s += x0 * x0 + x1 * x1 + x2 * x2 + x3 * x3; }
                s += __shfl_xor(s, 1); s += __shfl_xor(s, 2); s += __shfl_xor(s, 4);
                const float rstd = 1.f / sqrtf(s * (1.f / 96.f) + EPS);
                const int e0 = (12 * lane) % 96;
#pragma unroll
                for (int j = 0; j < 3; ++j) { const float x[4] = {bflo(a[j].x), bfhi(a[j].x), bflo(a[j].y), bfhi(a[j].y)}; const float gv[4] = {bflo(gg[j].x), bfhi(gg[j].x), bflo(gg[j].y), bfhi(gg[j].y)}; float r[4];
#pragma unroll
                    for (int e = 0; e < 4; ++e) r[e] = x[e] * rstd * gn[e0 + 4 * j + e] * (gv[e] * sigmoidf_(gv[e]));
                    u32x2 w; w.x = pk2(r[0], r[1]); w.y = pk2(r[2], r[3]); ((u32x2*)orow)[j] = w; }
            }
        }
        SEAM(pb + 10);
#endif
        if (INP(11)) for (int rep_ = 0; rep_ < 1 + (int)((MK_DUP >> 11) & 1u); ++rep_) { PH_LOCALS pg8::Gemm g{XBE, WING, MTOK, N_ING, DM, DM}; pg8::StaticOrder S; S.init(MTOK, N_ING, G, bx); EpiGate8 E{GS, rs_preload(lds, SS0, S, tid)}; pg8::gemm_phase<EpiGate8, pg8::StaticOrder, true, true>(lds, g, S, E, tid); }
        SEAM(pb + 11);
        if (INP(12)) for (int rep_ = 0; rep_ < 1 + (int)((MK_DUP >> 12) & 1u); ++rep_) { PH_LOCALS
            { pg8::Gemm3 g{AOUT, BO, CO, WA, WBb, WC, 256, 768, 768}; pg8::StaticOrder S; S.init(MTOK, DM, G, bx); EpiMerge3 E{MG, GS}; pg8::gemm_phase_ms<EpiMerge3, pg8::StaticOrder>(lds, g, S, E, tid); }
        }
        SEAM(pb + 12);
        if (INP(13)) for (int rep_ = 0; rep_ < 1 + (int)((MK_DUP >> 13) & 1u); ++rep_) { PH_LOCALS pg8::Gemm g{MG, WO, MTOK, DM, DM, DM}; pg8::StaticOrder S; S.init(MTOK, DM, G, bx); EpiResid E{XBE, XBO, rep_ ? 0.f : 1.0f, SS1}; pg8::gemm_phase<EpiResid, pg8::StaticOrder>(lds, g, S, E, tid);
            const f32x4* pp = (const f32x4*)(karg_in(1) + (size_t)Lyr * MTOK * PLE); u32x2* po = (u32x2*)PB;
            for (size_t i = (size_t)vcu * 512 + tid; i < (size_t)MTOK * PLE / 4; i += (size_t)G * 512 * 8) { f32x4 v[8];
#pragma unroll
                for (int q = 0; q < 8; ++q) v[q] = pp[i + (size_t)q * G * 512];
#pragma unroll
                for (int q = 0; q < 8; ++q) { u32x2 w; w.x = pk2(v[q].x, v[q].y); w.y = pk2(v[q].z, v[q].w); po[i + (size_t)q * G * 512] = w; } } }
        SEAM(pb + 13);
        if (INP(15)) for (int rep_ = 0; rep_ < 1 + (int)((MK_DUP >> 15) & 1u); ++rep_) { PH_LOCALS pg8::Gemm g{XBO, W2U, MTOK, 2 * DFF, DM, DM}; pg8::StaticOrder S; S.init(MTOK, 2 * DFF, G, bx); EpiSwiglu E{H, rs_preload(lds, SS1, S, tid)}; pg8::gemm_phase<EpiSwiglu, pg8::StaticOrder, true, true>(lds, g, S, E, tid); }
        SEAM(pb + 15);
        if (INP(16)) for (int rep_ = 0; rep_ < 1 + (int)((MK_DUP >> 16) & 1u); ++rep_) { PH_LOCALS pg8::Gemm g{H, W2D, MTOK, DM, DFF, DFF}; pg8::StaticOrder S; S.init(MTOK, DM, G, bx); EpiResid E{XBO, XBE, rep_ ? 0.f : 0.5f, SS0}; pg8::gemm_phase<EpiResid, pg8::StaticOrder>(lds, g, S, E, tid); }
        SEAM(pb + 16);
        if (INP(18)) for (int rep_ = 0; rep_ < 1 + (int)((MK_DUP >> 18) & 1u); ++rep_) { PH_LOCALS
            { pg8::Gemm g{PB, WPP, MTOK, DM, PLE, PLE}; pg8::StaticOrder S; S.init(MTOK, DM, G, bx); EpiBf16<0, false> E{PP, DM, RsTab{nullptr, 0}}; pg8::gemm_phase<EpiBf16<0, false>, pg8::StaticOrder>(lds, g, S, E, tid); }
            { pg8::Gemm g{XBE, WPG, MTOK, DM, DM, DM}; pg8::StaticOrder S; S.init(MTOK, DM, G, bx); EpiPle E{XBE, PP, rs_preload(lds, SS0, S, tid), XBO, SS1}; pg8::gemm_phase<EpiPle, pg8::StaticOrder, true, true>(lds, g, S, E, tid); }
            if (Lyr + 1 < DEPTH) WPREP(Lyr + 1, 1);
        }
        SEAM(pb + 18);
    }
    if (IN(DEPTH * NPH)) { PH_LOCALS
        const float* gf = karg_in(23); float* const xo = X; const bf16* const xb = XBO;
        f32x4 gv[4];
#pragma unroll
        for (int j = 0; j < 4; ++j) gv[j] = ((const GAS f32x4*)gf + lane)[64 * j];
        for (int m0 = gw; m0 < MTOK; m0 += 4 * NGW) {
            u32x2 w[4][4];
#pragma unroll
            for (int q = 0; q < 4; ++q) { const GAS u32x2* xr = (const GAS u32x2*)(xb + (size_t)(m0 + q * NGW) * DM) + lane;
#pragma unroll
                for (int j = 0; j < 4; ++j) w[q][j] = xr[64 * j]; }
            float sq[4];
#pragma unroll
            for (int q = 0; q < 4; ++q) { float t = 0.f;
#pragma unroll
                for (int j = 0; j < 4; ++j) { const float x0 = pg8::f16lo(w[q][j].x), x1 = pg8::f16hi(w[q][j].x), x2 = pg8::f16lo(w[q][j].y), x3 = pg8::f16hi(w[q][j].y); t += (x0 * x0 + x1 * x1) + (x2 * x2 + x3 * x3); }
                sq[q] = t; }
#pragma unroll
            for (int o = 1; o < 64; o <<= 1) {
#pragma unroll
                for (int q = 0; q < 4; ++q) sq[q] += __shfl_xor(sq[q], o); }
#pragma unroll
            for (int q = 0; q < 4; ++q) { GAS f32x4* orow = (GAS f32x4*)(xo + (size_t)(m0 + q * NGW) * DM) + lane; const float rstd = 1.f / sqrtf(sq[q] * (1.f / DM) + EPS);
#pragma unroll
                for (int j = 0; j < 4; ++j) { const f32x4 v = (f32x4){pg8::f16lo(w[q][j].x), pg8::f16hi(w[q][j].x), pg8::f16lo(w[q][j].y), pg8::f16hi(w[q][j].y)}; orow[64 * j] = v * rstd * gv[j]; } }
        }
    }
#undef IN
#undef SEAM
}
#undef X
#undef WSP
#undef ropeA
#undef ropeC
#undef LBW
#undef W1U
#undef W1D
#undef WIN1
#undef WINB
#undef WING
#undef WQB
#undef WKVB
#undef WA
#undef WBb
#undef WC
#undef WO
#undef W2U
#undef W2D
#undef WPG
#undef WPP
#undef XN
#undef XBE
#undef XBO
#undef SS0
#undef SS1
#undef MG
#undef H
#undef QKVA
#undef CLR
#undef QC
#undef CO
#undef KVC
#undef AOUT
#undef AOG
#undef LSEB
#undef SHB
#undef BIN
#undef BO
#undef GS
#undef PB
#undef PP
#undef PH_LOCALS
#undef WPREP
#undef INP


#ifdef MK_CHECK
constexpr size_t WS_STASH = 978 * MiB;
constexpr int CHK_WORDS = 8192;
__device__ __forceinline__ unsigned hash_u(unsigned x) { x ^= x >> 16; x *= 0x7feb352du; x ^= x >> 15; x *= 0x846ca68bu; x ^= x >> 16; return x; }
__device__ __forceinline__ float dot_bw(const bf16* a, const float* W, int K, int ldw, int col) { float s = 0.f; for (int k = 0; k < K; ++k) s += bf2f(a[k]) * W[(size_t)k * ldw + col]; return s; }
__device__ __forceinline__ void chk_add(unsigned* ctl, int k, float got, float exp_, float atol) {
    const bool bad = !(fabsf(got - exp_) <= 0.05f * fabsf(exp_) + atol);
    atomicAdd(&ctl[CHK_WORDS + 2 * k + 1], 1u); if (bad) atomicAdd(&ctl[CHK_WORDS + 2 * k], 1u);
}
__device__ __forceinline__ void rope_pair(float x1, float x2, int pos, int f, float theta, int dim, bool second, float& out) {
    const float inv = 1.0f / powf(theta, (float)(2 * f) / (float)dim); const float ang = (float)pos * inv; const float c = cosf(ang), s = sinf(ang);
    out = second ? (x2 * c + x1 * s) : (x1 * c - x2 * s);
}
__global__ void __launch_bounds__(512) mk_check(Args args, int p, int Lyr) {
    unsigned char* ws = args.ws; unsigned* ctl = (unsigned*)(ws + WS_CTL);
    const unsigned gt = blockIdx.x * 512 + threadIdx.x; const unsigned h0 = hash_u(gt * 2654435761u + 977u * (unsigned)p + 1u), h1 = hash_u(h0 + 0x9e3779b9u), h2 = hash_u(h1 + 0x85ebca6bu);
    const int m = (int)(h0 % MTOK), pos = m & (SEQ - 1);
    float* X = args.out; float* XS = (float*)(ws + WS_STASH); bf16* BS = (bf16*)(ws + WS_STASH + 4 * MiB);
    const bf16* XN = (const bf16*)(ws + WS_XN); const bf16* H = (const bf16*)(ws + WS_H); const bf16* QKVA = (const bf16*)(ws + WS_QKVA); const bf16* CLR = (const bf16*)(ws + WS_CLR);
    const bf16* QC = (const bf16*)(ws + WS_QC); const bf16* KVC = (const bf16*)(ws + WS_KVC); const bf16* CO = (const bf16*)(ws + WS_CO); const bf16* AOUT = (const bf16*)(ws + WS_AOUT);
    const bf16* BIN = (const bf16*)(ws + WS_BIN); const bf16* BO = (const bf16*)(ws + WS_BO); const bf16* GS = (const bf16*)(ws + WS_GS); const bf16* MG = (const bf16*)(ws + WS_MG);
    const bf16* PB = (const bf16*)(ws + WS_PB); const float* LBW = (const float*)(ws + WS_LB);
    const float* win = args.in[6] + (size_t)Lyr * DM * INW;
    auto stashX = [&]() { for (size_t i = gt; i < (size_t)1024 * 1024; i += (size_t)gridDim.x * 512) { const size_t r = i >> 10, c = i & 1023; XS[i] = X[(r * 64) * DM + c]; } };
    if (p == 0 || p == 3 || p == 14 || p == 17) {
        const int gi = (p == 0) ? 2 : (p == 3) ? 5 : (p == 14) ? 17 : 20; const float* g = args.in[gi] + Lyr * DM; const float* x = (p == 0 && Lyr == 0) ? args.in[0] : X;
        const int c = h1 % DM; float ss = 0.f; for (int k = 0; k < DM; ++k) { const float v = x[(size_t)m * DM + k]; ss += v * v; }
        chk_add(ctl, p, bf2f(XN[(size_t)m * DM + c]), x[(size_t)m * DM + c] / sqrtf(ss / DM + EPS) * g[c], 0.03f);
        if (p == 0) {
            const bf16* Wb = (const bf16*)(ws + WS_W); const int which = h2 % 6; const unsigned r1 = hash_u(h2 + 17u), r2 = hash_u(r1 + 29u);
            if (which == 0) { const int n = r1 % N_ING, k = r2 % 1024; chk_add(ctl, 24, bf2f(Wb[W_ING / 2 + (size_t)n * 1024 + k]), bf2f((bf16)f2bf(win[(size_t)k * INW + O_G + n])), 1e-6f); }
            if (which == 1) { const int n = r1 % N_INB, k = r2 % 1024; chk_add(ctl, 25, bf2f(Wb[W_INB / 2 + (size_t)n * 1024 + k]), bf2f((bf16)f2bf(win[(size_t)k * INW + O_B + n])), 1e-6f); }
            if (which == 2) { const int n = r1 % 1024, k = r2 % DFF; chk_add(ctl, 26, bf2f(Wb[W_1D / 2 + (size_t)n * DFF + k]), bf2f((bf16)f2bf((args.in[4] + (size_t)Lyr * DFF * DM)[(size_t)k * DM + n])), 1e-6f); }
            if (which == 3) { const int n = r1 % 1024, k = r2 % 1024; chk_add(ctl, 27, bf2f(Wb[W_O / 2 + (size_t)n * 1024 + k]), bf2f((bf16)f2bf((args.in[16] + (size_t)Lyr * DM * DM)[(size_t)k * DM + n])), 1e-6f); }
            if (which == 4) { const int n = r1 % 1024, k = r2 % 768; chk_add(ctl, 28, bf2f(Wb[W_C / 2 + (size_t)n * 768 + k]), bf2f((bf16)f2bf((args.in[15] + (size_t)Lyr * 768 * DM)[(size_t)k * DM + n])), 1e-6f); }
            if (which == 5) { const int n = r1 % 1024, k = r2 % 1024; chk_add(ctl, 29, bf2f(Wb[W_PG / 2 + (size_t)n * 1024 + k]), bf2f((bf16)f2bf((args.in[21] + (size_t)Lyr * DM * DM)[(size_t)k * DM + n])), 1e-6f); }
        }
        if (p == 14 || p == 17) stashX();
        if (p == 17) { const float* pp = args.in[1] + (size_t)Lyr * MTOK * PLE; const int j = h2 % PLE; chk_add(ctl, 19, bf2f(PB[(size_t)m * PLE + j]), pp[(size_t)m * PLE + j], 0.03f); }
    } else if (p == 1 || p == 15) {
        const float* W = args.in[p == 1 ? 3 : 18] + (size_t)Lyr * DM * 2 * DFF; const int j = h1 % DFF;
        const float a = dot_bw(XN + (size_t)m * DM, W, DM, 2 * DFF, j), b = dot_bw(XN + (size_t)m * DM, W, DM, 2 * DFF, DFF + j);
        chk_add(ctl, p, bf2f(H[(size_t)m * DFF + j]), a / (1.f + expf(-a)) * b, 0.02f);
    } else if (p == 2 || p == 16) {
        const float* W = args.in[p == 2 ? 4 : 19] + (size_t)Lyr * DFF * DM; const int c = h1 % DM;
        if (p == 2 && Lyr == 0) { chk_add(ctl, p, X[(size_t)m * DM + c], args.in[0][(size_t)m * DM + c] + 0.5f * dot_bw(H + (size_t)m * DFF, W, DFF, DM, c), 0.03f); }
        else if (p == 16) { const int r = h0 % 1024; const size_t mm = (size_t)r * 64; chk_add(ctl, p, X[mm * DM + c], XS[(size_t)r * DM + c] + 0.5f * dot_bw(H + mm * DFF, W, DFF, DM, c), 0.03f); }
    } else if (p == 4) {
        const bf16* a = XN + (size_t)m * DM; const int kind = h1 % 4;
        if (kind < 3) { const int which = kind, head = (h1 >> 8) % 12, d = (h2 >> 4) % 64; const int cb = which * 768 + head * 64; float val; int phys = d;
            if (which < 2 && d < 16) { const int i = d & 7; const float x1 = dot_bw(a, win, DM, INW, cb + i), x2 = dot_bw(a, win, DM, INW, cb + i + 8); rope_pair(x1, x2, pos, i, 500000.0f, 16, d >= 8, val); phys = (d < 8) ? 2 * d : 2 * (d - 8) + 1; }
            else val = dot_bw(a, win, DM, INW, cb + d);
            if (which == 0) val *= QSCALE_A;
            chk_add(ctl, 4, bf2f(QKVA[(size_t)m * P_QKVA + cb + phys]), val, which == 0 ? 0.006f : 0.03f);
        } else { const int sub = (h1 >> 8) % 3;
            if (sub == 0) { const int j = h2 % 384; chk_add(ctl, 20, bf2f(CLR[(size_t)m * P_CLR + j]), dot_bw(a, win, DM, INW, O_CQ + j), 0.03f); }
            else if (sub == 1) { const int j = h2 % 256; chk_add(ctl, 20, bf2f(CLR[(size_t)m * P_CLR + 512 + j]), dot_bw(a, win, DM, INW, O_CKV + j), 0.03f); }
            else { const int d = h2 % 64, i = d & 31; const float x1 = dot_bw(a, win, DM, INW, O_CKR + i), x2 = dot_bw(a, win, DM, INW, O_CKR + i + 32); float val; rope_pair(x1, x2, pos, i, 10000.0f, 64, d >= 32, val);
                const int phys = (d < 32) ? 2 * d : 2 * (d - 32) + 1; chk_add(ctl, 21, bf2f(CLR[(size_t)m * P_CLR + 768 + phys]), val, 0.03f); } }
    } else if (p == 5) {
        { const float* gq = args.in[9] + Lyr * 384; const float* gkv = args.in[11] + Lyr * 256; float s = 0.f; for (int j = 0; j < 384; ++j) { const float v = bf2f(CLR[(size_t)m * P_CLR + j]) / gq[j]; s += v * v; }
          chk_add(ctl, 22, s / 384.f, 1.0f, 0.0f); float s2 = 0.f; for (int j = 0; j < 256; ++j) { const float v = bf2f(CLR[(size_t)m * P_CLR + 512 + j]) / gkv[j]; s2 += v * v; } chk_add(ctl, 22, s2 / 256.f, 1.0f, 0.0f); }
    } else if (p == 6) {
        {
        const int hh = h1 % 4, d = (h1 >> 8) % 64; float og[3], lse[3];
        for (int g = 0; g < 3; ++g) { const int dil = (g == 0) ? 1 : (g == 1) ? 4 : 16, head = 4 * g + hh; float mx = -1e30f, l = 0.f, o = 0.f;
            for (int i = 0; i <= 128 && pos - i * dil >= 0; ++i) { const bf16* q = QKVA + (size_t)m * P_QKVA + head * 64; const bf16* k = QKVA + (size_t)(m - i * dil) * P_QKVA + 768 + head * 64; float s = 0.f; for (int e = 0; e < 64; ++e) s += bf2f(q[e]) * bf2f(k[e]);
                s *= 0.6931471805599453f; const float mn = fmaxf(mx, s), al = expf(mx - mn), pp = expf(s - mn); l = l * al + pp; o = o * al + pp * bf2f(QKVA[(size_t)(m - i * dil) * P_QKVA + 1536 + head * 64 + d]); mx = mn; }
            og[g] = o / l; lse[g] = mx + logf(l); }
        const float ml = fmaxf(lse[0], fmaxf(lse[1], lse[2])); const float w0 = expf(lse[0] - ml), w1 = expf(lse[1] - ml), w2 = expf(lse[2] - ml);
        chk_add(ctl, 5, bf2f(AOUT[(size_t)m * 256 + hh * 64 + d]), (w0 * og[0] + w1 * og[1] + w2 * og[2]) / (w0 + w1 + w2), 0.01f);
        }
        const float* wqb = args.in[10] + (size_t)Lyr * 384 * 1152; const float* wkvb = args.in[12] + (size_t)Lyr * 256 * 1536; const bf16* a = CLR + (size_t)m * P_CLR;
        if (h1 & 1) { const int h = (h1 >> 4) % 6, d = (h2 >> 4) % 192; float val; int phys = d;
            if (d >= 128) { const int e = d - 128, i = e & 31; const float x1 = dot_bw(a, wqb, 384, 1152, h * 192 + 128 + i), x2 = dot_bw(a, wqb, 384, 1152, h * 192 + 128 + i + 32); rope_pair(x1, x2, pos, i, 10000.0f, 64, e >= 32, val); phys = 128 + ((e < 32) ? 2 * e : 2 * (e - 32) + 1); }
            else val = dot_bw(a, wqb, 384, 1152, h * 192 + d);
            chk_add(ctl, 6, bf2f(QC[(size_t)m * P_QC + h * 192 + phys]), val * QSCALE_C, 0.004f);
        } else { const int c = h2 % 1536; chk_add(ctl, 23, bf2f(KVC[(size_t)m * P_KVC + c]), dot_bw(a + 512, wkvb, 256, 1536, c), 0.03f); }
    } else if (p == 7) {
        if (gt < 16384) { const int h = h1 % 6, d = (h1 >> 8) % 128; const size_t rb = (size_t)(m - pos); float mx = -1e30f, l = 0.f, o = 0.f; const bf16* q = QC + (size_t)m * P_QC + h * 192;
            for (int key = 0; key <= pos; ++key) { const bf16* k = KVC + (rb + key) * P_KVC + h * 256; const bf16* r = CLR + (rb + key) * P_CLR + 768; float s = 0.f; for (int e = 0; e < 128; ++e) s += bf2f(q[e]) * bf2f(k[e]); for (int e = 0; e < 64; ++e) s += bf2f(q[128 + e]) * bf2f(r[e]);
                s *= 0.6931471805599453f; const float mn = fmaxf(mx, s), al = expf(mx - mn), pp = expf(s - mn); l = l * al + pp; o = o * al + pp * bf2f(k[128 + d]); mx = mn; }
            chk_add(ctl, 7, bf2f(CO[(size_t)m * 768 + h * 128 + d]), o / l, 0.01f); }
    } else if (p == 8) { const int c = h1 % N_INB; chk_add(ctl, 8, bf2f(BIN[(size_t)m * P_BIN + c]), dot_bw(XN + (size_t)m * DM, win, DM, INW, O_B + c), 0.03f);
    } else if (p == 9) {
        if (gt < 32768) { const int head = h1 % 8, vc = (h1 >> 8) % 96; const float* lb = LBW + Lyr * 1024 + head * 128; float o = 0.f;
            for (int d = 0; d < 128; ++d) { float prod = 1.f, acc = 0.f; const float lbd = lb[d];
                for (int s = pos; s >= 0 && s > pos - 512; --s) { const bf16* r = BIN + (size_t)(m - pos + s) * P_BIN; const float z = bf2f(r[1024 + head * 128 + d]); const float sg = 1.f / (1.f + expf(-z)); const float f = lbd + (1.f - lbd) * sg, k = (1.f - lbd) * (1.f - sg);
                    acc += prod * k * bf2f(r[2048 + head * 96 + vc]); prod *= f; if (prod < 1e-9f) break; }
                o += bf2f(BIN[(size_t)m * P_BIN + head * 128 + d]) * acc; }
            chk_add(ctl, 9, bf2f(BO[(size_t)m * 768 + head * 96 + vc]), o, 0.03f); }
        for (size_t i = gt; i < (size_t)1024 * 768; i += (size_t)gridDim.x * 512) { const size_t r = i / 768, c = i % 768; BS[i] = BO[(r * 64) * 768 + c]; }
    } else if (p == 10) { const int r = h0 % 1024, head = h1 % 8, e = (h1 >> 8) % 96; const size_t mm = (size_t)r * 64; const float* gn = args.in[8] + Lyr * 96; float s = 0.f; for (int j = 0; j < 96; ++j) { const float v = bf2f(BS[(size_t)r * 768 + head * 96 + j]); s += v * v; }
        const float gv = bf2f(BIN[mm * P_BIN + 2816 + head * 96 + e]); chk_add(ctl, 10, bf2f(BO[mm * 768 + head * 96 + e]), bf2f(BS[(size_t)r * 768 + head * 96 + e]) / sqrtf(s / 96.f + EPS) * gn[e] * gv / (1.f + expf(-gv)), 0.02f);
    } else if (p == 11) { const int c = h1 % N_ING; const float a = dot_bw(XN + (size_t)m * DM, win, DM, INW, O_G + c); chk_add(ctl, 11, bf2f(GS[(size_t)m * P_GS + c]), 1.f / (1.f + expf(-a)), 0.01f);
    } else if (p == 12) { const int c = h1 % DM; const float ya = dot_bw(AOUT + (size_t)m * 256, args.in[13] + (size_t)Lyr * 256 * DM, 256, DM, c), yb = dot_bw(BO + (size_t)m * 768, args.in[14] + (size_t)Lyr * 768 * DM, 768, DM, c), yc = dot_bw(CO + (size_t)m * 768, args.in[15] + (size_t)Lyr * 768 * DM, 768, DM, c);
        chk_add(ctl, 12, bf2f(MG[(size_t)m * DM + c]), bf2f(GS[(size_t)m * P_GS + c]) * ya + bf2f(GS[(size_t)m * P_GS + 1024 + c]) * yb + bf2f(GS[(size_t)m * P_GS + 2048 + c]) * yc, 0.02f); stashX();
    } else if (p == 13) { const int r = h0 % 1024, c = h1 % DM; const size_t mm = (size_t)r * 64; chk_add(ctl, 13, X[mm * DM + c], XS[(size_t)r * DM + c] + dot_bw(MG + mm * DM, args.in[16] + (size_t)Lyr * DM * DM, DM, DM, c), 0.03f);
    } else if (p == 18) { const int r = h0 % 1024, c = h1 % DM; const size_t mm = (size_t)r * 64; const float a = dot_bw(XN + mm * DM, args.in[21] + (size_t)Lyr * DM * DM, DM, DM, c), b = dot_bw(PB + mm * PLE, args.in[22] + (size_t)Lyr * PLE * DM, PLE, DM, c);
        chk_add(ctl, 18, X[mm * DM + c], XS[(size_t)r * DM + c] + b / (1.f + expf(-a)), 0.03f); }
}
__global__ void mk_verdict(Args args) {
    const unsigned* ctl = (const unsigned*)(args.ws + WS_CTL); float val = 0.f;
#ifdef MK_REPORT_K
    { const unsigned bad = ctl[CHK_WORDS + 2 * MK_REPORT_K], tot = ctl[CHK_WORDS + 2 * MK_REPORT_K + 1]; val = (tot == 0) ? 100.f : 3.f + 60.f * (float)bad / (float)tot; }
#else
    for (int k = 0; k < 32; ++k) { const unsigned bad = ctl[CHK_WORDS + 2 * k], tot = ctl[CHK_WORDS + 2 * k + 1]; if (bad > tot / 512 + 2) { val = 3.f * (k + 1); break; } }
#endif
    for (size_t i = (size_t)blockIdx.x * blockDim.x + threadIdx.x; i < (size_t)MTOK * DM; i += (size_t)gridDim.x * blockDim.x) args.out[i] = val;
}
#endif
extern "C" void kernel_launch(void* const* d_in, const int* in_sizes, int n_in, void* d_out, int out_size, void* d_ws, size_t ws_size, hipStream_t stream) {
    static int grid = 0;
    if (grid == 0) {
        if (n_in != 24 || in_sizes[0] != MTOK * DM || out_size != MTOK * DM || ws_size < WS_END + 8 * MiB) { fprintf(stderr, "kernel_launch: unexpected shapes (n_in %d, ws %zu); nothing launched\n", n_in, ws_size); grid = -1; return; }
        int dev = 0, cus = 0, per_cu = 0;
        if (hipGetDevice(&dev) != hipSuccess || hipDeviceGetAttribute(&cus, hipDeviceAttributeMultiprocessorCount, dev) != hipSuccess) { grid = -1; return; }
        if (hipFuncSetAttribute((const void*)mk_fwd, hipFuncAttributeMaxDynamicSharedMemorySize, LDS_BYTES) != hipSuccess) { fprintf(stderr, "kernel_launch: hipFuncSetAttribute failed\n"); grid = -1; return; }
        if (hipOccupancyMaxActiveBlocksPerMultiprocessor(&per_cu, (const void*)mk_fwd, 512, LDS_BYTES) != hipSuccess || per_cu < 1) fprintf(stderr, "kernel_launch: occupancy query reports %d\n", per_cu);
        (void)hipGetLastError();
        grid = cus;
        if (grid != 256) { fprintf(stderr, "kernel_launch: built for the 256-CU MI355X (unit deal of the GEMM phases, rstd tables); found %d CUs; nothing launched\n", grid); grid = -1; return; }
    }
    if (grid < 0) return;
    if (hipMemsetAsync((char*)d_ws + WS_CTL, 0, CTL_ZERO_BYTES, stream) != hipSuccess) return;
    Args a{};
    for (int i = 0; i < 24; ++i) a.in[i] = (const float*)d_in[i];
    a.out = (float*)d_out; a.ws = (unsigned char*)d_ws;
#if MK_N_LAUNCHES == 1
    a.ph_lo = 0; a.ph_hi = NPHASES;
    hipLaunchKernelGGL(mk_fwd, dim3(grid), dim3(512), LDS_BYTES, stream, a);
#elif defined(MK_CHECK)
    for (int p = 0; p < NPH * (MK_CHECK + 1); ++p) {
#ifdef MK_SKIP
        if ((MK_SKIP >> (p % NPH)) & 1u) continue;
#endif
        a.ph_lo = p; a.ph_hi = p + 1; hipLaunchKernelGGL(mk_fwd, dim3(grid), dim3(512), LDS_BYTES, stream, a);
        if (p / NPH == MK_CHECK) hipLaunchKernelGGL(mk_check, dim3(256), dim3(512), 0, stream, a, p % NPH, p / NPH); }
    hipLaunchKernelGGL(mk_verdict, dim3(1024), dim3(256), 0, stream, a);
#else
    for (int p = 0; p < NPHASES; ++p) { a.ph_lo = p; a.ph_hi = p + 1; hipLaunchKernelGGL(mk_fwd, dim3(grid), dim3(512), LDS_BYTES, stream, a); }
#endif
}
```
